# Optimizing an MI355X kernel written in HIP

```python
import math
import jax, jax.numpy as jnp
from jax import lax
import numpy as np

D_MODEL = 2048
BATCH = 4
SEQ = 4096
DEPTH = 2

N_MEM = 256
EPS = 1e-6
ROPE_THETA = 10000.0
Q_BLOCK = 128

MLA_HEADS = 8
MLA_Q_RANK = 512
MLA_KV_RANK = 512
MLA_NOPE = 128
MLA_ROPE = 64
MLA_V = 128
MLA_QK = MLA_NOPE + MLA_ROPE

SSD_HEADS = 16
SSD_HEAD_DIM = 64
SSD_INNER = SSD_HEADS * SSD_HEAD_DIM
SSD_GROUPS = 4
SSD_STATE = 128
SSD_CONV = 4
SSD_CHUNK = 128
SSD_CONV_DIM = SSD_INNER + 2 * SSD_GROUPS * SSD_STATE

EVEN_SPLITS = [MLA_Q_RANK, MLA_KV_RANK, MLA_ROPE, SSD_INNER, SSD_CONV_DIM, SSD_HEADS]
EVEN_IN = sum(EVEN_SPLITS)
EVEN_MIX = MLA_HEADS * MLA_V + SSD_INNER

DIFF_HEADS = 8
DIFF_HEAD_DIM = D_MODEL // DIFF_HEADS // 2
DIFF_V = 2 * DIFF_HEAD_DIM
DIFF_MIX = DIFF_HEADS * DIFF_V

MEM_HEADS = 4
MEM_HEAD_DIM = 128
MEM_WIDTH = MEM_HEADS * MEM_HEAD_DIM

PEER_HEADS = 8
PEER_KEYS = 128
PEER_EXPERTS = PEER_KEYS * PEER_KEYS
PEER_TOPK = 16
PEER_DKEY = 256
PEER_HALF = PEER_DKEY // 2
PEER_TOKEN_BLOCK = 128

N_EVEN = (DEPTH + 1) // 2
N_ODD = DEPTH // 2

kernel_name = "hybrid_mla_ssd_diffattn_peer_block"


def rms_norm(x, g):
    xf = x.astype(jnp.float32)
    y = xf * lax.rsqrt(jnp.mean(xf * xf, axis=-1, keepdims=True) + EPS)
    return (y * g.astype(jnp.float32)).astype(x.dtype)


def rope(x, positions):
    d = x.shape[-1]
    half = d // 2
    inv = 1.0 / (ROPE_THETA ** (jnp.arange(half, dtype=jnp.float32) / half))
    ang = positions.astype(jnp.float32)[..., None] * inv
    shape = ang.shape[:2] + (1,) * (x.ndim - 3) + (half,)
    cos = jnp.cos(ang).reshape(shape)
    sin = jnp.sin(ang).reshape(shape)
    x1 = x[..., :half].astype(jnp.float32)
    x2 = x[..., half:].astype(jnp.float32)
    return jnp.concatenate([x1 * cos - x2 * sin, x2 * cos + x1 * sin], axis=-1).astype(x.dtype)


def causal_block_attention(q, k, v, scale):
    b, s, h, m, dk = q.shape
    nb = s // Q_BLOCK
    qb = jnp.moveaxis(q.reshape(b, nb, Q_BLOCK, h, m, dk), 1, 0)
    kpos = jnp.arange(s)

    def block(args):
        qi, i = args
        sc = jnp.einsum('bqhmd,bkhmd->bhmqk', qi, k).astype(jnp.float32) * scale
        qpos = i * Q_BLOCK + jnp.arange(Q_BLOCK)
        sc = jnp.where(kpos[None, :] <= qpos[:, None], sc, -jnp.inf)
        p = jax.nn.softmax(sc, axis=-1).astype(v.dtype)
        return jnp.einsum('bhmqk,bkhd->bqhmd', p, v)

    out = lax.map(block, (qb, jnp.arange(nb)))
    return jnp.moveaxis(out, 0, 1).reshape(b, s, h, m, v.shape[-1])


def causal_depthwise_conv(x, w, bias):
    kw, c = w.shape
    out = lax.conv_general_dilated(x, w[:, None, :].astype(x.dtype), window_strides=(1,),
                                   padding=[(kw - 1, 0)],
                                   dimension_numbers=('NWC', 'WIO', 'NWC'),
                                   feature_group_count=c)
    return out + bias.astype(x.dtype)


def segsum(a):
    cs = jnp.cumsum(a, axis=-1)
    diff = cs[..., :, None] - cs[..., None, :]
    t = a.shape[-1]
    mask = jnp.tril(jnp.ones((t, t), dtype=bool))
    return jnp.where(mask, diff, -jnp.inf)


def ssd_chunked(x, dt, a, b_in, c_in):
    bsz, s, h, p = x.shape
    g, n = b_in.shape[-2:]
    hg = h // g
    nc = s // SSD_CHUNK
    l = SSD_CHUNK
    xd = (x * dt[..., None]).reshape(bsz, nc, l, g, hg, p)
    adt = jnp.transpose((dt * a).reshape(bsz, nc, l, g, hg), (0, 3, 4, 1, 2))
    bc = b_in.reshape(bsz, nc, l, g, n)
    cc = c_in.reshape(bsz, nc, l, g, n)
    a_cs = jnp.cumsum(adt, axis=-1)
    decay_in = jnp.exp(segsum(adt))
    cb = jnp.einsum('bclgn,bcsgn->bgcls', cc, bc)
    y_diag = jnp.einsum('bgcls,bghcls,bcsghp->bclghp', cb, decay_in, xd)
    decay_states = jnp.exp(a_cs[..., -1:] - a_cs)
    states = jnp.einsum('bclgn,bghcl,bclghp->bcghpn', bc, decay_states, xd)
    chunk_decay = jnp.exp(a_cs[..., -1])

    def step(h_prev, inp):
        st, dec = inp
        return h_prev * dec[..., None, None] + st, h_prev

    h0 = jnp.zeros((bsz, g, hg, p, n), dtype=x.dtype)
    _, prev = lax.scan(step, h0, (jnp.moveaxis(states, 1, 0), jnp.moveaxis(chunk_decay, 3, 0)))
    prev = jnp.moveaxis(prev, 0, 1)
    y_off = jnp.einsum('bclgn,bcghpn,bghcl->bclghp', cc, prev, jnp.exp(a_cs))
    return (y_diag + y_off).reshape(bsz, s, h, p)


def even_mixer(xn, positions, w_in, q_norm, kv_norm, w_uq, w_ukv, q_gain, k_gain,
               conv_w, conv_b, dt_bias, a_log, d_skip, ssd_norm, w_out):
    bsz, s, _ = xn.shape
    proj = xn @ w_in
    c_q, c_kv, k_r, z, xbc, dt = jnp.split(proj, list(np.cumsum(EVEN_SPLITS)[:-1]), axis=-1)
    q = (rms_norm(c_q, q_norm) @ w_uq).reshape(bsz, s, MLA_HEADS, MLA_QK)
    kv = (rms_norm(c_kv, kv_norm) @ w_ukv).reshape(bsz, s, MLA_HEADS, MLA_NOPE + MLA_V)
    k_nope, v = kv[..., :MLA_NOPE], kv[..., MLA_NOPE:]
    k = jnp.concatenate([k_nope, jnp.broadcast_to(k_r[:, :, None, :], (bsz, s, MLA_HEADS, MLA_ROPE))], axis=-1)
    q = rms_norm(q, q_gain)
    k = rms_norm(k, k_gain)
    q = jnp.concatenate([q[..., :MLA_NOPE], rope(q[..., MLA_NOPE:], positions)], axis=-1)
    k = jnp.concatenate([k[..., :MLA_NOPE], rope(k[..., MLA_NOPE:], positions)], axis=-1)
    attn = causal_block_attention(q[:, :, :, None], k[:, :, :, None], v, MLA_QK ** -0.5)[:, :, :, 0]
    mla_out = attn.reshape(bsz, s, MLA_HEADS * MLA_V)
    xbc = jax.nn.silu(causal_depthwise_conv(xbc, conv_w, conv_b))
    xs, b_ssm, c_ssm = jnp.split(xbc, [SSD_INNER, SSD_INNER + SSD_GROUPS * SSD_STATE], axis=-1)
    xs = xs.reshape(bsz, s, SSD_HEADS, SSD_HEAD_DIM).astype(jnp.float32)
    dt = jax.nn.softplus(dt.astype(jnp.float32) + dt_bias.astype(jnp.float32))
    a = -jnp.exp(a_log.astype(jnp.float32))
    y = ssd_chunked(xs, dt, a,
                    b_ssm.reshape(bsz, s, SSD_GROUPS, SSD_STATE).astype(jnp.float32),
                    c_ssm.reshape(bsz, s, SSD_GROUPS, SSD_STATE).astype(jnp.float32))
    y = y + d_skip.astype(jnp.float32)[:, None] * xs
    y = y.reshape(bsz, s, SSD_INNER) * jax.nn.silu(z.astype(jnp.float32))
    y = rms_norm(y.reshape(bsz, s, SSD_GROUPS, SSD_INNER // SSD_GROUPS),
                 ssd_norm.reshape(SSD_GROUPS, SSD_INNER // SSD_GROUPS))
    y = y.reshape(bsz, s, SSD_INNER).astype(xn.dtype)
    return jnp.concatenate([mla_out, y], axis=-1) @ w_out


def odd_mixer(xn, positions, layer, w_qkv, q_gain, k_gain, lam_q1, lam_k1, lam_q2, lam_k2, subln, w_o):
    bsz, s, _ = xn.shape
    q, k, v = jnp.split(xn @ w_qkv, 3, axis=-1)
    q = q.reshape(bsz, s, DIFF_HEADS, 2, DIFF_HEAD_DIM)
    k = k.reshape(bsz, s, DIFF_HEADS, 2, DIFF_HEAD_DIM)
    v = v.reshape(bsz, s, DIFF_HEADS, DIFF_V)
    q = rope(rms_norm(q, q_gain), positions)
    k = rope(rms_norm(k, k_gain), positions)
    out = causal_block_attention(q, k, v, DIFF_HEAD_DIM ** -0.5)
    lam_init = 0.8 - 0.6 * math.exp(-0.3 * layer)
    lam = (jnp.exp(jnp.sum(lam_q1.astype(jnp.float32) * lam_k1.astype(jnp.float32)))
           - jnp.exp(jnp.sum(lam_q2.astype(jnp.float32) * lam_k2.astype(jnp.float32))) + lam_init)
    attn = out[:, :, :, 0] - lam.astype(out.dtype) * out[:, :, :, 1]
    attn = rms_norm(attn, subln) * (1.0 - lam_init)
    return attn.reshape(bsz, s, DIFF_MIX) @ w_o


def memory_attention(xn, mem_n, w_q, w_kv, q_gain, k_gain, w_o):
    bsz, s, _ = xn.shape
    m = mem_n.shape[1]
    q = rms_norm((xn @ w_q).reshape(bsz, s, MEM_HEADS, MEM_HEAD_DIM), q_gain)
    mk, mv = jnp.split(mem_n @ w_kv, 2, axis=-1)
    mk = rms_norm(mk.reshape(bsz, m, MEM_HEADS, MEM_HEAD_DIM), k_gain)
    mv = mv.reshape(bsz, m, MEM_HEADS, MEM_HEAD_DIM)
    sc = jnp.einsum('bqhd,bkhd->bhqk', q, mk).astype(jnp.float32) * (MEM_HEAD_DIM ** -0.5)
    p = jax.nn.softmax(sc, axis=-1).astype(mv.dtype)
    o = jnp.einsum('bhqk,bkhd->bqhd', p, mv).reshape(bsz, s, MEM_WIDTH)
    return o @ w_o


def peer(xn, w_q, sub_keys, u_tab, v_tab):
    bsz, s, d = xn.shape
    q = (xn @ w_q).reshape(bsz, s, PEER_HEADS, 2, PEER_HALF)
    sc = jnp.einsum('bshpk,hpnk->bshpn', q, sub_keys).astype(jnp.float32)
    top_s, top_i = lax.top_k(sc, PEER_TOPK)
    cand_s = top_s[..., 0, :, None] + top_s[..., 1, None, :]
    cand_i = top_i[..., 0, :, None] * PEER_KEYS + top_i[..., 1, None, :]
    kk = PEER_TOPK * PEER_TOPK
    best_s, best_pos = lax.top_k(cand_s.reshape(bsz, s, PEER_HEADS, kk), PEER_TOPK)
    experts = jnp.take_along_axis(cand_i.reshape(bsz, s, PEER_HEADS, kk), best_pos, axis=-1)
    gates = jax.nn.softmax(best_s, axis=-1).astype(xn.dtype)
    nblk = (bsz * s) // PEER_TOKEN_BLOCK
    hk = PEER_HEADS * PEER_TOPK
    xt = xn.reshape(nblk, PEER_TOKEN_BLOCK, d)
    et = experts.reshape(nblk, PEER_TOKEN_BLOCK, hk)
    gt = gates.reshape(nblk, PEER_TOKEN_BLOCK, hk)

    def block(args):
        xb, eb, gb = args
        u = u_tab[eb]
        act = jax.nn.gelu(jnp.einsum('td,tkd->tk', xb, u), approximate=False)
        return jnp.einsum('tk,tkd->td', act * gb, v_tab[eb])

    out = lax.map(block, (xt, et, gt))
    return out.reshape(bsz, s, d)


def setup_inputs(seed: int = 0) -> dict:
    key = jax.random.key(seed)
    ks = iter(jax.random.split(key, 64))

    def nrm(shape, scale):
        return jax.random.normal(next(ks), shape, jnp.float32) * scale

    def gain(shape):
        return 1.0 + nrm(shape, 0.02)

    D = D_MODEL
    inp = {}
    inp['x'] = nrm((BATCH, SEQ, D), 1.0)
    inp['mem'] = nrm((BATCH, N_MEM, D), 1.0)
    inp['positions'] = jnp.broadcast_to(jnp.arange(SEQ, dtype=jnp.int32), (BATCH, SEQ))
    inp['norm_mix'] = gain((DEPTH, D))
    inp['norm_mem'] = gain((DEPTH, D))
    inp['norm_mem_kv'] = gain((DEPTH, D))
    inp['norm_ffn'] = gain((DEPTH, D))
    inp['mem_w_q'] = nrm((DEPTH, D, MEM_WIDTH), D ** -0.5)
    inp['mem_w_kv'] = nrm((DEPTH, D, 2 * MEM_WIDTH), D ** -0.5)
    inp['mem_q_gain'] = gain((DEPTH, MEM_HEAD_DIM))
    inp['mem_k_gain'] = gain((DEPTH, MEM_HEAD_DIM))
    inp['mem_w_o'] = nrm((DEPTH, MEM_WIDTH, D), MEM_WIDTH ** -0.5)
    inp['peer_w_q'] = nrm((DEPTH, D, PEER_HEADS * PEER_DKEY), D ** -0.5)
    inp['peer_sub_keys'] = nrm((DEPTH, PEER_HEADS, 2, PEER_KEYS, PEER_HALF), PEER_HALF ** -0.5)
    inp['peer_u'] = nrm((DEPTH, PEER_EXPERTS, D), D ** -0.5)
    inp['peer_v'] = nrm((DEPTH, PEER_EXPERTS, D), PEER_HEADS ** -0.5)
    inp['ev_w_in'] = nrm((N_EVEN, D, EVEN_IN), D ** -0.5)
    inp['ev_q_norm'] = gain((N_EVEN, MLA_Q_RANK))
    inp['ev_kv_norm'] = gain((N_EVEN, MLA_KV_RANK))
    inp['ev_w_uq'] = nrm((N_EVEN, MLA_Q_RANK, MLA_HEADS * MLA_QK), MLA_Q_RANK ** -0.5)
    inp['ev_w_ukv'] = nrm((N_EVEN, MLA_KV_RANK, MLA_HEADS * (MLA_NOPE + MLA_V)), MLA_KV_RANK ** -0.5)
    inp['ev_q_gain'] = gain((N_EVEN, MLA_QK))
    inp['ev_k_gain'] = gain((N_EVEN, MLA_QK))
    inp['ev_conv_w'] = nrm((N_EVEN, SSD_CONV, SSD_CONV_DIM), SSD_CONV ** -0.5)
    inp['ev_conv_b'] = nrm((N_EVEN, SSD_CONV_DIM), 0.02)
    u = jax.random.uniform(next(ks), (N_EVEN, SSD_HEADS), jnp.float32)
    dt0 = jnp.exp(u * (math.log(0.1) - math.log(0.001)) + math.log(0.001))
    inp['ev_dt_bias'] = dt0 + jnp.log(-jnp.expm1(-dt0))
    inp['ev_a_log'] = jnp.log(jax.random.uniform(next(ks), (N_EVEN, SSD_HEADS), jnp.float32, 1.0, 16.0))
    inp['ev_d_skip'] = 1.0 + nrm((N_EVEN, SSD_HEADS), 0.1)
    inp['ev_ssd_norm'] = gain((N_EVEN, SSD_INNER))
    inp['ev_w_out'] = nrm((N_EVEN, EVEN_MIX, D), EVEN_MIX ** -0.5)
    inp['od_w_qkv'] = nrm((N_ODD, D, 2 * DIFF_HEADS * DIFF_HEAD_DIM * 2 + DIFF_MIX - DIFF_MIX), D ** -0.5) if False else nrm((N_ODD, D, 3 * D), D ** -0.5)
    inp['od_q_gain'] = gain((N_ODD, DIFF_HEAD_DIM))
    inp['od_k_gain'] = gain((N_ODD, DIFF_HEAD_DIM))
    inp['od_lam_q1'] = nrm((N_ODD, DIFF_HEAD_DIM), 0.1)
    inp['od_lam_k1'] = nrm((N_ODD, DIFF_HEAD_DIM), 0.1)
    inp['od_lam_q2'] = nrm((N_ODD, DIFF_HEAD_DIM), 0.1)
    inp['od_lam_k2'] = nrm((N_ODD, DIFF_HEAD_DIM), 0.1)
    inp['od_subln'] = gain((N_ODD, DIFF_V))
    inp['od_w_o'] = nrm((N_ODD, DIFF_MIX, D), DIFF_MIX ** -0.5)
    return inp


def reference(x, mem, positions,
              norm_mix, norm_mem, norm_mem_kv, norm_ffn,
              mem_w_q, mem_w_kv, mem_q_gain, mem_k_gain, mem_w_o,
              peer_w_q, peer_sub_keys, peer_u, peer_v,
              ev_w_in, ev_q_norm, ev_kv_norm, ev_w_uq, ev_w_ukv, ev_q_gain, ev_k_gain,
              ev_conv_w, ev_conv_b, ev_dt_bias, ev_a_log, ev_d_skip, ev_ssd_norm, ev_w_out,
              od_w_qkv, od_q_gain, od_k_gain, od_lam_q1, od_lam_k1, od_lam_q2, od_lam_k2,
              od_subln, od_w_o):
    for layer in range(DEPTH):
        i = layer // 2
        xn = rms_norm(x, norm_mix[layer])
        if layer % 2 == 0:
            h = even_mixer(xn, positions, ev_w_in[i], ev_q_norm[i], ev_kv_norm[i], ev_w_uq[i],
                           ev_w_ukv[i], ev_q_gain[i], ev_k_gain[i], ev_conv_w[i], ev_conv_b[i],
                           ev_dt_bias[i], ev_a_log[i], ev_d_skip[i], ev_ssd_norm[i], ev_w_out[i])
        else:
            h = odd_mixer(xn, positions, layer, od_w_qkv[i], od_q_gain[i], od_k_gain[i],
                          od_lam_q1[i], od_lam_k1[i], od_lam_q2[i], od_lam_k2[i],
                          od_subln[i], od_w_o[i])
        x = x + h
        x = x + memory_attention(rms_norm(x, norm_mem[layer]), rms_norm(mem, norm_mem_kv[layer]),
                                 mem_w_q[layer], mem_w_kv[layer], mem_q_gain[layer],
                                 mem_k_gain[layer], mem_w_o[layer])
        x = x + peer(rms_norm(x, norm_ffn[layer]), peer_w_q[layer], peer_sub_keys[layer],
                     peer_u[layer], peer_v[layer])
    return x
```

```cpp
#include <hip/hip_runtime.h>
#include <cstdio>
#include <cstdint>

#ifndef MK_ONE_LAUNCH
#define MK_ONE_LAUNCH 1
#endif

#define LAS __attribute__((address_space(3)))
#define GAS __attribute__((address_space(1)))
typedef unsigned short bf16_t;
typedef short bf16x8 __attribute__((ext_vector_type(8)));
typedef short s16x4 __attribute__((ext_vector_type(4)));
typedef float f32x4 __attribute__((ext_vector_type(4)));
typedef float f32x2 __attribute__((ext_vector_type(2)));
typedef float f32x16 __attribute__((ext_vector_type(16)));
typedef unsigned u32x4 __attribute__((ext_vector_type(4)));
typedef unsigned u32x2 __attribute__((ext_vector_type(2)));
typedef __bf16 bf16x2_t __attribute__((ext_vector_type(2)));

constexpr int BATCH = 4, SEQ = 4096, DM = 2048, TOK = BATCH * SEQ;
constexpr int NMEM = 256;
constexpr float EPS = 1e-6f;
constexpr int MLA_H = 8, MLA_QK = 192, MLA_NOPE = 128, MLA_ROPE = 64, MLA_V = 128, MLA_RANK = 512;
constexpr int SSD_H = 16, SSD_P = 64, SSD_INNER = 1024, SSD_G = 4, SSD_N = 128, SSD_CONVD = 2048;
constexpr int EVEN_IN = 4176, WIN_N = 4352;
constexpr int DIFF_H = 8, DIFF_HD = 128, DIFF_V = 256;
constexpr int MEM_H = 4, MEM_HD = 128, MEM_W = 512;
constexpr int PEER_H = 8, PEER_KEYS = 128, PEER_E = 16384, PEER_K = 16, PEER_HK = 128;

constexpr size_t MiB = 1u << 20;
constexpr size_t WS_CTL = 0, CTL_ZERO_BYTES = 1 * MiB;
constexpr size_t WS_WIN = 1 * MiB;
constexpr size_t WS_WUQ = 18 * MiB;
constexpr size_t WS_WUKV = 20 * MiB;
constexpr size_t WS_WOUT = 22 * MiB;
constexpr size_t WS_WMEMQ = 30 * MiB;
constexpr size_t WS_WMEMKV = 34 * MiB;
constexpr size_t WS_WMEMO = 42 * MiB;
constexpr size_t WS_WPEERQ = 46 * MiB;
constexpr size_t WS_WQKV = 62 * MiB;
constexpr size_t WS_WO = 86 * MiB;
constexpr size_t WS_KEYS = 94 * MiB;
constexpr size_t WS_U8 = 96 * MiB;
constexpr size_t WS_V8 = 160 * MiB;
constexpr size_t WS_TSC = 224 * MiB;
constexpr size_t WS_ROPE32 = 352 * MiB;
constexpr size_t WS_ROPE64 = 356 * MiB;
constexpr size_t WS_XB = 364 * MiB;
constexpr size_t WS_RSTD = 428 * MiB;
constexpr size_t WS_RSTD_CQ = WS_RSTD + 65536;
constexpr size_t WS_RSTD_CKV = WS_RSTD + 2 * 65536;
constexpr size_t WS_RSTD_MEM = WS_RSTD + 3 * 65536;
constexpr size_t WS_SSQ1 = 925 * MiB, WS_SSQ2 = 927 * MiB;
constexpr size_t WS_MEMB = 429 * MiB;
constexpr size_t WS_MEMKV = 433 * MiB;
constexpr size_t WS_MIX = 437 * MiB;
constexpr size_t WS_LR = 501 * MiB;
constexpr size_t WS_CQ = WS_LR;
constexpr size_t WS_CKV = WS_LR + 16 * MiB;
constexpr size_t WS_Z = WS_LR + 32 * MiB;
constexpr size_t WS_XBC = WS_LR + 64 * MiB;
constexpr size_t WS_XBCC = WS_LR + 128 * MiB;
constexpr size_t WS_TAIL = WS_LR + 192 * MiB;
constexpr size_t WS_DT = WS_LR + 198 * MiB;
constexpr size_t WS_QM = WS_LR + 200 * MiB;
constexpr size_t WS_KV = WS_LR + 248 * MiB;
constexpr size_t WS_KM = WS_LR + 312 * MiB;
constexpr size_t WS_YG = WS_LR + 360 * MiB;
constexpr size_t WS_QD = WS_LR;
constexpr size_t WS_KD = WS_LR + 64 * MiB;
constexpr size_t WS_VD = WS_LR + 128 * MiB;
constexpr size_t WS_OD = WS_LR + 192 * MiB;
constexpr size_t WS_MEMQ = WS_LR;
constexpr size_t WS_MEMO = WS_LR + 16 * MiB;
constexpr size_t WS_PQ = WS_LR + 32 * MiB;
constexpr size_t WS_EXP = WS_LR + 96 * MiB;
constexpr size_t WS_GATE = WS_LR + 104 * MiB;
constexpr size_t WS_PW = WS_LR + 112 * MiB;
constexpr size_t WS_PWS = WS_LR + 158 * MiB;
constexpr size_t WS_XQ = WS_LR + 120 * MiB;
constexpr size_t WS_SW = WS_LR + 152 * MiB + 131072;
constexpr size_t WS_SX = WS_LR + 152 * MiB + 65536;
constexpr size_t WS_XS = WS_LR + 152 * MiB;
constexpr size_t WS_PD = WS_LR + 160 * MiB;
constexpr size_t WS_END = WS_LR + 428 * MiB;
constexpr int CW_BAR = 4096;

constexpr int RING_BYTES = 131072;
constexpr int MISC_OFF = RING_BYTES;
constexpr int LDS_BYTES = 147456;
constexpr int NWAVES = 8, NTHREADS = 512;

__device__ __forceinline__ unsigned cvt_pk_bf16(float lo, float hi) { unsigned r; asm volatile("v_cvt_pk_bf16_f32 %0, %1, %2" : "=v"(r) : "v"(lo), "v"(hi)); return r; }
__device__ __forceinline__ float bf_lo(unsigned w) { return __uint_as_float(w << 16); }
__device__ __forceinline__ float bf_hi(unsigned w) { return __uint_as_float(w & 0xffff0000u); }
__device__ __forceinline__ float bf2f(bf16_t h) { return __uint_as_float(((unsigned)h) << 16); }
__device__ __forceinline__ bf16_t f2bf(float f) { return (bf16_t)(cvt_pk_bf16(f, 0.f) & 0xffffu); }
__device__ __forceinline__ int lane_id() { int l; asm volatile("v_mbcnt_lo_u32_b32 %0, -1, 0\n\tv_mbcnt_hi_u32_b32 %0, -1, %0" : "=v"(l)); return l; }
__device__ __forceinline__ float shx(float v, int m, int lane) { return __int_as_float(__builtin_amdgcn_ds_bpermute((lane ^ m) << 2, __float_as_int(v))); }
__device__ __forceinline__ unsigned shxu(unsigned v, int m, int lane) { return (unsigned)__builtin_amdgcn_ds_bpermute((lane ^ m) << 2, (int)v); }
__device__ __forceinline__ float shf(float v, int src) { return __int_as_float(__builtin_amdgcn_ds_bpermute(src << 2, __float_as_int(v))); }
__device__ __forceinline__ int rs_bit5(int lo, int hi) { auto r = __builtin_amdgcn_permlane32_swap((unsigned)lo, (unsigned)hi, false, false); return (int)r[0] + (int)r[1]; }
__device__ __forceinline__ int rs_bit4(int lo, int hi) { auto r = __builtin_amdgcn_permlane16_swap((unsigned)lo, (unsigned)hi, false, false); return (int)r[0] + (int)r[1]; }
__device__ __forceinline__ int rs_bit3(int lo, int hi, bool b3) { const int keep = b3 ? hi : lo, send = b3 ? lo : hi; return keep + __builtin_amdgcn_update_dpp(0, send, 0x128, 0xf, 0xf, false); }
template <int CTRL> __device__ __forceinline__ float dppf(float v) { return __int_as_float(__builtin_amdgcn_update_dpp(0, __float_as_int(v), CTRL, 0xf, 0xf, false)); }
template <int CTRL> __device__ __forceinline__ int dppi(int v) { return __builtin_amdgcn_update_dpp(0, v, CTRL, 0xf, 0xf, false); }
__device__ __forceinline__ float row8_sum(float v) { v += dppf<0xB1>(v); v += dppf<0x4E>(v); v += dppf<0x141>(v); return v; }
__device__ __forceinline__ float row16_sum(float v) { v = row8_sum(v); v += dppf<0x140>(v); return v; }
__device__ __forceinline__ float half_sum(float v) { v = row16_sum(v); auto s = __builtin_amdgcn_permlane16_swap(__float_as_uint(v), __float_as_uint(v), false, false); return __uint_as_float(s[0]) + __uint_as_float(s[1]); }
__device__ __forceinline__ float wave_sum(float v, int) { v = half_sum(v); auto t = __builtin_amdgcn_permlane32_swap(__float_as_uint(v), __float_as_uint(v), false, false); return __uint_as_float(t[0]) + __uint_as_float(t[1]); }
__device__ __forceinline__ float wave_max(float v) { v = fmaxf(v, dppf<0xB1>(v)); v = fmaxf(v, dppf<0x4E>(v)); v = fmaxf(v, dppf<0x141>(v)); v = fmaxf(v, dppf<0x140>(v));
    auto s = __builtin_amdgcn_permlane16_swap(__float_as_uint(v), __float_as_uint(v), false, false); v = fmaxf(__uint_as_float(s[0]), __uint_as_float(s[1]));
    auto t = __builtin_amdgcn_permlane32_swap(__float_as_uint(v), __float_as_uint(v), false, false); return fmaxf(__uint_as_float(t[0]), __uint_as_float(t[1])); }
__device__ __forceinline__ int wave_sum_i(int v) { v += dppi<0xB1>(v); v += dppi<0x4E>(v); v += dppi<0x141>(v); v += dppi<0x140>(v);
    auto s = __builtin_amdgcn_permlane16_swap((unsigned)v, (unsigned)v, false, false); v = (int)s[0] + (int)s[1];
    auto t = __builtin_amdgcn_permlane32_swap((unsigned)v, (unsigned)v, false, false); return (int)t[0] + (int)t[1]; }
__device__ __forceinline__ u32x4 pack8(f32x4 a, f32x4 b) { u32x4 w; w.x = cvt_pk_bf16(a.x, a.y); w.y = cvt_pk_bf16(a.z, a.w); w.z = cvt_pk_bf16(b.x, b.y); w.w = cvt_pk_bf16(b.z, b.w); return w; }
__device__ __forceinline__ void unpack8(u32x4 w, float (&f)[8]) { f[0] = bf_lo(w.x); f[1] = bf_hi(w.x); f[2] = bf_lo(w.y); f[3] = bf_hi(w.y); f[4] = bf_lo(w.z); f[5] = bf_hi(w.z); f[6] = bf_lo(w.w); f[7] = bf_hi(w.w); }
__device__ __forceinline__ float fast_exp(float x) { return __builtin_amdgcn_exp2f(x * 1.4426950408889634f); }
__device__ __forceinline__ float silu_f(float v) { return v * __builtin_amdgcn_rcpf(1.f + fast_exp(-v)); }
__device__ __forceinline__ float gelu_f(float v) {
    const float av = fabsf(v), t = __builtin_amdgcn_rcpf(av * 0.2316418882f + 1.0f);
    float q = t * 0.5307027145f + (-0.7265760135f); q = q * t + 0.7107068705f; q = q * t + (-0.142248368f); q = q * t + 0.127414796f; q = q * t;
    const float e = __builtin_amdgcn_exp2f((v * v) * (-0.72134752044f));
    const float m = v * (q * e);
    return v < 0.f ? m : v - m;
}

__device__ __forceinline__ float ld_ssq(const float* p) { return __hip_atomic_fetch_add(const_cast<float*>(p), 0.0f, __ATOMIC_RELAXED, __HIP_MEMORY_SCOPE_AGENT); }
namespace pg8 {
constexpr int BM = 256, BK = 64, HALF = 128, HTB = HALF * BK * 2, STAGE_BYTES = 8 * HTB, NXCD = 8, WGM = 8;
__host__ __device__ __forceinline__ int lds_byte(int r, int c) { const int st = (r >> 4) * 2 + (c >> 5), rr = r & 15, cc = c & 31, ob = rr * 64 + cc * 2; return st * 1024 + (ob ^ (((ob >> 9) & 1) << 5)); }
__host__ __device__ __forceinline__ void stage_rc(int b, int& R, int& C) { const int st = b / 1024, sb = b % 1024, swz = sb ^ (((sb >> 9) & 1) << 5); R = (st >> 1) * 16 + swz / 64; C = (st & 1) * 32 + (swz % 64) / 2; }
__host__ __device__ __forceinline__ int perm32(int rho) { const int n = rho >> 4, i = rho & 15; return 8 * (i >> 2) + 4 * n + (i & 3); }
struct Unit { int pm, pn; };
struct Gemm { const bf16_t* A; const bf16_t* Bt; int M, N, K; };
struct StaticOrder {
    int nM, nN, nwg, G, c;
    __host__ __device__ void init(int M, int N, int G_, int c_) { nM = M / BM; nN = N / BM; nwg = nM * nN; G = G_; c = c_; }
    __host__ __device__ bool next(int i, Unit& u) const {
        const long L = (long)i * G + c; if (L >= nwg) return false;
        int wgid = (int)L; { const int q = nwg / NXCD, r = nwg % NXCD, xcd = wgid % NXCD, off = wgid / NXCD; wgid = (xcd < r ? xcd * (q + 1) : r * (q + 1) + (xcd - r) * q) + off; }
        const int nig = WGM * nN, gid = wgid / nig, fm = gid * WGM, gsz = (nM - fm) < WGM ? (nM - fm) : WGM;
        u.pm = fm + ((wgid % nig) % gsz); u.pn = (wgid % nig) / gsz; return true;
    }
    __device__ __forceinline__ void a_ready(const Unit&) const {}
    __device__ __forceinline__ void done(const Unit&) const {}
};
template <class Epi, class Sched, bool ALIGN_EPI = false, bool SP2 = false, bool HALFN = false>
__device__ __forceinline__ void gemm_phase(LAS unsigned char* lds, const Gemm g, const Sched& S, const Epi& E, int tid_in) {
    static_assert(!HALFN || SP2, "HALFN is written for the SP2 schedule");
    int tid = tid_in; asm volatile("" : "+v"(tid));
    const int wid = __builtin_amdgcn_readfirstlane(tid >> 6), lane = tid & 63, wr = wid >> 2, wc = wid & 3, fr = lane & 15, fq = lane >> 4;
    const int K = g.K, nt = K / BK;
    unsigned voffA[2], voffB[2];
#pragma unroll
    for (int i = 0; i < 2; ++i) { int R, C; stage_rc(tid * 16 + i * 8192, R, C); const int Rb = Epi::PERM ? ((R & ~31) + perm32(R & 31)) : R;
        voffA[i] = (unsigned)(R * K + C) * 2u; voffB[i] = (unsigned)(Rb * K + C) * 2u; }
    const size_t kstep = (size_t)(BK * 2);
    const size_t hstep = (size_t)HALF * K * 2;
    const size_t tstep = 2 * hstep;
    const unsigned ldsw = (unsigned)wid * 1024u;
    const int aoff = lds_byte(wr * 64 + fr, fq * 8), boff = lds_byte(wc * 32 + fr, fq * 8);
#define PG8_SA(b, h) (((b) * 2 + (h)) * HTB)
#define PG8_SB(b, h) ((4 + (b) * 2 + (h)) * HTB)
#define PG8_STAGE(bufoff, gbase, voff) do { _Pragma("unroll") for (int _i = 0; _i < 2; ++_i) \
        __builtin_amdgcn_global_load_lds((const unsigned*)((const char*)(gbase) + (voff)[_i]), (LAS unsigned*)(lds + (bufoff) + ldsw + _i * 8192), 16, 0, 0); } while (0)
#define PG8_LDA(dst, b, h) do { _Pragma("unroll") for (int m = 0; m < 4; ++m) _Pragma("unroll") for (int k = 0; k < 2; ++k) dst[m][k] = *(const LAS bf16x8*)(lds + PG8_SA(b, h) + aoff + m * 2048 + k * 1024); } while (0)
#define PG8_LDB(dst, b, h) do { _Pragma("unroll") for (int n = 0; n < 2; ++n) _Pragma("unroll") for (int k = 0; k < 2; ++k) dst[n][k] = *(const LAS bf16x8*)(lds + PG8_SB(b, h) + boff + n * 2048 + k * 1024); } while (0)
#define PG8_MMA(ai, bj, At, Bt) do { __builtin_amdgcn_s_setprio(1); _Pragma("unroll") for (int m = 0; m < 4; ++m) _Pragma("unroll") for (int n = 0; n < 2; ++n) _Pragma("unroll") for (int k = 0; k < 2; ++k) \
        acc[ai][bj][m][n] = __builtin_amdgcn_mfma_f32_16x16x32_bf16(Bt[n][k], At[m][k], acc[ai][bj][m][n], 0, 0, 0); __builtin_amdgcn_s_setprio(0); } while (0)
#define PG8_WAIT_V(n) asm volatile("s_waitcnt vmcnt(" #n ")" ::: "memory")
#define PG8_WAIT_L(n) asm volatile("s_waitcnt lgkmcnt(" #n ")" ::: "memory")
#define PG8_BAR __builtin_amdgcn_s_barrier()
#define PG8_SCHED __builtin_amdgcn_sched_barrier(0)
    Unit cur, nxt; int ui = 0;
    if (!S.next(0, cur)) return;
    f32x4 acc[2][2][4][2];
#pragma unroll
    for (int a = 0; a < 2; ++a)
#pragma unroll
        for (int b = 0; b < 2; ++b)
#pragma unroll
            for (int m = 0; m < 4; ++m)
#pragma unroll
                for (int n = 0; n < 2; ++n) acc[a][b][m][n] = (f32x4){0.f, 0.f, 0.f, 0.f};
    bf16x8 At[4][2], B0[2][2], B1[2][2];
    const size_t bstep = HALFN ? hstep : tstep;
    const char* cA = (const char*)g.A + (size_t)cur.pm * tstep; const char* cB = (const char*)g.Bt + (size_t)cur.pn * bstep;
    S.a_ready(cur);
    if constexpr (HALFN) {
        PG8_STAGE(PG8_SB(0, 0), cB, voffB); PG8_STAGE(PG8_SA(0, 0), cA, voffA); PG8_STAGE(PG8_SA(0, 1), cA + hstep, voffA);
        if (wr == 1) PG8_BAR;
        PG8_WAIT_V(2); PG8_BAR;
        PG8_STAGE(PG8_SB(1, 0), cB + kstep, voffB); PG8_STAGE(PG8_SA(1, 0), cA + kstep, voffA);
        PG8_WAIT_V(4); PG8_BAR;
    } else if constexpr (SP2) {
        PG8_STAGE(PG8_SB(0, 0), cB, voffB); PG8_STAGE(PG8_SB(0, 1), cB + hstep, voffB); PG8_STAGE(PG8_SA(0, 0), cA, voffA); PG8_STAGE(PG8_SA(0, 1), cA + hstep, voffA);
        if (wr == 1) PG8_BAR;
        PG8_WAIT_V(2); PG8_BAR;
        PG8_STAGE(PG8_SB(1, 0), cB + kstep, voffB); PG8_STAGE(PG8_SA(1, 0), cA + kstep, voffA); PG8_STAGE(PG8_SB(1, 1), cB + hstep + kstep, voffB);
        PG8_WAIT_V(6); PG8_BAR;
    } else {
        PG8_STAGE(PG8_SB(0, 0), cB, voffB); PG8_STAGE(PG8_SA(0, 0), cA, voffA); PG8_STAGE(PG8_SB(0, 1), cB + hstep, voffB); PG8_STAGE(PG8_SA(0, 1), cA + hstep, voffA);
        if (wr == 1) PG8_BAR;
        PG8_WAIT_V(4); PG8_BAR;
        PG8_STAGE(PG8_SB(1, 0), cB + kstep, voffB); PG8_STAGE(PG8_SA(1, 0), cA + kstep, voffA); PG8_STAGE(PG8_SB(1, 1), cB + hstep + kstep, voffB);
        PG8_WAIT_V(6); PG8_BAR;
    }
    for (;;) {
        const bool has_next = S.next(ui + 1, nxt);
        const char* nA = has_next ? (const char*)g.A + (size_t)nxt.pm * tstep : cA; const char* nB = has_next ? (const char*)g.Bt + (size_t)nxt.pn * bstep : cB;
        for (int t = 0; t < nt; t += 2) {
            const bool last = (t == nt - 2);
            const char* a1 = cA + (size_t)(t + 1) * kstep;
            const char* a2 = last ? nA : cA + (size_t)(t + 2) * kstep; const char* b2 = last ? nB : cB + (size_t)(t + 2) * kstep;
            const char* a3 = a2 + kstep; const char* b3 = b2 + kstep;
            if (last && has_next) S.a_ready(nxt);
            if constexpr (HALFN) {
            PG8_LDB(B0, 0, 0); PG8_SCHED; PG8_LDA(At, 0, 0); PG8_STAGE(PG8_SA(1, 1), a1 + hstep, voffA);
            PG8_WAIT_V(6); PG8_WAIT_L(0); PG8_BAR; PG8_MMA(0, 0, At, B0); PG8_BAR; PG8_SCHED;
            PG8_LDA(At, 0, 1); PG8_STAGE(PG8_SB(0, 0), b2, voffB); PG8_STAGE(PG8_SA(0, 0), a2, voffA);
            PG8_WAIT_V(6); PG8_WAIT_L(0); PG8_BAR; PG8_MMA(1, 0, At, B0); PG8_BAR; PG8_SCHED;
            PG8_LDB(B0, 1, 0); PG8_SCHED; PG8_LDA(At, 1, 0); PG8_STAGE(PG8_SA(0, 1), a2 + hstep, voffA);
            PG8_WAIT_V(6); PG8_WAIT_L(0); PG8_BAR; PG8_MMA(0, 0, At, B0); PG8_BAR; PG8_SCHED;
            PG8_LDA(At, 1, 1); PG8_STAGE(PG8_SB(1, 0), b3, voffB); PG8_STAGE(PG8_SA(1, 0), a3, voffA);
            PG8_WAIT_V(6); PG8_WAIT_L(0); PG8_BAR; PG8_MMA(1, 0, At, B0); PG8_BAR; PG8_SCHED;
            } else if constexpr (SP2) {
            PG8_LDB(B0, 0, 0); PG8_LDB(B1, 0, 1); PG8_SCHED; PG8_LDA(At, 0, 0); PG8_STAGE(PG8_SA(1, 1), a1 + hstep, voffA);
            PG8_WAIT_V(8); PG8_WAIT_L(0); PG8_BAR; PG8_MMA(0, 0, At, B0); PG8_MMA(0, 1, At, B1); PG8_BAR; PG8_SCHED;
            PG8_LDA(At, 0, 1); PG8_STAGE(PG8_SB(0, 0), b2, voffB); PG8_STAGE(PG8_SB(0, 1), b2 + hstep, voffB); PG8_STAGE(PG8_SA(0, 0), a2, voffA);
            PG8_WAIT_V(8); PG8_WAIT_L(0); PG8_BAR; PG8_MMA(1, 0, At, B0); PG8_MMA(1, 1, At, B1); PG8_BAR; PG8_SCHED;
            PG8_LDB(B0, 1, 0); PG8_LDB(B1, 1, 1); PG8_SCHED; PG8_LDA(At, 1, 0); PG8_STAGE(PG8_SA(0, 1), a2 + hstep, voffA);
            PG8_WAIT_V(8); PG8_WAIT_L(0); PG8_BAR; PG8_MMA(0, 0, At, B0); PG8_MMA(0, 1, At, B1); PG8_BAR; PG8_SCHED;
            PG8_LDA(At, 1, 1); PG8_STAGE(PG8_SB(1, 0), b3, voffB); PG8_STAGE(PG8_SB(1, 1), b3 + hstep, voffB); PG8_STAGE(PG8_SA(1, 0), a3, voffA);
            PG8_WAIT_V(8); PG8_WAIT_L(0); PG8_BAR; PG8_MMA(1, 0, At, B0); PG8_MMA(1, 1, At, B1); PG8_BAR; PG8_SCHED;
            } else {
            PG8_LDB(B0, 0, 0); PG8_SCHED; PG8_LDA(At, 0, 0); PG8_STAGE(PG8_SA(1, 1), a1 + hstep, voffA);
            PG8_WAIT_L(8); PG8_BAR; PG8_WAIT_L(0); PG8_MMA(0, 0, At, B0); PG8_BAR; PG8_SCHED;
            PG8_LDB(B1, 0, 1); PG8_STAGE(PG8_SB(0, 0), b2, voffB);
            PG8_BAR; PG8_WAIT_L(0); PG8_MMA(0, 1, At, B1); PG8_BAR;
            PG8_LDA(At, 0, 1); PG8_STAGE(PG8_SA(0, 0), a2, voffA);
            PG8_BAR; PG8_WAIT_L(0); PG8_MMA(1, 0, At, B0); PG8_BAR; PG8_SCHED;
            PG8_STAGE(PG8_SB(0, 1), b2 + hstep, voffB);
            PG8_WAIT_V(6); PG8_BAR; PG8_MMA(1, 1, At, B1); PG8_BAR;
            PG8_LDB(B0, 1, 0); PG8_SCHED; PG8_LDA(At, 1, 0); PG8_STAGE(PG8_SA(0, 1), a2 + hstep, voffA);
            PG8_WAIT_L(8); PG8_BAR; PG8_WAIT_L(0); PG8_MMA(0, 0, At, B0); PG8_BAR; PG8_SCHED;
            PG8_LDB(B1, 1, 1); PG8_STAGE(PG8_SB(1, 0), b3, voffB);
            PG8_BAR; PG8_WAIT_L(0); PG8_MMA(0, 1, At, B1); PG8_BAR;
            PG8_LDA(At, 1, 1); PG8_STAGE(PG8_SA(1, 0), a3, voffA);
            PG8_BAR; PG8_WAIT_L(0); PG8_MMA(1, 0, At, B0); PG8_BAR; PG8_SCHED;
            PG8_STAGE(PG8_SB(1, 1), b3 + hstep, voffB);
            PG8_WAIT_V(6); PG8_BAR; PG8_MMA(1, 1, At, B1); PG8_BAR;
            }
        }
        if constexpr (ALIGN_EPI) { if (wr == 0) PG8_BAR; }
        if constexpr (!Epi::AFTER_DRAIN) { E(acc, cur, wr, wc, fr, fq); S.done(cur); }
        if (!has_next) break;
#pragma unroll
        for (int a = 0; a < 2; ++a)
#pragma unroll
            for (int b = 0; b < 2; ++b)
#pragma unroll
                for (int m = 0; m < 4; ++m)
#pragma unroll
                    for (int n = 0; n < 2; ++n) acc[a][b][m][n] = (f32x4){0.f, 0.f, 0.f, 0.f};
        cur = nxt; cA = nA; cB = nB; ++ui;
        if constexpr (ALIGN_EPI) { if (wr == 1) PG8_BAR; }
    }
    PG8_WAIT_V(0);
    if constexpr (!ALIGN_EPI) { if (wr == 0) PG8_BAR; }
    PG8_BAR;
#undef PG8_SA
#undef PG8_SB
#undef PG8_STAGE
#undef PG8_LDA
#undef PG8_LDB
#undef PG8_MMA
#undef PG8_WAIT_V
#undef PG8_WAIT_L
#undef PG8_BAR
#undef PG8_SCHED
}

__device__ __forceinline__ float xrow16_sum(float x) {
    auto s = __builtin_amdgcn_permlane16_swap(__float_as_uint(x), __float_as_uint(x), false, false); x = __uint_as_float(s[0]) + __uint_as_float(s[1]);
    auto t = __builtin_amdgcn_permlane32_swap(__float_as_uint(x), __float_as_uint(x), false, false); return __uint_as_float(t[0]) + __uint_as_float(t[1]);
}
struct EpiStore {
    static constexpr bool PERM = true, AFTER_DRAIN = false;
    bf16_t* O; int ldc; const float* rscale; int split_cols; size_t split_stride; float inv_n; bool slots; bool halfn = false;
    __device__ __forceinline__ void operator()(const f32x4 (&acc)[2][2][4][2], const Unit& u, int wr, int wc, int fr, int fq) const {
        const int row0 = u.pm * BM + wr * 64 + fr; int colt = u.pn * (halfn ? HALF : BM); bf16_t* base = O;
        if (split_cols) { const int t = colt / split_cols; base += (size_t)t * split_stride; colt -= t * split_cols; }
        const int col0 = colt + wc * 32 + 8 * fq;
#pragma unroll
        for (int ai = 0; ai < 2; ++ai)
#pragma unroll
            for (int m = 0; m < 4; ++m) { const int row = row0 + ai * HALF + m * 16; float sc = 1.f; if (slots) { const f32x4 s0 = *(const f32x4*)(rscale + (size_t)row * 32 + fq * 8), s1 = *(const f32x4*)(rscale + (size_t)row * 32 + fq * 8 + 4); sc = 1.0f / sqrtf(xrow16_sum((s0.x + s0.y) + (s0.z + s0.w) + (s1.x + s1.y) + (s1.z + s1.w)) * inv_n + EPS); } else if (inv_n > 0.f) sc = 1.0f / sqrtf(rscale[row] * inv_n + EPS); else if (rscale) sc = rscale[row]; bf16_t* rowp = base + (size_t)row * ldc + col0;
#pragma unroll
                for (int bj = 0; bj < 2; ++bj) if (bj == 0 || !halfn) *(u32x4*)(rowp + bj * HALF) = pack8(acc[ai][bj][m][0] * sc, acc[ai][bj][m][1] * sc); }
    }
};
struct EpiWin {
    static constexpr bool PERM = true, AFTER_DRAIN = false;
    bf16_t *CQ, *CKV, *Z, *XBC; float* TAIL; const float* rscale;
    __device__ __forceinline__ void operator()(const f32x4 (&acc)[2][2][4][2], const Unit& u, int wr, int wc, int fr, int fq) const {
        const int row0 = u.pm * BM + wr * 64 + fr, pn = u.pn;
        bf16_t* base; int ldc, colt;
        if (pn < 2) { base = CQ; ldc = 512; colt = pn * 256; } else if (pn < 4) { base = CKV; ldc = 512; colt = (pn - 2) * 256; }
        else if (pn < 8) { base = Z; ldc = 1024; colt = (pn - 4) * 256; } else { base = XBC; ldc = 2048; colt = (pn - 8) * 256; }
        const int cl = wc * 32 + 8 * fq;
#pragma unroll
        for (int ai = 0; ai < 2; ++ai)
#pragma unroll
            for (int m = 0; m < 4; ++m) { const int row = row0 + ai * HALF + m * 16; const float sc = 1.0f / sqrtf(rscale[row] * (1.f / 2048.f) + EPS);
                if (pn < 16) { bf16_t* rowp = base + (size_t)row * ldc + colt + cl;
#pragma unroll
                    for (int bj = 0; bj < 2; ++bj) *(u32x4*)(rowp + bj * HALF) = pack8(acc[ai][bj][m][0] * sc, acc[ai][bj][m][1] * sc); }
                else if (cl < 80) { float* rowp = TAIL + (size_t)row * 80 + cl; *(f32x4*)rowp = acc[ai][0][m][0] * sc; *(f32x4*)(rowp + 4) = acc[ai][0][m][1] * sc; } }
    }
};
struct EpiResid {
    static constexpr bool PERM = true, AFTER_DRAIN = false;
    bf16_t* X; float* SSQ; float fac;
    __device__ __forceinline__ void operator()(const f32x4 (&acc)[2][2][4][2], const Unit& u, int wr, int wc, int fr, int fq) const {
        const int row0 = u.pm * BM + wr * 64 + fr, col0 = u.pn * BM + wc * 32 + 8 * fq;
#pragma unroll
        for (int ai = 0; ai < 2; ++ai)
#pragma unroll
            for (int m = 0; m < 4; ++m) { const int row = row0 + ai * HALF + m * 16; const size_t off = (size_t)row * DM + col0; float ss = 0.f;
#pragma unroll
                for (int bj = 0; bj < 2; ++bj) { float f[8]; unpack8(*(const u32x4*)(X + off + bj * HALF), f);
                    const f32x4 v0 = (f32x4){f[0], f[1], f[2], f[3]} + acc[ai][bj][m][0] * fac, v1 = (f32x4){f[4], f[5], f[6], f[7]} + acc[ai][bj][m][1] * fac;
                    *(u32x4*)(X + off + bj * HALF) = pack8(v0, v1);
                    ss += ((v0.x * v0.x + v0.y * v0.y) + (v0.z * v0.z + v0.w * v0.w)) + ((v1.x * v1.x + v1.y * v1.y) + (v1.z * v1.z + v1.w * v1.w)); }
                ss = xrow16_sum(ss);
                if (SSQ && fq == 0) SSQ[(size_t)row * 32 + u.pn * 4 + wc] = ss; }
    }
};
struct EpiTail {
    static constexpr bool PERM = true, AFTER_DRAIN = false;
    EpiWin in;
    __device__ __forceinline__ void operator()(const f32x4 (&acc)[2][2][4][2], const Unit& u, int wr, int wc, int fr, int fq) const { const Unit t{u.pm, 16}; in(acc, t, wr, wc, fr, fq); }
};
}

#define XB_TMO      128
#define XB_XCNT(j)  (256  + 64 * (j))
#define XB_XSUB(j)  (1280 + 64 * (j))
#define XB_XGEN(j)  (2304 + 64 * (j))
#define XB_TOP      3328
#define XB_TOPGEN   3392
#define XCD_BAR_WORDS 3456
#define XB_SPIN_CAP (1u << 25)
__device__ __forceinline__ unsigned xb_ld(unsigned* p)              { return __hip_atomic_load(p, __ATOMIC_RELAXED, __HIP_MEMORY_SCOPE_AGENT); }
__device__ __forceinline__ unsigned xb_add(unsigned* p, unsigned v) { return __hip_atomic_fetch_add(p, v, __ATOMIC_RELAXED, __HIP_MEMORY_SCOPE_AGENT); }
__device__ __forceinline__ unsigned xb_xcc_id() { return (unsigned)__builtin_amdgcn_s_getreg((3 << 11) | 20) & 0xFu; }
#define XB_SPIN(cond, bar) do { unsigned _sp = 0; while (cond) { __builtin_amdgcn_s_sleep(1); \
    if ((++_sp & 255u) == 0u) { if (xb_ld(&(bar)[XB_TMO])) break; if (_sp > XB_SPIN_CAP) { atomicAdd(&(bar)[XB_TMO], 1u); break; } } } } while (0)
struct XcdBarrier { unsigned* bar; unsigned x; volatile LAS unsigned* st; };
__device__ __forceinline__ XcdBarrier xcd_barrier_post(unsigned* bar, volatile LAS unsigned* st) {
    XcdBarrier b; b.bar = bar; b.x = xb_xcc_id(); b.st = st;
    if (threadIdx.x == 0) (void)xb_add(&bar[XB_XCNT(b.x)], 1u);
    return b;
}
__device__ __forceinline__ void xcd_barrier_complete(unsigned* bar, unsigned x, unsigned& nloc, unsigned& nx) {
    const unsigned G = gridDim.x * gridDim.y * gridDim.z;
    unsigned sum, cnt, mine, sp = 0u;
    for (;;) {
        sum = 0u; cnt = 0u; mine = 0u;
#pragma unroll
        for (unsigned j = 0; j < 16; ++j) { const unsigned c = xb_ld(&bar[XB_XCNT(j)]); sum += c; cnt += (c > 0u) ? 1u : 0u; mine = (j == x) ? c : mine; }
        if (sum == G) break;
        __builtin_amdgcn_s_sleep(1);
        if ((++sp & 255u) == 0u) { if (xb_ld(&bar[XB_TMO])) break; if (sp > XB_SPIN_CAP) { atomicAdd(&bar[XB_TMO], 1u); break; } }
    }
    nloc = mine > 0u ? mine : 1u; nx = cnt > 0u ? cnt : 1u;
}
__device__ __forceinline__ void xcd_barrier(const XcdBarrier& b, bool is_t0) {
    asm volatile("s_waitcnt vmcnt(0)" ::: "memory");
    __syncthreads();
    if (is_t0) {
        unsigned* bar = b.bar;
        __builtin_amdgcn_s_waitcnt(0);
        unsigned nloc = b.st[0], nx = b.st[1];
        if (nloc == 0u) { xcd_barrier_complete(bar, b.x, nloc, nx); b.st[0] = nloc; b.st[1] = nx; }
        const unsigned old = xb_add(&bar[XB_XSUB(b.x)], 1u);
        const unsigned gen = old / nloc;
        if (old + 1u == (gen + 1u) * nloc) {
            __builtin_amdgcn_fence(__ATOMIC_RELEASE, "agent");
            asm volatile("s_waitcnt vmcnt(0)" ::: "memory");
            const unsigned og = xb_add(&bar[XB_TOP], 1u);
            const unsigned tg = og / nx;
            if (og + 1u == (tg + 1u) * nx) xb_add(&bar[XB_TOPGEN], 1u);
            else XB_SPIN(xb_ld(&bar[XB_TOPGEN]) == tg, bar);
            __builtin_amdgcn_fence(__ATOMIC_ACQUIRE, "agent");
            xb_add(&bar[XB_XGEN(b.x)], 1u);
            asm volatile("s_waitcnt vmcnt(0)" ::: "memory");
        } else {
            XB_SPIN(xb_ld(&bar[XB_XGEN(b.x)]) == gen, bar);
            __builtin_amdgcn_fence(__ATOMIC_ACQUIRE, "agent");
            asm volatile("s_waitcnt vmcnt(0)" ::: "memory");
        }
    }
    __syncthreads();
}

struct Args {
    const float* in[39]; const int* pos; float* out; unsigned char* ws; int ph_lo, ph_hi;
};
struct Frame {
    LAS unsigned char* lds; int tid, lane, wave, G, bid, gw, NGW;
    GAS unsigned char* ws;
};
#define WSP(T, off) ((T*)(F.ws + (off)))

__device__ __forceinline__ void transpose_item(const float* W, int K, int N, bf16_t* WT, int ldt, int dst_row0, const float* gain, LAS float* scr, int k0, int n0, int lane) {
    const int n4 = (lane & 7) * 4; const bool ok = n0 + n4 < N;
    f32x4 v[8];
#pragma unroll
    for (int i = 0; i < 8; ++i) { const int kk = (lane >> 3) + 8 * i; v[i] = ok ? *(const f32x4*)(W + (size_t)(k0 + kk) * N + n0 + n4) : (f32x4){0.f, 0.f, 0.f, 0.f}; }
#pragma unroll
    for (int i = 0; i < 8; ++i) { const int kk = (lane >> 3) + 8 * i; const float gg = gain ? gain[k0 + kk] : 1.f; LAS float* s = scr + kk * 33 + n4; s[0] = v[i].x * gg; s[1] = v[i].y * gg; s[2] = v[i].z * gg; s[3] = v[i].w * gg; }
    asm volatile("s_waitcnt lgkmcnt(0)" ::: "memory");
    const int c = lane & 7;
#pragma unroll
    for (int j = 0; j < 4; ++j) { const int n = (lane >> 3) + 8 * j; const LAS float* s = scr + (8 * c) * 33 + n;
        u32x4 o; o.x = cvt_pk_bf16(s[0 * 33], s[1 * 33]); o.y = cvt_pk_bf16(s[2 * 33], s[3 * 33]); o.z = cvt_pk_bf16(s[4 * 33], s[5 * 33]); o.w = cvt_pk_bf16(s[6 * 33], s[7 * 33]);
        *(u32x4*)(WT + (size_t)(dst_row0 + n) * ldt + k0 + 8 * c) = o; }
    asm volatile("s_waitcnt lgkmcnt(0)" ::: "memory");
}
__device__ __forceinline__ void transpose_matrix(Frame& F, const float* W, int K, int N, bf16_t* WT, int row_off, const float* gain, LAS float* scr) {
    const int nblk = (N + 31) / 32, items = (K / 64) * nblk;
    for (int it = F.gw; it < items; it += F.NGW) { const int kb = it / nblk, nb = it % nblk; transpose_item(W, K, N, WT, K, row_off + nb * 32, gain, scr, kb * 64, nb * 32, F.lane); }
}
__device__ __forceinline__ int win_dst_row(int n0) {
    if (n0 < 1024) return n0; if (n0 < 1088) return 4096 + (n0 - 1024); if (n0 < 2112) return 1024 + (n0 - 1088); if (n0 < 4160) return 2048 + (n0 - 2112); return 4160;
}
__device__ __forceinline__ void rowstat_row(const float* xrow, bf16_t* orow, float* rstd_out, int lane) {
    f32x4 v[8]; float s = 0.f;
#pragma unroll
    for (int j = 0; j < 8; ++j) v[j] = *(const f32x4*)(xrow + j * 256 + lane * 4);
#pragma unroll
    for (int j = 0; j < 8; ++j) s += (v[j].x * v[j].x + v[j].y * v[j].y) + (v[j].z * v[j].z + v[j].w * v[j].w);
    s = wave_sum(s, lane);
#pragma unroll
    for (int j = 0; j < 8; ++j) { u32x2 o; o.x = cvt_pk_bf16(v[j].x, v[j].y); o.y = cvt_pk_bf16(v[j].z, v[j].w); *(u32x2*)(orow + j * 256 + lane * 4) = o; }
    if (lane == 0) *rstd_out = s;
}
__device__ __forceinline__ void rowstat_phase(Frame& F, const float* X, bf16_t* XB, float* RSTD, int nrows) {
    for (int m = F.gw; m < nrows; m += F.NGW) rowstat_row(X + (size_t)m * DM, XB + (size_t)m * DM, RSTD + m, F.lane);
}

constexpr int PEER_V4_MASK = 3;
constexpr int PEER_U4_MASK = 3;
constexpr int TCONV_G = 256, TCONV_FIRST = 64, TCONV_BLOCKS = 128;
__device__ __forceinline__ void convert_table_rows(Frame& F, const Args& a, int r0, int r1, int w0, int nw) {
    if (r0 + w0 >= r1) return;
    const int l = r0 / PEER_E;
    const bool u4 = (PEER_U4_MASK >> l) & 1, v4 = (PEER_V4_MASK >> l) & 1;
    f32x4 vg[8];
    { const float* gain = a.in[6] + l * 2048;
#pragma unroll
      for (int q = 0; q < 8; ++q) vg[q] = *(const f32x4*)(gain + q * 256 + F.lane * 4); }
    f32x4 nu[8], nv[8];
#define CV_LOAD(row) do { _Pragma("unroll") for (int q = 0; q < 8; ++q) { const size_t o_ = (size_t)(row) * 2048 + q * 256 + F.lane * 4; nu[q] = *(const f32x4*)(a.in[14] + o_); nv[q] = *(const f32x4*)(a.in[15] + o_); } } while (0)
    unsigned pu[8], pv[8]; float su = 0.f, sv = 0.f; int rp = r0 + w0;
#define CV_STORE() do { const int er_ = rp % PEER_E; unsigned char* du_ = WSP(unsigned char, WS_U8) + (size_t)l * PEER_E * 2048 + (size_t)er_ * 128; unsigned char* dv_ = WSP(unsigned char, WS_V8) + (size_t)l * PEER_E * 2048 + (size_t)er_ * 128; \
        _Pragma("unroll") for (int q = 0; q < 8; ++q) { const size_t so_ = (size_t)(q * 2 + (F.lane >> 5)) * PEER_E * 128 + (F.lane & 31) * 4, s4_ = (size_t)q * PEER_E * 128 + (F.lane >> 1) * 4; \
            if (!u4) *(unsigned*)(du_ + so_) = pu[q]; else if ((F.lane & 1) == 0) *(unsigned*)(du_ + s4_) = pu[q]; \
            if (!v4) *(unsigned*)(dv_ + so_) = pv[q]; else if ((F.lane & 1) == 0) *(unsigned*)(dv_ + s4_) = pv[q]; } \
        if (F.lane == 0) { WSP(float, WS_TSC)[rp] = su; WSP(float, WS_TSC)[(size_t)2 * PEER_E + rp] = sv; } } while (0)
#define S8(x, s) (((unsigned)(int)__builtin_rintf((x) * (s))) & 0xffu)
#define T4(x, s) ((unsigned)(((int)__builtin_rintf((x) * (s)) + o8) & 0xF))
#define CV_PACK(row) do { float mu = 0.f, mv = 0.f; \
        _Pragma("unroll") for (int i = 0; i < 8; ++i) { vu[i] = vu[i] * vg[i]; \
            mu = fmaxf(fmaxf(mu, fmaxf(fabsf(vu[i].x), fabsf(vu[i].y))), fmaxf(fabsf(vu[i].z), fabsf(vu[i].w))); \
            mv = fmaxf(fmaxf(mv, fmaxf(fabsf(vv[i].x), fabsf(vv[i].y))), fmaxf(fabsf(vv[i].z), fabsf(vv[i].w))); } \
        mu = wave_max(mu); mv = wave_max(mv); \
        const float iu = mu > 0.f ? (u4 ? 7.f : 127.f) / mu : 0.f, iv = mv > 0.f ? (v4 ? 7.f : 127.f) / mv : 0.f; const int o8 = (F.lane & 1) ? 0 : 8; \
        _Pragma("unroll") for (int q = 0; q < 8; ++q) { const f32x4 x = vu[q], y = vv[q]; \
            if (!u4) pu[q] = S8(x.x, iu) | (S8(x.y, iu) << 8) | (S8(x.z, iu) << 16) | (S8(x.w, iu) << 24); \
            else { const unsigned nb = T4(x.x, iu) | (T4(x.y, iu) << 8) | (T4(x.z, iu) << 16) | (T4(x.w, iu) << 24); pu[q] = nb | ((unsigned)dppi<0xB1>((int)nb) << 4); }        \
            if (!v4) pv[q] = S8(y.x, iv) | (S8(y.y, iv) << 8) | (S8(y.z, iv) << 16) | (S8(y.w, iv) << 24); \
            else { const unsigned nb = T4(y.x, iv) | (T4(y.y, iv) << 8) | (T4(y.z, iv) << 16) | (T4(y.w, iv) << 24); pv[q] = nb | ((unsigned)dppi<0xB1>((int)nb) << 4); } } \
        su = mu * (u4 ? 1.f / 7.f : 1.f / 127.f); sv = mv * (v4 ? 1.f / 7.f : 1.f / 127.f); rp = (row); } while (0)
    CV_LOAD(r0 + w0);
    { f32x4 vu[8], vv[8];
#pragma unroll
      for (int q = 0; q < 8; ++q) { vu[q] = nu[q]; vv[q] = nv[q]; }
      { const int rn = r0 + w0 + nw < r1 ? r0 + w0 + nw : r0 + w0; CV_LOAD(rn); }
      CV_PACK(r0 + w0); }
#pragma unroll 1
    for (int r = r0 + w0 + nw; r < r1; r += nw) {
        f32x4 vu[8], vv[8];
#pragma unroll
        for (int q = 0; q < 8; ++q) { vu[q] = nu[q]; vv[q] = nv[q]; }
        CV_STORE();
        { const int rn = r + nw < r1 ? r + nw : r; CV_LOAD(rn); }
        CV_PACK(r);
    }
    CV_STORE();
#undef CV_LOAD
#undef CV_STORE
#undef CV_PACK
#undef S8
#undef T4
}
__device__ __forceinline__ void transpose_matrix_w(int w0, int nw, int lane, const float* W, int K, int N, bf16_t* WT, const float* gain, LAS float* scr) {
    const int nblk = (N + 31) / 32, items = (K / 64) * nblk;
    for (int it = w0; it < items; it += nw) { const int kb = it / nblk, nb = it % nblk; transpose_item(W, K, N, WT, K, nb * 32, gain, scr, kb * 64, nb * 32, lane); }
}
__device__ __forceinline__ void p_layer1_weights(Frame& F, const Args& a, int w0, int nw) {
    LAS float* scr = (LAS float*)(F.lds + F.wave * 16384);
    transpose_matrix_w(w0, nw, F.lane, a.in[30], 2048, 6144, WSP(bf16_t, WS_WQKV), a.in[3] + 2048, scr);
    transpose_matrix_w(w0, nw, F.lane, a.in[38], 2048, 2048, WSP(bf16_t, WS_WO), nullptr, scr);
    transpose_matrix_w(w0, nw, F.lane, a.in[7] + (size_t)2048 * 512, 2048, 512, WSP(bf16_t, WS_WMEMQ) + (size_t)512 * 2048, a.in[4] + 2048, scr);
    transpose_matrix_w(w0, nw, F.lane, a.in[11] + (size_t)512 * 2048, 512, 2048, WSP(bf16_t, WS_WMEMO) + (size_t)2048 * 512, nullptr, scr);
    transpose_matrix_w(w0, nw, F.lane, a.in[12] + (size_t)2048 * 2048, 2048, 2048, WSP(bf16_t, WS_WPEERQ) + (size_t)2048 * 2048, a.in[6] + 2048, scr);
}
__device__ __forceinline__ void p_layer0_late_weights(Frame& F, const Args& a, int w0, int nw) {
    LAS float* scr = (LAS float*)(F.lds + F.wave * 16384);
    transpose_matrix_w(w0, nw, F.lane, a.in[29], 2048, 2048, WSP(bf16_t, WS_WOUT), nullptr, scr);
    transpose_matrix_w(w0, nw, F.lane, a.in[7], 2048, 512, WSP(bf16_t, WS_WMEMQ), a.in[4], scr);
    transpose_matrix_w(w0, nw, F.lane, a.in[11], 512, 2048, WSP(bf16_t, WS_WMEMO), nullptr, scr);
    transpose_matrix_w(w0, nw, F.lane, a.in[12], 2048, 2048, WSP(bf16_t, WS_WPEERQ), a.in[6], scr);
}
__device__ __forceinline__ void p_prologue(Frame& F, const Args& a) {
    LAS float* scr = (LAS float*)(F.lds + F.wave * 16384);
    {
        const float* W = a.in[16]; const float* gain = a.in[3]; bf16_t* WT = WSP(bf16_t, WS_WIN);
        const int nblk = 131, items = 32 * nblk;
        for (int it = F.gw; it < items; it += F.NGW) { const int kb = it / nblk, nb = it % nblk; transpose_item(W, 2048, EVEN_IN, WT, 2048, win_dst_row(nb * 32), gain, scr, kb * 64, nb * 32, F.lane); }
        for (int i = F.gw * 64 + F.lane; i < (4352 - 4192) * 2048 / 8; i += F.NGW * 64) *(u32x4*)(WT + (size_t)4192 * 2048 + (size_t)i * 8) = (u32x4){0u, 0u, 0u, 0u};
    }
    transpose_matrix(F, a.in[19], 512, 1536, WSP(bf16_t, WS_WUQ), 0, a.in[17], scr);
    transpose_matrix(F, a.in[20], 512, 2048, WSP(bf16_t, WS_WUKV), 0, a.in[18], scr);
    if (F.G != TCONV_G) p_layer0_late_weights(F, a, F.gw, F.NGW);
    for (int l = 0; l < 2; ++l) transpose_matrix(F, a.in[8] + (size_t)l * 2048 * 1024, 2048, 1024, WSP(bf16_t, WS_WMEMKV) + (size_t)l * 1024 * 2048, 0, a.in[5] + l * 2048, scr);
    if (F.G != TCONV_G) p_layer1_weights(F, a, F.gw, F.NGW);
    { const float* src = a.in[13]; bf16_t* dst = WSP(bf16_t, WS_KEYS); const int n8 = 2 * 8 * 2 * 128 * 128 / 8;
      for (int i = F.gw * 64 + F.lane; i < n8; i += F.NGW * 64) *(u32x4*)(dst + (size_t)i * 8) = pack8(*(const f32x4*)(src + (size_t)i * 8), *(const f32x4*)(src + (size_t)i * 8 + 4)); }
    if (F.G != TCONV_G) { convert_table_rows(F, a, 0, PEER_E, F.gw, F.NGW); convert_table_rows(F, a, PEER_E, 2 * PEER_E, F.gw, F.NGW); }
    { f32x2* r32 = WSP(f32x2, WS_ROPE32); f32x2* r64 = WSP(f32x2, WS_ROPE64);
      for (int i = F.gw * 64 + F.lane; i < TOK * 96; i += F.NGW * 64) { const int t = i / 96, j = i % 96; const bool is32 = j < 32; const int jj = is32 ? j : j - 32; const float half = is32 ? 32.f : 64.f;
          const float inv = 1.0f / exp2f(((float)jj / half) * 13.287712379549449f);
          const float ang = (float)a.pos[t] * inv;
          double rv = (double)ang * 0.15915494309189535; rv -= __builtin_rint(rv);
          const float fr = (float)rv; const f32x2 cs = {__builtin_amdgcn_cosf(fr), __builtin_amdgcn_sinf(fr)};
          if (is32) r32[(size_t)t * 32 + jj] = cs; else r64[(size_t)t * 64 + jj] = cs; } }
    rowstat_phase(F, a.in[0], WSP(bf16_t, WS_XB), WSP(float, WS_RSTD), TOK);
    rowstat_phase(F, a.in[1], WSP(bf16_t, WS_MEMB), WSP(float, WS_RSTD_MEM), BATCH * NMEM);
}


namespace att {
__device__ __forceinline__ int crow(int r, int hi) { return (r & 3) + 8 * (r >> 2) + 4 * hi; }
template <int ND> __device__ __forceinline__ int v_st(int k, int c) { const int kk = (k & ~0xC) | ((k & 4) << 1) | ((k & 8) >> 1); return ((kk >> 3) * ND + (c >> 5)) * 512 + ((kk & 7) * 32 + (c & 31)) * 2; }
__device__ __forceinline__ int v_rd_base(int lane) { return ((lane & 3) << 3) | (((lane >> 2) & 3) << 6) | (((lane >> 4) & 1) << 5) | (((lane >> 5) & 1) << 8); }
#define ATT_TR(dst, off) asm volatile("ds_read_b64_tr_b16 %0, %1 offset:%2" : "=&v"(dst) : "v"(vb), "i"(off) : "memory")
#define ATT_PK(L, H) (bf16x8){L[0], L[1], L[2], L[3], H[0], H[1], H[2], H[3]}
template <int BASE> __device__ __forceinline__ bf16x8 att_pk4(const f32x16& P) {
    const unsigned a0 = cvt_pk_bf16(P[BASE + 0], P[BASE + 1]), a1 = cvt_pk_bf16(P[BASE + 2], P[BASE + 3]), b0 = cvt_pk_bf16(P[BASE + 4], P[BASE + 5]), b1 = cvt_pk_bf16(P[BASE + 6], P[BASE + 7]);
    auto r0 = __builtin_amdgcn_permlane32_swap(a0, b0, false, false); auto r1 = __builtin_amdgcn_permlane32_swap(a1, b1, false, false);
    const u32x4 w = {r0[0], r1[0], r0[1], r1[1]}; return __builtin_bit_cast(bf16x8, w);
}
template <int ND, int D0> __device__ __forceinline__ void sm_slice(f32x16& p1, float Cr, float mnC, float& ps1, bf16x8& pa2, bf16x8& pa3) {
    if constexpr (D0 + 1 < ND) { constexpr int R0 = D0 * 16 / (ND - 1), R1 = (D0 + 1) * 16 / (ND - 1);
#pragma unroll
        for (int r = R0; r < R1; ++r) p1[r] = __builtin_amdgcn_exp2f(fmaf(p1[r], Cr, mnC)); }
    else { ps1 = ((p1[0] + p1[1]) + (p1[2] + p1[3])) + ((p1[4] + p1[5]) + (p1[6] + p1[7])) + (((p1[8] + p1[9]) + (p1[10] + p1[11])) + ((p1[12] + p1[13]) + (p1[14] + p1[15])));
           pa2 = att_pk4<0>(p1); pa3 = att_pk4<8>(p1); }
}
template <int ND, int D0> struct PvB {
    static __device__ __forceinline__ void run(f32x16* o, int vb, bf16x8 pa2, bf16x8 pa3, s16x4& c0, s16x4& c1, s16x4& c2, s16x4& c3, s16x4& n0, s16x4& n1, s16x4& n2, s16x4& n3) {
        constexpr int KS = 2 * ND * 512, HF = ND * 512;
        if constexpr (D0 + 1 < ND) { constexpr int NB = (D0 + 1) * 512; ATT_TR(n0, NB + 2 * KS); ATT_TR(n1, NB + 2 * KS + HF); ATT_TR(n2, NB + 3 * KS); ATT_TR(n3, NB + 3 * KS + HF); asm volatile("s_waitcnt lgkmcnt(4)" ::: "memory"); }
        else asm volatile("s_waitcnt lgkmcnt(0)" ::: "memory");
        __builtin_amdgcn_sched_barrier(0);
        o[D0] = __builtin_amdgcn_mfma_f32_32x32x16_bf16(pa2, ATT_PK(c0, c1), o[D0], 0, 0, 0);
        o[D0] = __builtin_amdgcn_mfma_f32_32x32x16_bf16(pa3, ATT_PK(c2, c3), o[D0], 0, 0, 0);
        __builtin_amdgcn_sched_barrier(0);
        if constexpr (D0 + 1 < ND) PvB<ND, D0 + 1>::run(o, vb, pa2, pa3, n0, n1, n2, n3, c0, c1, c2, c3);
    }
};
template <int ND, int D0> struct PvA {
    static __device__ __forceinline__ void run(f32x16* o, int vb, bf16x8 pa0, bf16x8 pa1, bf16x8& pa2, bf16x8& pa3, f32x16& p1, float Cr, float mnC, float& ps1,
                                               s16x4& c0, s16x4& c1, s16x4& c2, s16x4& c3, s16x4& n0, s16x4& n1, s16x4& n2, s16x4& n3) {
        constexpr int KS = 2 * ND * 512, HF = ND * 512;
        if constexpr (D0 + 1 < ND) { constexpr int NB = (D0 + 1) * 512; ATT_TR(n0, NB); ATT_TR(n1, NB + HF); ATT_TR(n2, NB + KS); ATT_TR(n3, NB + KS + HF); }
        else { ATT_TR(n0, 2 * KS); ATT_TR(n1, 2 * KS + HF); ATT_TR(n2, 3 * KS); ATT_TR(n3, 3 * KS + HF); }
        asm volatile("s_waitcnt lgkmcnt(4)" ::: "memory"); __builtin_amdgcn_sched_barrier(0);
        o[D0] = __builtin_amdgcn_mfma_f32_32x32x16_bf16(pa0, ATT_PK(c0, c1), o[D0], 0, 0, 0);
        o[D0] = __builtin_amdgcn_mfma_f32_32x32x16_bf16(pa1, ATT_PK(c2, c3), o[D0], 0, 0, 0);
        __builtin_amdgcn_sched_barrier(0);
        sm_slice<ND, D0>(p1, Cr, mnC, ps1, pa2, pa3);
        __builtin_amdgcn_sched_barrier(0);
        if constexpr (D0 + 1 < ND) PvA<ND, D0 + 1>::run(o, vb, pa0, pa1, pa2, pa3, p1, Cr, mnC, ps1, n0, n1, n2, n3, c0, c1, c2, c3);
        else PvB<ND, 0>::run(o, vb, pa2, pa3, n0, n1, n2, n3, c0, c1, c2, c3);
    }
};
template <int ND> __device__ __forceinline__ void pv_all(f32x16* o, int vb, bf16x8 pa0, bf16x8 pa1, f32x16& p1, float Cr, float mnC, float& ps1) {
    constexpr int KS = 2 * ND * 512, HF = ND * 512;
    s16x4 a0, a1, a2, a3, b0, b1, b2, b3; bf16x8 pa2, pa3;
    ATT_TR(a0, 0); ATT_TR(a1, HF); ATT_TR(a2, KS); ATT_TR(a3, KS + HF);
    PvA<ND, 0>::run(o, vb, pa0, pa1, pa2, pa3, p1, Cr, mnC, ps1, a0, a1, a2, a3, b0, b1, b2, b3);
}
template <int DQK, int DV, bool CAUSAL, bool QNORM = false, int NRP = 0, bool DIFFC = false>
__device__ __forceinline__ void attn_unit(LAS unsigned char* lds, const bf16_t* __restrict__ Qb, int ldq, const bf16_t* __restrict__ Kh, int ldk, const bf16_t* __restrict__ Vh, int ldv,
                                          bf16_t* __restrict__ Ob, int ldo, int NT, int q0, float C, int tid_in, const float* __restrict__ qgain = nullptr, const f32x2* __restrict__ qrope = nullptr,
                                          const bf16_t* O1b = nullptr, bf16_t* Mb = nullptr, int ldm = 0, float dlam = 0.f, const float* __restrict__ cgain = nullptr, float cscale = 1.f) {
    constexpr int NQ = DQK / 16, ND = DV / 32, RBK = DQK * 2, SHM_K = 64 * RBK, SHM_V = 64 * DV * 2;
    constexpr int KCH = DQK / 8, VCH = DV / 8, NKS = 64 * KCH / 512, NVS = 64 * VCH / 512, OST = 128 + 8;
    int tid = tid_in; asm volatile("" : "+v"(tid));
    const int wid = tid >> 6, lane = tid & 63, r32 = lane & 31, hi = lane >> 5;
    LAS float* wsf = (LAS float*)lds + wid * 64; LAS float* li_l = wsf; LAS float* al_l = wsf + 32;
    LAS unsigned char* V_lds = lds + 2048; LAS unsigned char* K_lds = lds + 2048 + 2 * SHM_V;
    float m_reg = -1e30f, l_reg = 0.f; f32x16 o[ND]; bf16x8 qr[NQ];
#pragma unroll
    for (int d = 0; d < ND; ++d)
#pragma unroll
        for (int r = 0; r < 16; ++r) o[d][r] = 0.f;
    { const int qoff = (wid * 32 + r32) * ldq + hi * 8;
#pragma unroll
      for (int d0 = 0; d0 < NQ; ++d0) qr[d0] = *(const bf16x8*)(Qb + (qoff + d0 * 16)); }
    if constexpr (NRP > 0) {
        constexpr int D0R = (DQK - 2 * NRP) / 16, NRD = NRP / 16;
        f32x4 cs[NRD][4];
#pragma unroll
        for (int dd = 0; dd < NRD; ++dd)
#pragma unroll
            for (int e2 = 0; e2 < 4; ++e2) cs[dd][e2] = *(const f32x4*)(qrope + ((wid * 32 + r32) * NRP + dd * 16 + hi * 8 + e2 * 2));
        float ss = 0.f;
#pragma unroll
        for (int d0 = 0; d0 < NQ; ++d0) { float f[8]; unpack8(__builtin_bit_cast(u32x4, qr[d0]), f);
#pragma unroll
            for (int e = 0; e < 8; ++e) ss += f[e] * f[e]; }
        { auto rr = __builtin_amdgcn_permlane32_swap(__float_as_uint(ss), __float_as_uint(ss), false, false); ss = __uint_as_float(rr[0]) + __uint_as_float(rr[1]); }
        const float rs = 1.0f / sqrtf(ss * (1.f / DQK) + EPS);
#define ATT_QG(f, d0) do { const f32x4 g0_ = *(const f32x4*)(qgain + (d0) * 16 + hi * 8), g1_ = *(const f32x4*)(qgain + (d0) * 16 + hi * 8 + 4); \
            f[0] *= rs * g0_.x; f[1] *= rs * g0_.y; f[2] *= rs * g0_.z; f[3] *= rs * g0_.w; f[4] *= rs * g1_.x; f[5] *= rs * g1_.y; f[6] *= rs * g1_.z; f[7] *= rs * g1_.w; } while (0)
#define ATT_QP(f) __builtin_bit_cast(bf16x8, pack8((f32x4){f[0], f[1], f[2], f[3]}, (f32x4){f[4], f[5], f[6], f[7]}))
#pragma unroll
        for (int d0 = 0; d0 < D0R; ++d0) { float f[8]; unpack8(__builtin_bit_cast(u32x4, qr[d0]), f); ATT_QG(f, d0); qr[d0] = ATT_QP(f); }
#pragma unroll
        for (int dd = 0; dd < NRD; ++dd) { const int d0 = D0R + dd, d1 = d0 + NRD; float fa[8], fb[8]; unpack8(__builtin_bit_cast(u32x4, qr[d0]), fa); unpack8(__builtin_bit_cast(u32x4, qr[d1]), fb); ATT_QG(fa, d0); ATT_QG(fb, d1);
#pragma unroll
            for (int e2 = 0; e2 < 4; ++e2) { const f32x4 c = cs[dd][e2];
                const float a0 = fa[2 * e2], b0 = fb[2 * e2], a1 = fa[2 * e2 + 1], b1 = fb[2 * e2 + 1];
                fa[2 * e2] = a0 * c.x - b0 * c.y; fb[2 * e2] = b0 * c.x + a0 * c.y; fa[2 * e2 + 1] = a1 * c.z - b1 * c.w; fb[2 * e2 + 1] = b1 * c.z + a1 * c.w; }
            qr[d0] = ATT_QP(fa); qr[d1] = ATT_QP(fb); }
#undef ATT_QG
#undef ATT_QP
    }
    float Cr = C;
    if constexpr (QNORM) { float ss = 0.f;
#pragma unroll
        for (int d0 = 0; d0 < NQ; ++d0) { float f[8]; unpack8(__builtin_bit_cast(u32x4, qr[d0]), f);
#pragma unroll
            for (int e = 0; e < 8; ++e) ss += f[e] * f[e]; }
        { auto rr = __builtin_amdgcn_permlane32_swap(__float_as_uint(ss), __float_as_uint(ss), false, false); ss = __uint_as_float(rr[0]) + __uint_as_float(rr[1]); }
        Cr = C / sqrtf(ss * (1.f / DQK) + EPS); }
    const int widu = __builtin_amdgcn_readfirstlane(wid); int kgo[NKS], vgo[NVS];
#pragma unroll
    for (int i = 0; i < NKS; ++i) { const int s = (i * 8 + wid) * 64 + lane, row = s / KCH, pos = s % KCH, ch = pos ^ (row & 7); kgo[i] = row * ldk + ch * 8; }
#pragma unroll
    for (int i = 0; i < NVS; ++i) { const int s = (i * 8 + wid) * 64 + lane, sub = s >> 5, within = s & 31, kk = (sub / ND) * 8 + (within >> 2), k = (kk & ~0xC) | ((kk & 4) << 1) | ((kk & 8) >> 1), c = (sub % ND) * 32 + (within & 3) * 8; vgo[i] = k * ldv + c; }
#define ATT_DMA(b, k0) do { const bf16_t* kb_ = Kh + (size_t)(k0) * ldk; const bf16_t* vb_ = Vh + (size_t)(k0) * ldv; \
        _Pragma("unroll") for (int i = 0; i < NKS; ++i) __builtin_amdgcn_global_load_lds((const unsigned*)(kb_ + kgo[i]), (LAS unsigned*)(K_lds + (b) * SHM_K + (i * 8 + widu) * 1024), 16, 0, 0); \
        _Pragma("unroll") for (int i = 0; i < NVS; ++i) __builtin_amdgcn_global_load_lds((const unsigned*)(vb_ + vgo[i]), (LAS unsigned*)(V_lds + (b) * SHM_V + (i * 8 + widu) * 1024), 16, 0, 0); } while (0)
    const int vb0 = (int)(uintptr_t)V_lds + v_rd_base(lane);
    ATT_DMA(0, 0);
    if (widu >= 4) __builtin_amdgcn_s_setprio(1);
    for (int j = 0; j < NT; ++j) {
        asm volatile("s_waitcnt vmcnt(0)" ::: "memory");
        __syncthreads();
        if (j + 1 < NT) ATT_DMA((j + 1) & 1, (j + 1) * 64);
        if (CAUSAL && 64 * j > q0 + widu * 32 + 31) continue;
        __builtin_amdgcn_sched_barrier(0);
        f32x16 p0, p1;
#pragma unroll
        for (int r = 0; r < 16; ++r) { p0[r] = 0.f; p1[r] = 0.f; }
        { const LAS unsigned char* Ks = K_lds + (j & 1) * SHM_K;
          bf16x8 kb0 = *(const LAS bf16x8*)(Ks + r32 * RBK + ((hi * 16) ^ ((r32 & 7) << 4))), kb1 = *(const LAS bf16x8*)(Ks + (32 + r32) * RBK + ((hi * 16) ^ ((r32 & 7) << 4)));
          __builtin_amdgcn_sched_barrier(0);
#pragma unroll
          for (int d0 = 0; d0 < NQ; ++d0) { const int cb = ((d0 + 1) * 16 + hi * 8) * 2; bf16x8 nb0 = kb0, nb1 = kb1;
              if (d0 + 1 < NQ) { nb0 = *(const LAS bf16x8*)(Ks + r32 * RBK + (cb ^ ((r32 & 7) << 4))); nb1 = *(const LAS bf16x8*)(Ks + (32 + r32) * RBK + (cb ^ ((r32 & 7) << 4))); }
              p0 = __builtin_amdgcn_mfma_f32_32x32x16_bf16(kb0, qr[d0], p0, 0, 0, 0);
              p1 = __builtin_amdgcn_mfma_f32_32x32x16_bf16(kb1, qr[d0], p1, 0, 0, 0);
              __builtin_amdgcn_sched_group_barrier(0x100, 2, 0); __builtin_amdgcn_sched_group_barrier(0x008, 2, 0);
              kb0 = nb0; kb1 = nb1; } }
        if (CAUSAL) {
            if (64 * j + 63 > q0 + wid * 32) { const int lim = q0 + wid * 32 + r32 - 64 * j - 4 * hi;
#pragma unroll
                for (int r = 0; r < 16; ++r) { if ((r & 3) + 8 * (r >> 2) > lim) p0[r] = -1e30f; if ((r & 3) + 8 * (r >> 2) + 32 > lim) p1[r] = -1e30f; } } }
        __builtin_amdgcn_sched_barrier(0);
        float pmax = p0[0];
#pragma unroll
        for (int r = 1; r < 16; ++r) pmax = fmaxf(pmax, p0[r]);
#pragma unroll
        for (int r = 0; r < 16; ++r) pmax = fmaxf(pmax, p1[r]);
        { auto rr = __builtin_amdgcn_permlane32_swap(__float_as_uint(pmax), __float_as_uint(pmax), false, false); pmax = fmaxf(__uint_as_float(rr[0]), __uint_as_float(rr[1])); }
        float alpha = 1.f;
        if (!__all((pmax - m_reg) * Cr <= 11.541560327f)) { const float mn = fmaxf(m_reg, pmax); alpha = __builtin_amdgcn_exp2f((m_reg - mn) * Cr); m_reg = mn; }
        if (__any(alpha < 1.f)) { if (hi == 0) al_l[r32] = alpha; asm volatile("s_waitcnt lgkmcnt(0)" ::: "memory");
#pragma unroll
            for (int r = 0; r < 16; ++r) { const float af = al_l[crow(r, hi)];
#pragma unroll
                for (int d = 0; d < ND; ++d) o[d][r] *= af; } }
        const float mnC = -m_reg * Cr; float ps = 0.f, ps1 = 0.f;
#pragma unroll
        for (int r = 0; r < 16; ++r) { p0[r] = __builtin_amdgcn_exp2f(fmaf(p0[r], Cr, mnC)); ps += p0[r]; }
        const bf16x8 pa0 = att_pk4<0>(p0), pa1 = att_pk4<8>(p0);
        __builtin_amdgcn_sched_barrier(0);
        pv_all<ND>(o, vb0 + (j & 1) * SHM_V, pa0, pa1, p1, Cr, mnC, ps1);
        ps += ps1;
        { auto rr = __builtin_amdgcn_permlane32_swap(__float_as_uint(ps), __float_as_uint(ps), false, false); ps = __uint_as_float(rr[0]) + __uint_as_float(rr[1]); }
        l_reg = l_reg * alpha + ps;
    }
#undef ATT_DMA
    __builtin_amdgcn_s_setprio(0);
    __syncthreads();
    {
    const int lane = lane_id(), r32 = lane & 31, hi = lane >> 5, wid = widu; LAS float* li_l = (LAS float*)lds + widu * 64;
    if (hi == 0) li_l[r32] = l_reg;
    asm volatile("s_waitcnt lgkmcnt(0)" ::: "memory");
    LAS bf16_t* ost = (LAS bf16_t*)(lds + 2048) + wid * (32 * OST);
    if constexpr (DIFFC) { if (dlam != 0.f) {
        u32x4 vp[2][8]; float ss[8];
        __builtin_amdgcn_fence(__ATOMIC_ACQUIRE, "workgroup");
#pragma unroll
        for (int i = 0; i < 8; ++i) ss[i] = 0.f;
#pragma unroll
        for (int hb = 0; hb < 2; ++hb) {
#pragma unroll
            for (int r = 0; r < 16; ++r) { const int row = crow(r, hi); const float inv = __builtin_amdgcn_rcpf(li_l[row]);
#pragma unroll
                for (int d = 0; d < 4; ++d) ost[row * OST + d * 32 + r32] = f2bf(o[4 * hb + d][r] * inv); }
            asm volatile("s_waitcnt lgkmcnt(0)" ::: "memory");
            u32x4 w1[8];
#pragma unroll
            for (int i = 0; i < 8; ++i) { const int cc = lane + 64 * i, row = cc / 16, ch = cc % 16;
                w1[i] = *(const u32x4*)(O1b + ((wid * 32 + row) * ldo + hb * 128 + ch * 8)); }
#pragma unroll
            for (int i = 0; i < 8; ++i) { const int cc = lane + 64 * i, row = cc / 16, ch = cc % 16; float f1[8], f2[8];
                unpack8(w1[i], f1); unpack8(*(const LAS u32x4*)(ost + row * OST + ch * 8), f2);
#pragma unroll
                for (int e = 0; e < 8; ++e) { f1[e] -= dlam * f2[e]; ss[i] += f1[e] * f1[e]; }
                vp[hb][i] = pack8((f32x4){f1[0], f1[1], f1[2], f1[3]}, (f32x4){f1[4], f1[5], f1[6], f1[7]}); }
            asm volatile("s_waitcnt lgkmcnt(0)" ::: "memory");
        }
#pragma unroll
        for (int i = 0; i < 8; ++i) { float t = row16_sum(ss[i]); ss[i] = cscale / sqrtf(t * (1.f / 256.f) + EPS); }
#pragma unroll
        for (int hb = 0; hb < 2; ++hb)
#pragma unroll
            for (int i = 0; i < 8; ++i) { const int cc = lane + 64 * i, row = cc / 16, ch = cc % 16; float f[8]; unpack8(vp[hb][i], f);
                const f32x4 g0 = *(const f32x4*)(cgain + hb * 128 + ch * 8), g1 = *(const f32x4*)(cgain + hb * 128 + ch * 8 + 4); const float rs = ss[i];
                *(u32x4*)(Mb + ((wid * 32 + row) * ldm + hb * 128 + ch * 8)) = pack8((f32x4){f[0], f[1], f[2], f[3]} * rs * g0, (f32x4){f[4], f[5], f[6], f[7]} * rs * g1); }
        __syncthreads();
        return; } }
#pragma unroll
    for (int hb = 0; hb < ND / 4; ++hb) {
#pragma unroll
        for (int r = 0; r < 16; ++r) { const int row = crow(r, hi); const float inv = __builtin_amdgcn_rcpf(li_l[row]);
#pragma unroll
            for (int d = 0; d < 4; ++d) ost[row * OST + d * 32 + r32] = f2bf(o[4 * hb + d][r] * inv); }
        asm volatile("s_waitcnt lgkmcnt(0)" ::: "memory");
#pragma unroll
        for (int i = 0; i < 32 * 16 / 64; ++i) { const int cc = lane + 64 * i, row = cc / 16, ch = cc % 16;
            const u32x4 w = *(const LAS u32x4*)(ost + row * OST + ch * 8); const int ooff = (wid * 32 + row) * ldo + hb * 128 + ch * 8; *(u32x4*)(Ob + ooff) = w; }
        asm volatile("s_waitcnt lgkmcnt(0)" ::: "memory");
    }
    }
    __syncthreads();
}
}

__device__ __forceinline__ void p_prepA(Frame& F, const Args& a, int u0, int nu) {
    const bf16_t* XBC = WSP(bf16_t, WS_XBC); bf16_t* XC = WSP(bf16_t, WS_XBCC);
    const bf16_t* CQ = WSP(bf16_t, WS_CQ); const bf16_t* CKV = WSP(bf16_t, WS_CKV);
    float* RCQ = WSP(float, WS_RSTD_CQ); float* RCKV = WSP(float, WS_RSTD_CKV); const float* TAIL = WSP(float, WS_TAIL); float* DT = WSP(float, WS_DT);
    const float* cw = a.in[23]; const float* cb = a.in[24]; const float* dtb = a.in[25];
    const int cg = F.tid & 255, half = F.tid >> 8, c0 = cg * 8;
    float w[4][8], bs[8];
#pragma unroll
    for (int e = 0; e < 8; ++e) { bs[e] = cb[c0 + e];
#pragma unroll
        for (int j = 0; j < 4; ++j) w[j][e] = cw[j * 2048 + c0 + e]; }
    for (int u = u0; u < TOK / 64; u += nu) {
        const int t0 = u * 64 + half * 32;
        float x0[8], x1[8], x2[8], x3[8];
        if ((t0 & (SEQ - 1)) == 0) {
#pragma unroll
            for (int e = 0; e < 8; ++e) { x0[e] = 0.f; x1[e] = 0.f; x2[e] = 0.f; }
        } else {
            unpack8(*(const u32x4*)(XBC + (size_t)(t0 - 3) * 2048 + c0), x0); unpack8(*(const u32x4*)(XBC + (size_t)(t0 - 2) * 2048 + c0), x1); unpack8(*(const u32x4*)(XBC + (size_t)(t0 - 1) * 2048 + c0), x2);
        }
#pragma unroll 1
        for (int i8 = 0; i8 < 32; i8 += 16) {
            u32x4 rr[16];
#pragma unroll
            for (int q = 0; q < 16; ++q) rr[q] = *(const u32x4*)(XBC + (size_t)(t0 + i8 + q) * 2048 + c0);
#pragma unroll
            for (int q = 0; q < 16; ++q) { unpack8(rr[q], x3); float o[8];
#pragma unroll
                for (int e = 0; e < 8; ++e) { o[e] = silu_f(bs[e] + w[0][e] * x0[e] + w[1][e] * x1[e] + w[2][e] * x2[e] + w[3][e] * x3[e]); x0[e] = x1[e]; x1[e] = x2[e]; x2[e] = x3[e]; }
                u32x4 pk; pk.x = cvt_pk_bf16(o[0], o[1]); pk.y = cvt_pk_bf16(o[2], o[3]); pk.z = cvt_pk_bf16(o[4], o[5]); pk.w = cvt_pk_bf16(o[6], o[7]);
                *(u32x4*)(XC + (size_t)(t0 + i8 + q) * 2048 + c0) = pk; }
        }
        { u32x4 rq[8], rk[8];
#pragma unroll
          for (int k = 0; k < 8; ++k) { const size_t t = (size_t)u * 64 + F.wave * 8 + k; rq[k] = *(const u32x4*)(CQ + t * 512 + F.lane * 8); rk[k] = *(const u32x4*)(CKV + t * 512 + F.lane * 8); }
#pragma unroll
          for (int k = 0; k < 8; ++k) { const int t = u * 64 + F.wave * 8 + k; float f[8], g[8]; unpack8(rq[k], f); unpack8(rk[k], g); float sq = 0.f, sk = 0.f;
#pragma unroll
              for (int e = 0; e < 8; ++e) { sq += f[e] * f[e]; sk += g[e] * g[e]; }
              sq = wave_sum(sq, F.lane); sk = wave_sum(sk, F.lane);
              if (F.lane == 0) { RCQ[t] = 1.0f / sqrtf(sq * (1.f / 512.f) + EPS); RCKV[t] = 1.0f / sqrtf(sk * (1.f / 512.f) + EPS); } } }
    }
}
__device__ __forceinline__ void p_prep_late(Frame& F, const Args& a) {
    const float* TAIL = WSP(float, WS_TAIL); float* DT = WSP(float, WS_DT); const float* dtb = a.in[25];
    for (int i = F.gw * 64 + F.lane; i < TOK * 16; i += F.NGW * 64) { const int t = i >> 4, h = i & 15; const float v = TAIL[(size_t)t * 80 + 64 + h] + dtb[h];
        DT[i] = fmaxf(v, 0.f) + log1pf(expf(-fabsf(v))); }
    for (int r = F.gw; r < 2 * BATCH * NMEM; r += F.NGW) { const int l = r / (BATCH * NMEM); bf16_t* p = WSP(bf16_t, WS_MEMKV) + (size_t)r * 1024 + F.lane * 8; const float* kg = a.in[10] + l * 128 + (F.lane & 15) * 8; const float* qg = a.in[9] + l * 128 + (F.lane & 15) * 8;
        float f[8]; unpack8(*(const u32x4*)p, f); float s = 0.f;
#pragma unroll
        for (int e = 0; e < 8; ++e) s += f[e] * f[e];
        s = row16_sum(s);
        const float rs = 1.0f / sqrtf(s * (1.f / 128.f) + EPS);
        u32x4 pk; pk.x = cvt_pk_bf16(f[0] * rs * kg[0] * qg[0], f[1] * rs * kg[1] * qg[1]); pk.y = cvt_pk_bf16(f[2] * rs * kg[2] * qg[2], f[3] * rs * kg[3] * qg[3]); pk.z = cvt_pk_bf16(f[4] * rs * kg[4] * qg[4], f[5] * rs * kg[5] * qg[5]); pk.w = cvt_pk_bf16(f[6] * rs * kg[6] * qg[6], f[7] * rs * kg[7] * qg[7]);
        *(u32x4*)p = pk; }
}
__device__ __forceinline__ void p_prepB(Frame& F, const Args& a) {
    const bf16_t* KV = WSP(bf16_t, WS_KV); bf16_t* KM = WSP(bf16_t, WS_KM); const float* TAIL = WSP(float, WS_TAIL); const f32x2* R32 = WSP(f32x2, WS_ROPE32);
    const float* kg = a.in[22];
    const int g = F.lane >> 3, i = F.lane & 7;
    for (int t = F.gw; t < TOK; t += F.NGW) {
        f32x2 cs[8];
        const bf16_t* ksrc = KV + (size_t)t * 2048 + g * 256;
        const u32x4 rk0 = *(const u32x4*)(ksrc + 8 * i), rk1 = *(const u32x4*)(ksrc + 64 + 8 * i);
        const f32x4 r0 = *(const f32x4*)(TAIL + (size_t)t * 80 + 8 * i), r1 = *(const f32x4*)(TAIL + (size_t)t * 80 + 8 * i + 4);
#pragma unroll
        for (int e = 0; e < 8; ++e) cs[e] = R32[(size_t)t * 32 + 8 * (i & 3) + e];
        float v0[8], v1[8], v2[8];
        unpack8(rk0, v0); unpack8(rk1, v1);
        v2[0] = r0.x; v2[1] = r0.y; v2[2] = r0.z; v2[3] = r0.w; v2[4] = r1.x; v2[5] = r1.y; v2[6] = r1.z; v2[7] = r1.w;
        float s = 0.f;
#pragma unroll
        for (int e = 0; e < 8; ++e) s += v0[e] * v0[e] + v1[e] * v1[e] + v2[e] * v2[e];
        s = row8_sum(s);
        const float rs = 1.0f / sqrtf(s * (1.f / 192.f) + EPS);
        float o2[8];
#pragma unroll
        for (int e = 0; e < 8; ++e) { v0[e] *= rs * kg[8 * i + e]; v1[e] *= rs * kg[64 + 8 * i + e]; v2[e] *= rs * kg[128 + 8 * i + e]; }
#pragma unroll
        for (int e = 0; e < 8; ++e) { const float pv = shx(v2[e], 4, F.lane); o2[e] = (i < 4) ? v2[e] * cs[e].x - pv * cs[e].y : v2[e] * cs[e].x + pv * cs[e].y; }
        bf16_t* dst = KM + (size_t)t * 1536 + g * 192;
        u32x4 pk; pk.x = cvt_pk_bf16(v0[0], v0[1]); pk.y = cvt_pk_bf16(v0[2], v0[3]); pk.z = cvt_pk_bf16(v0[4], v0[5]); pk.w = cvt_pk_bf16(v0[6], v0[7]); *(u32x4*)(dst + 8 * i) = pk;
        pk.x = cvt_pk_bf16(v1[0], v1[1]); pk.y = cvt_pk_bf16(v1[2], v1[3]); pk.z = cvt_pk_bf16(v1[4], v1[5]); pk.w = cvt_pk_bf16(v1[6], v1[7]); *(u32x4*)(dst + 64 + 8 * i) = pk;
        pk.x = cvt_pk_bf16(o2[0], o2[1]); pk.y = cvt_pk_bf16(o2[2], o2[3]); pk.z = cvt_pk_bf16(o2[4], o2[5]); pk.w = cvt_pk_bf16(o2[6], o2[7]); *(u32x4*)(dst + 128 + 8 * i) = pk;
    }
}
__device__ __forceinline__ bf16x8 tr_frag(int a0, int a1) {
    s16x4 lo, hi2; asm volatile("ds_read_b64_tr_b16 %0, %2\n\tds_read_b64_tr_b16 %1, %3\n\ts_waitcnt lgkmcnt(0)" : "=&v"(lo), "=&v"(hi2) : "v"(a0), "v"(a1) : "memory");
    return (bf16x8){lo[0], lo[1], lo[2], lo[3], hi2[0], hi2[1], hi2[2], hi2[3]};
}
__device__ __forceinline__ void ssd_item(Frame& F, const Args& a, int it) {
    const bf16_t* XC = WSP(bf16_t, WS_XBCC); const float* DT = WSP(float, WS_DT); const bf16_t* Z = WSP(bf16_t, WS_Z); bf16_t* YG = WSP(bf16_t, WS_YG);
    constexpr int SBN = 272, SXD = 144;
    constexpr int O_BN = 0, O_CN = 17408, O_XD = 34816, O_HB = 44032, O_ACS = 61440, O_YO = 61952, O_XR = 78336, O_ZR = 78336 + 2 * 9216, NCH = SEQ / 64;
    int tid = F.tid; asm volatile("" : "+v"(tid));
    const int lane = tid & 63, wave = tid >> 6, r32 = lane & 31, hi = lane >> 5, gq = lane >> 4, li = lane & 15;
    const int h = it & 15, b = it >> 4, g = h >> 2;
    const float a_h = -expf(a.in[26][h]), dskip = a.in[27][h];
    LAS unsigned char* L = F.lds; const int Lb = (int)(uintptr_t)L;
    const int sl = tid >> 4, sc = tid & 15, xl = tid >> 3, xc = tid & 7;
    for (int i = tid; i < 64 * SBN / 4; i += NTHREADS) *(LAS unsigned*)(L + O_HB + i * 4) = 0u;
    f32x16 HT;
#pragma unroll
    for (int r = 0; r < 16; ++r) HT[r] = 0.f;
    u32x4 rb0, rb1, rc0, rc1, rx, rz; float rdt, rdtx;
#define SSD_LOAD(c) do { const size_t t0_ = (size_t)b * SEQ + (size_t)(c) * 64; \
        rb0 = *(const u32x4*)(XC + (t0_ + sl) * 2048 + 1024 + g * 128 + sc * 8); rb1 = *(const u32x4*)(XC + (t0_ + 32 + sl) * 2048 + 1024 + g * 128 + sc * 8); \
        rc0 = *(const u32x4*)(XC + (t0_ + sl) * 2048 + 1536 + g * 128 + sc * 8); rc1 = *(const u32x4*)(XC + (t0_ + 32 + sl) * 2048 + 1536 + g * 128 + sc * 8); \
        rx = *(const u32x4*)(XC + (t0_ + xl) * 2048 + h * 64 + xc * 8); rz = *(const u32x4*)(Z + (t0_ + xl) * 1024 + h * 64 + xc * 8); rdtx = DT[(t0_ + xl) * 16 + h]; rdt = DT[(t0_ + lane) * 16 + h]; } while (0)
    SSD_LOAD(0);
    f32x16 yd; float dAtot = 1.f; f32x16 ST;
#pragma unroll
    for (int r = 0; r < 16; ++r) { yd[r] = 0.f; ST[r] = 0.f; }
    const int trB = (li >> 2) * SBN + (16 * (gq & 1) + 4 * (li & 3)) * 2, trX = (li >> 2) * SXD + (16 * (gq & 1) + 4 * (li & 3)) * 2;
    for (int c = 0; c <= NCH; ++c) {
        if (c > 0) {
            if (wave < 4) { const int lb = wave & 1, pb = wave >> 1; const size_t t0_ = (size_t)b * SEQ + (size_t)(c - 1) * 64;
#pragma unroll
                for (int r = 0; r < 16; ++r) { const int l = 32 * lb + att::crow(r, hi), p = 32 * pb + r32; const size_t tr = t0_ + l;
                    const float yv = yd[r] + *(const LAS float*)(L + O_YO + (l * 64 + p) * 4);
                    const bf16_t xv = *(const LAS bf16_t*)(L + O_XR + ((c - 1) & 1) * 9216 + l * SXD + p * 2), zv = *(const LAS bf16_t*)(L + O_ZR + ((c - 1) & 1) * 9216 + l * SXD + p * 2);
                    YG[tr * 1024 + h * 64 + p] = f2bf((yv + dskip * bf2f(xv)) * silu_f(bf2f(zv))); } }
            const int nb = wave & 3, ph = wave >> 2;
#pragma unroll
            for (int r = 0; r < 16; ++r) HT[r] = HT[r] * dAtot + ST[r];
#pragma unroll
            for (int q = 0; q < 4; ++q) { u32x2 w; w.x = cvt_pk_bf16(HT[4 * q], HT[4 * q + 1]); w.y = cvt_pk_bf16(HT[4 * q + 2], HT[4 * q + 3]);
                *(LAS u32x2*)(L + O_HB + (32 * ph + r32) * SBN + (32 * nb + 8 * q + 4 * hi) * 2) = w; }
        }
        if (c == NCH) break;
        { *(LAS u32x4*)(L + O_BN + sl * SBN + sc * 16) = rb0; *(LAS u32x4*)(L + O_BN + (32 + sl) * SBN + sc * 16) = rb1;
          *(LAS u32x4*)(L + O_CN + sl * SBN + sc * 16) = rc0; *(LAS u32x4*)(L + O_CN + (32 + sl) * SBN + sc * 16) = rc1;
          float fx[8]; unpack8(rx, fx); u32x4 xw; xw.x = cvt_pk_bf16(fx[0] * rdtx, fx[1] * rdtx); xw.y = cvt_pk_bf16(fx[2] * rdtx, fx[3] * rdtx); xw.z = cvt_pk_bf16(fx[4] * rdtx, fx[5] * rdtx); xw.w = cvt_pk_bf16(fx[6] * rdtx, fx[7] * rdtx);
          *(LAS u32x4*)(L + O_XD + xl * SXD + xc * 16) = xw;
          *(LAS u32x4*)(L + O_XR + (c & 1) * 9216 + xl * SXD + xc * 16) = rx; *(LAS u32x4*)(L + O_ZR + (c & 1) * 9216 + xl * SXD + xc * 16) = rz;
          if (wave == 0) { float v = rdt * a_h;
              v += __int_as_float(__builtin_amdgcn_update_dpp(0, __float_as_int(v), 0x111, 0xf, 0xf, false)); v += __int_as_float(__builtin_amdgcn_update_dpp(0, __float_as_int(v), 0x112, 0xf, 0xf, false));
              v += __int_as_float(__builtin_amdgcn_update_dpp(0, __float_as_int(v), 0x114, 0xf, 0xf, false)); v += __int_as_float(__builtin_amdgcn_update_dpp(0, __float_as_int(v), 0x118, 0xf, 0xf, false));
              v += __int_as_float(__builtin_amdgcn_update_dpp(0, __float_as_int(v), 0x142, 0xa, 0xf, false)); v += __int_as_float(__builtin_amdgcn_update_dpp(0, __float_as_int(v), 0x143, 0xc, 0xf, false));
              *(LAS float*)(L + O_ACS + lane * 4) = v; } }
        __syncthreads();
        if (c + 1 < NCH) SSD_LOAD(c + 1);
        dAtot = fast_exp(*(const LAS float*)(L + O_ACS + 63 * 4));
        if (wave < 4) {
            const int lb = wave & 1, pb = wave >> 1;
#pragma unroll
            for (int r = 0; r < 16; ++r) yd[r] = 0.f;
            const float acl = *(const LAS float*)(L + O_ACS + (32 * lb + r32) * 4);
#pragma unroll
            for (int sb = 0; sb < 2; ++sb) { if (sb <= lb) {
                f32x16 X;
#pragma unroll
                for (int r = 0; r < 16; ++r) X[r] = 0.f;
#pragma unroll
                for (int ks = 0; ks < 8; ++ks) { const bf16x8 af = *(const LAS bf16x8*)(L + O_BN + (32 * sb + r32) * SBN + (16 * ks + 8 * hi) * 2), bfr = *(const LAS bf16x8*)(L + O_CN + (32 * lb + r32) * SBN + (16 * ks + 8 * hi) * 2);
                    X = __builtin_amdgcn_mfma_f32_32x32x16_bf16(af, bfr, X, 0, 0, 0); }
#pragma unroll
                for (int q = 0; q < 4; ++q) { const f32x4 as = *(const LAS f32x4*)(L + O_ACS + (32 * sb + 8 * q + 4 * hi) * 4);
#pragma unroll
                    for (int e = 0; e < 4; ++e) { const int r = 4 * q + e; float gv = X[r] * fast_exp(acl - as[e]); if (sb == lb && (8 * q + 4 * hi + e) > r32) gv = 0.f; X[r] = gv; } }
#pragma unroll
                for (int k2 = 0; k2 < 2; ++k2) { u32x4 aw; aw.x = cvt_pk_bf16(X[8 * k2], X[8 * k2 + 1]); aw.y = cvt_pk_bf16(X[8 * k2 + 2], X[8 * k2 + 3]); aw.z = cvt_pk_bf16(X[8 * k2 + 4], X[8 * k2 + 5]); aw.w = cvt_pk_bf16(X[8 * k2 + 6], X[8 * k2 + 7]);
                    const int xa = Lb + O_XD + (32 * sb + 16 * k2 + 4 * hi) * SXD + (32 * pb) * 2 + trX;
                    const bf16x8 bw = tr_frag(xa, xa + 8 * SXD);
                    yd = __builtin_amdgcn_mfma_f32_32x32x16_bf16(__builtin_bit_cast(bf16x8, aw), bw, yd, 0, 0, 0); } } }
        } else {
            const int lb = wave & 1, pb = (wave >> 1) & 1; f32x16 Y;
#pragma unroll
            for (int r = 0; r < 16; ++r) Y[r] = 0.f;
#pragma unroll
            for (int ks = 0; ks < 8; ++ks) { const bf16x8 af = *(const LAS bf16x8*)(L + O_CN + (32 * lb + r32) * SBN + (16 * ks + 8 * hi) * 2), bfr = *(const LAS bf16x8*)(L + O_HB + (32 * pb + r32) * SBN + (16 * ks + 8 * hi) * 2);
                Y = __builtin_amdgcn_mfma_f32_32x32x16_bf16(af, bfr, Y, 0, 0, 0); }
#pragma unroll
            for (int q = 0; q < 4; ++q) { const f32x4 al = *(const LAS f32x4*)(L + O_ACS + (32 * lb + 8 * q + 4 * hi) * 4);
#pragma unroll
                for (int e = 0; e < 4; ++e) *(LAS float*)(L + O_YO + ((32 * lb + 8 * q + 4 * hi + e) * 64 + 32 * pb + r32) * 4) = Y[4 * q + e] * fast_exp(al[e]); }
        }
        { const int nb = wave & 3, ph = wave >> 2; const float ac63 = *(const LAS float*)(L + O_ACS + 63 * 4);
#pragma unroll
          for (int r = 0; r < 16; ++r) ST[r] = 0.f;
#pragma unroll
          for (int ks = 0; ks < 4; ++ks) { const int l0 = 16 * ks + 8 * hi;
              const int ba = Lb + O_BN + l0 * SBN + (32 * nb) * 2 + trB; const bf16x8 af = tr_frag(ba, ba + 4 * SBN);
              const int xa = Lb + O_XD + l0 * SXD + (32 * ph) * 2 + trX; const bf16x8 xf = tr_frag(xa, xa + 4 * SXD);
              float fx[8]; unpack8(__builtin_bit_cast(u32x4, xf), fx);
              const f32x4 a0 = *(const LAS f32x4*)(L + O_ACS + l0 * 4), a1 = *(const LAS f32x4*)(L + O_ACS + (l0 + 4) * 4);
              u32x4 bw; bw.x = cvt_pk_bf16(fx[0] * fast_exp(ac63 - a0.x), fx[1] * fast_exp(ac63 - a0.y)); bw.y = cvt_pk_bf16(fx[2] * fast_exp(ac63 - a0.z), fx[3] * fast_exp(ac63 - a0.w));
              bw.z = cvt_pk_bf16(fx[4] * fast_exp(ac63 - a1.x), fx[5] * fast_exp(ac63 - a1.y)); bw.w = cvt_pk_bf16(fx[6] * fast_exp(ac63 - a1.z), fx[7] * fast_exp(ac63 - a1.w));
              ST = __builtin_amdgcn_mfma_f32_32x32x16_bf16(af, __builtin_bit_cast(bf16x8, bw), ST, 0, 0, 0); } }
        __syncthreads();
    }
    __syncthreads();
#undef SSD_LOAD
}
__device__ __forceinline__ void p_mla_ssd(Frame& F, const Args& a, unsigned* qctr, volatile LAS int* slot) {
    for (int it = F.bid; it < 64; it += F.G) ssd_item(F, a, it);
    if (F.G == TCONV_G && F.bid >= TCONV_FIRST && F.bid < TCONV_FIRST + TCONV_BLOCKS) { constexpr int RPB = (PEER_E + TCONV_BLOCKS - 1) / TCONV_BLOCKS; const int cb = F.bid - TCONV_FIRST;
        __syncthreads();
        p_layer0_late_weights(F, a, cb * 8 + F.wave, TCONV_BLOCKS * 8);
        p_layer1_weights(F, a, cb * 8 + F.wave, TCONV_BLOCKS * 8);
#pragma unroll 1
        for (int l = 0; l < 2; ++l) { const int rb = l * PEER_E + cb * RPB, re = rb + RPB < (l + 1) * PEER_E ? rb + RPB : (l + 1) * PEER_E; convert_table_rows(F, a, rb, re, F.wave, 8); }
        __syncthreads(); }
    const bf16_t* QM = WSP(bf16_t, WS_QM); const bf16_t* KM = WSP(bf16_t, WS_KM); const bf16_t* KV = WSP(bf16_t, WS_KV); bf16_t* MIX = WSP(bf16_t, WS_MIX);
    const float scale = 0.07216878364870322f;
#pragma unroll 1
    for (;;) {
        __syncthreads();
        if (F.tid == 0) *slot = (int)__hip_atomic_fetch_add(qctr, 1u, __ATOMIC_RELAXED, __HIP_MEMORY_SCOPE_AGENT);
        __syncthreads();
        const int idx = *slot;
        if (idx >= 512) break;
        const int qb = 15 - (idx >> 5), bh = idx & 31, b = bh >> 3, h = bh & 7, q0 = qb * 256; const size_t row0 = (size_t)b * SEQ + q0, kr0 = (size_t)b * SEQ;
        att::attn_unit<192, 128, true, false, 32>(F.lds, QM + row0 * 1536 + h * 192, 1536, KM + kr0 * 1536 + h * 192, 1536, KV + kr0 * 2048 + h * 256 + 128, 2048, MIX + row0 * 2048 + h * 128, 2048,
                                       4 * (qb + 1), q0, scale * 1.4426950408889634f, F.tid, a.in[21], WSP(f32x2, WS_ROPE32) + row0 * 32);
    }
}
__device__ __forceinline__ void p_ssd_norm(Frame& F, const Args& a) {
    const bf16_t* YG = WSP(bf16_t, WS_YG); bf16_t* MIX = WSP(bf16_t, WS_MIX); const float* gn = a.in[28] + F.lane * 8;
    for (int t = F.gw; t < TOK; t += F.NGW) { const bf16_t* p = YG + (size_t)t * 1024 + F.lane * 8;
        const u32x4 w0 = *(const u32x4*)p, w1 = *(const u32x4*)(p + 512); float f0[8], f1[8]; unpack8(w0, f0); unpack8(w1, f1); float s0 = 0.f, s1 = 0.f;
#pragma unroll
        for (int e = 0; e < 8; ++e) { s0 += f0[e] * f0[e]; s1 += f1[e] * f1[e]; }
        s0 = half_sum(s0); s1 = half_sum(s1);
        const float r0 = 1.0f / sqrtf(s0 * (1.f / 256.f) + EPS), r1 = 1.0f / sqrtf(s1 * (1.f / 256.f) + EPS);
        const f32x4 g00 = *(const f32x4*)gn, g01 = *(const f32x4*)(gn + 4), g10 = *(const f32x4*)(gn + 512), g11 = *(const f32x4*)(gn + 516);
        bf16_t* d = MIX + (size_t)t * 2048 + 1024 + F.lane * 8;
        *(u32x4*)d = pack8((f32x4){f0[0], f0[1], f0[2], f0[3]} * r0 * g00, (f32x4){f0[4], f0[5], f0[6], f0[7]} * r0 * g01);
        *(u32x4*)(d + 512) = pack8((f32x4){f1[0], f1[1], f1[2], f1[3]} * r1 * g10, (f32x4){f1[4], f1[5], f1[6], f1[7]} * r1 * g11); }
}
__device__ __forceinline__ void p_attn_mem(Frame& F, int layer) {
    const bf16_t* MQ = WSP(bf16_t, WS_MEMQ); const bf16_t* MKV = WSP(bf16_t, WS_MEMKV) + (size_t)layer * 1024 * 1024; bf16_t* MO = WSP(bf16_t, WS_MEMO);
    const float scale = 0.08838834764831845f;
    for (int it = F.bid; it < 256; it += F.G) { const int h = it & 3, qb = (it >> 2) & 15, b = it >> 6; const size_t row0 = (size_t)b * SEQ + qb * 256;
        att::attn_unit<128, 128, false, true>(F.lds, MQ + row0 * 512 + h * 128, 512, MKV + (size_t)b * 256 * 1024 + h * 128, 1024, MKV + (size_t)b * 256 * 1024 + 512 + h * 128, 1024, MO + row0 * 512 + h * 128, 512,
                                              4, 0, scale * 1.4426950408889634f, F.tid); }
}
__device__ __forceinline__ unsigned ordf(float x) { const unsigned u = __float_as_uint(x); return u ^ ((unsigned)((int)u >> 31) | 0x80000000u); }
__device__ __forceinline__ float unordf(unsigned k) { return __uint_as_float((k & 0x80000000u) ? (k ^ 0x80000000u) : ~k); }
#define TK_CS(a, b) do { const unsigned hi_ = (a) > (b) ? (a) : (b); const unsigned lo_ = (a) > (b) ? (b) : (a); (a) = hi_; (b) = lo_; } while (0)
__device__ __forceinline__ void tk_sort16(unsigned (&a)[16]) {
#pragma unroll
    for (int k = 2; k <= 16; k <<= 1)
#pragma unroll
        for (int j = k >> 1; j > 0; j >>= 1)
#pragma unroll
            for (int i = 0; i < 16; ++i) { const int l = i ^ j; if (l > i) { if ((i & k) == 0) TK_CS(a[i], a[l]); else TK_CS(a[l], a[i]); } }
}
__device__ __forceinline__ void tk_merge16(unsigned (&L)[16], const unsigned (&B)[16]) {
#pragma unroll
    for (int i = 0; i < 16; ++i) L[i] = L[i] > B[15 - i] ? L[i] : B[15 - i];
#pragma unroll
    for (int j = 8; j > 0; j >>= 1)
#pragma unroll
        for (int i = 0; i < 16; ++i) { const int l = i ^ j; if (l > i) TK_CS(L[i], L[l]); }
}
__device__ __forceinline__ void p_peer_topk(Frame& F, int layer, int tb, int te, int w0, int nw, int stag) {
    const bf16_t* PQ = WSP(bf16_t, WS_PQ); const bf16_t* KEYS = WSP(bf16_t, WS_KEYS) + (size_t)layer * 8 * 2 * 128 * 128; int* EXPo = WSP(int, WS_EXP); float* GATEo = WSP(float, WS_GATE);
    LAS float* sc = (LAS float*)(F.lds + F.wave * 16384);
    const bool u4 = (PEER_U4_MASK >> layer) & 1;
#pragma unroll 1
    for (int pass = 0; pass < 2; ++pass) {
    if ((pass ^ stag) == 0) {
    for (int t = tb + w0; t < te; t += nw) { const int lane = F.lane; const bf16_t* xrow = WSP(bf16_t, WS_XB) + (size_t)t * 2048; float f[32]; float mx = 0.f; int xsum = 0;
#pragma unroll
        for (int c = 0; c < 2; ++c) { float g8[8]; unpack8(*(const u32x4*)(xrow + (c * 1024 + lane * 16)), g8);
#pragma unroll
            for (int j = 0; j < 8; ++j) f[c * 16 + j] = g8[j];
            unpack8(*(const u32x4*)(xrow + (c * 1024 + lane * 16 + 8)), g8);
#pragma unroll
            for (int j = 0; j < 8; ++j) f[c * 16 + 8 + j] = g8[j]; }
#pragma unroll
        for (int j = 0; j < 32; ++j) mx = fmaxf(mx, fabsf(f[j]));
        mx = wave_max(mx);
        const float inv = mx > 0.f ? 127.f / mx : 0.f;
#pragma unroll
        for (int c = 0; c < 2; ++c) { u32x4 w; unsigned* wp = (unsigned*)&w;
#pragma unroll
            for (int q = 0; q < 4; ++q) { unsigned v = 0u;
#pragma unroll
                for (int e = 0; e < 4; ++e) v |= (((unsigned)(int)__builtin_rintf(f[c * 16 + q * 4 + e] * inv)) & 0xffu) << (8 * e);
                wp[q] = v; }
            if (!u4) *(u32x4*)(WSP(unsigned char, WS_XQ) + ((size_t)(c * 8 + (lane >> 3)) * TOK + t) * 128 + (lane & 7) * 16) = w;
            else *(u32x4*)(WSP(unsigned char, WS_XQ) + ((size_t)(c * 4 + (lane >> 4)) * TOK + t) * 256 + (lane & 15) * 16) = w;
#pragma unroll
            for (int q = 0; q < 4; q += 2) xsum = __builtin_amdgcn_sdot4((int)wp[q], 0x01010101, xsum, false); }
        if (u4) {
            xsum = wave_sum_i(xsum);
            if (lane == 0) WSP(int, WS_SX)[t] = xsum; }
        const float ssq = wave_sum(lane < 32 ? WSP(float, WS_SSQ2)[(size_t)t * 32 + lane] : 0.f, lane);
        if (lane == 0) WSP(float, WS_XS)[t] = mx * (1.f / 127.f) / sqrtf(ssq * (1.f / 2048.f) + EPS); }
    } else {
    for (int it = (tb / 32) * 8 + w0; it < (te / 32) * 8; it += nw) {
        int lane = lane_id(); asm volatile("" : "+v"(lane));
        const int r32 = lane & 31, hi = lane >> 5, h = it & 7, t0 = (it >> 3) * 32;
        unsigned KF[2][16];
#pragma unroll 1
        for (int p = 0; p < 2; ++p) {
            const bf16_t* qp = PQ + (size_t)(t0) * 2048 + h * 256 + p * 128; const int qo = r32 * 2048 + hi * 8; bf16x8 qf[8], af[8], an[8];
#pragma unroll
            for (int k = 0; k < 8; ++k) qf[k] = *(const bf16x8*)(qp + (qo + k * 16));
            const bf16_t* kp = KEYS + (size_t)(h * 2 + p) * 128 * 128; const int ko = r32 * 128 + hi * 8;
#pragma unroll
            for (int k = 0; k < 8; ++k) af[k] = *(const bf16x8*)(kp + (ko + k * 16));
            unsigned L[16];
#pragma unroll
            for (int i = 0; i < 16; ++i) L[i] = 0u;
#pragma unroll 1
            for (int nb = 0; nb < 4; ++nb) { f32x16 acc;
#pragma unroll
                for (int r = 0; r < 16; ++r) acc[r] = 0.f;
#pragma unroll
                for (int k = 0; k < 8; ++k) acc = __builtin_amdgcn_mfma_f32_32x32x16_bf16(af[k], qf[k], acc, 0, 0, 0);
                if (nb < 3) {
#pragma unroll
                    for (int k = 0; k < 8; ++k) an[k] = *(const bf16x8*)(kp + ((nb + 1) * 32 * 128 + ko + k * 16)); }
                const int nbase = 127 - (nb * 32 + 4 * hi); unsigned Bk[16];
#pragma unroll
                for (int r = 0; r < 16; ++r) Bk[r] = (ordf(acc[r]) & 0xFFFFFF80u) | (unsigned)(nbase - ((r & 3) + 8 * (r >> 2)));
                tk_sort16(Bk); tk_merge16(L, Bk);
#pragma unroll
                for (int k = 0; k < 8; ++k) af[k] = an[k];
            }
            unsigned P[16];
#pragma unroll
            for (int i = 0; i < 16; ++i) { auto sw_ = __builtin_amdgcn_permlane32_swap(L[i], L[i], false, false); P[i] = hi ? sw_[0] : sw_[1]; }
            tk_merge16(L, P);
            if (p == 0) {
#pragma unroll
                for (int i = 0; i < 16; ++i) KF[0][i] = L[i];
            } else {
#pragma unroll
                for (int i = 0; i < 16; ++i) KF[1][i] = L[i]; }
        }
        float s0[16], s1[16];
#pragma unroll
        for (int i = 0; i < 16; ++i) { s0[i] = unordf(KF[0][i] & 0xFFFFFF80u); s1[i] = unordf(KF[1][i] & 0xFFFFFF80u);
            sc[i * 64 + lane] = __int_as_float(127 - (int)(KF[0][i] & 127u)); sc[(16 + i) * 64 + lane] = __int_as_float(127 - (int)(KF[1][i] & 127u)); }
        unsigned Cn[16], Cb[16];
#define TK_CAND(i, j) ((ordf(s0[i] + s1[j]) & 0xFFFFFF00u) | (unsigned)(255 - ((i) * 16 + (j))))
        { int c = 0;
#pragma unroll
          for (int i = 0; i < 16; ++i)
#pragma unroll
              for (int j = 0; j < 16; ++j) if ((i + 1) * (j + 1) <= 16) { if (c < 16) Cn[c] = TK_CAND(i, j); ++c; } }
        tk_sort16(Cn);
#pragma unroll
        for (int grp = 1; grp < 4; ++grp) { int c = 0;
#pragma unroll
            for (int q = 0; q < 16; ++q) Cb[q] = 0u;
#pragma unroll
            for (int i = 0; i < 16; ++i)
#pragma unroll
                for (int j = 0; j < 16; ++j) if ((i + 1) * (j + 1) <= 16) { if (c >= grp * 16 && c < grp * 16 + 16) Cb[c - grp * 16] = TK_CAND(i, j); ++c; }
            tk_sort16(Cb); tk_merge16(Cn, Cb); }
#undef TK_CAND
        float bs[16]; int ex[16]; float mx = unordf(Cn[0] & 0xFFFFFF00u), sum = 0.f;
#pragma unroll
        for (int k = 0; k < 16; ++k) { const int c = 255 - (int)(Cn[k] & 255u); const int n0 = __float_as_int(sc[(c >> 4) * 64 + lane]), n1 = __float_as_int(sc[(16 + (c & 15)) * 64 + lane]);
            ex[k] = n0 * 128 + n1; bs[k] = fast_exp(unordf(Cn[k] & 0xFFFFFF00u) - mx); sum += bs[k]; }
        const float inv = 1.0f / sum;
        if (hi == 0) { int* ep = EXPo + (size_t)(t0 + r32) * 128 + h * 16; float* gp = GATEo + (size_t)(t0 + r32) * 128 + h * 16;
#pragma unroll
            for (int k = 0; k < 16; k += 4) { *(int4*)(ep + k) = make_int4(ex[k], ex[k + 1], ex[k + 2], ex[k + 3]); *(f32x4*)(gp + k) = (f32x4){bs[k] * inv, bs[k + 1] * inv, bs[k + 2] * inv, bs[k + 3] * inv}; } }
    }
    } }
}
#define UB0(x) ((float)((x) & 0xffu))
#define UB1(x) ((float)(((x) >> 8) & 0xffu))
#define UB2(x) ((float)(((x) >> 16) & 0xffu))
#define UB3(x) ((float)((x) >> 24))
template <bool U4> __device__ __forceinline__ void p_peer_u(Frame& F, int layer, unsigned* qbase, int chunk0, int nchunk) {
    const unsigned char* U8 = WSP(unsigned char, WS_U8) + (size_t)layer * PEER_E * 2048; const unsigned char* XQ = WSP(unsigned char, WS_XQ); const int* EXPi = WSP(int, WS_EXP); short* PD = WSP(short, WS_PD);
    const int xcc = (int)xb_xcc_id();
#pragma unroll 1
    for (int ri = 0; ri < (U4 ? 8 : 16); ++ri) {
        const int sl = U4 ? ((xcc + ri) & 7) : ((xcc + 8 * (ri & 1) + (ri >> 1)) & 15);
        const unsigned char* Us = U8 + (size_t)sl * PEER_E * 128; const unsigned char* Xs = XQ + (size_t)sl * TOK * (U4 ? 256 : 128); short* PDs = PD + (size_t)sl * TOK * 128;
#pragma unroll 1
        for (;;) {
            int lane = lane_id(); asm volatile("" : "+v"(lane));
            int chunk = 0; if (lane == 0) chunk = (int)__hip_atomic_fetch_add(qbase + sl * 64, 1u, __ATOMIC_RELAXED, __HIP_MEMORY_SCOPE_AGENT);
            chunk = __builtin_amdgcn_readfirstlane(chunk);
            if (chunk >= nchunk) break;
            chunk += chunk0;
            const int r = lane >> 3, c = lane & 7; const bool c4 = c & 4, c2 = c & 2, c1 = c & 1;
            u32x4 en[4]; u32x4 xn, xn2 = {0u, 0u, 0u, 0u};
#define U_EXP(dst, tok) do { const int* ep_ = EXPi + (tok) * 128 + 8 * r; dst[0] = *(const u32x4*)ep_; dst[1] = *(const u32x4*)(ep_ + 4); dst[2] = *(const u32x4*)(ep_ + 64); dst[3] = *(const u32x4*)(ep_ + 68); } while (0)
            { const size_t t_ = (size_t)chunk * 32; U_EXP(en, t_); if constexpr (U4) { xn = *(const u32x4*)(Xs + (t_ * 256 + c * 32)); xn2 = *(const u32x4*)(Xs + (t_ * 256 + c * 32 + 16)); } else xn = *(const u32x4*)(Xs + (t_ * 128 + c * 16)); }
#pragma unroll 1
            for (int ti = 0; ti < 32; ++ti) {
                const size_t t = (size_t)chunk * 32 + ti; const u32x4 e0 = en[0], e1 = en[1], e2 = en[2], e3 = en[3]; const u32x4 xv = xn, xv2 = xn2; (void)xv2;
                if (ti + 1 < 32) { U_EXP(en, t + 1); if constexpr (U4) { xn = *(const u32x4*)(Xs + ((t + 1) * 256 + c * 32)); xn2 = *(const u32x4*)(Xs + ((t + 1) * 256 + c * 32 + 16)); } else xn = *(const u32x4*)(Xs + ((t + 1) * 128 + c * 16)); }
                u32x4 R[16];
#pragma unroll
                for (int g = 0; g < 16; ++g) { const u32x4 ev = g < 4 ? e0 : (g < 8 ? e1 : (g < 12 ? e2 : e3)); const int ek = (int)ev[g & 3]; R[g] = *(const u32x4*)(Us + (ek * 128 + c * 16)); }
                int part[16];
#pragma unroll
                for (int g = 0; g < 16; ++g) {
                    if constexpr (U4) { int d = 0, dh = 0;
#define U4_DW(w, xa, xb) d = __builtin_amdgcn_sdot4((int)((w) & 0x0F0F0F0Fu), (int)(xa), d, false); dh = __builtin_amdgcn_sdot4((int)((w) & 0xF0F0F0F0u), (int)(xb), dh, false)
                        U4_DW(R[g].x, xv.x, xv.y); U4_DW(R[g].y, xv.z, xv.w); U4_DW(R[g].z, xv2.x, xv2.y); U4_DW(R[g].w, xv2.z, xv2.w);
#undef U4_DW
                        part[g] = d + (dh >> 4); }
                    else { int d = __builtin_amdgcn_sdot4((int)R[g].x, (int)xv.x, 0, false); d = __builtin_amdgcn_sdot4((int)R[g].y, (int)xv.y, d, false);
                        d = __builtin_amdgcn_sdot4((int)R[g].z, (int)xv.z, d, false); part[g] = __builtin_amdgcn_sdot4((int)R[g].w, (int)xv.w, d, false); } }
#pragma unroll
                for (int hh = 0; hh < 2; ++hh) { int q4[4], q2[2];
#pragma unroll
                    for (int i = 0; i < 4; ++i) q4[i] = (c4 ? part[8 * hh + 4 + i] : part[8 * hh + i]) + __builtin_amdgcn_update_dpp(0, c4 ? part[8 * hh + i] : part[8 * hh + 4 + i], 0x141, 0xf, 0xf, false);
#pragma unroll
                    for (int i = 0; i < 2; ++i) q2[i] = (c2 ? q4[2 + i] : q4[i]) + __builtin_amdgcn_update_dpp(0, c2 ? q4[i] : q4[2 + i], 0x4E, 0xf, 0xf, false);
                    const int q1 = (c1 ? q2[1] : q2[0]) + __builtin_amdgcn_update_dpp(0, c1 ? q2[0] : q2[1], 0xB1, 0xf, 0xf, false);
                    const int qs = (q1 + 2) >> 2; PDs[t * 128 + 64 * hh + lane] = (short)(qs > 32767 ? 32767 : (qs < -32767 ? -32767 : qs)); }
            }
        }
    }
}
#undef U_EXP
__device__ __forceinline__ void p_peer_fin(Frame& F, int layer) {
    const float* USC = WSP(float, WS_TSC) + (size_t)layer * PEER_E; const float* VSC = WSP(float, WS_TSC) + (size_t)(2 + layer) * PEER_E;
    const short* PD = WSP(short, WS_PD); const float* XS = WSP(float, WS_XS); const int* EXPi = WSP(int, WS_EXP); const float* GATEi = WSP(float, WS_GATE);
    const bool u4 = (PEER_U4_MASK >> layer) & 1;
    for (int t = F.gw; t < TOK; t += F.NGW) { const int lane = F.lane; int s0 = 0, s1 = 0;
        if (!u4) {
#pragma unroll
            for (int s = 0; s < 16; ++s) { s0 += PD[((size_t)s * TOK + t) * 128 + lane]; s1 += PD[((size_t)s * TOK + t) * 128 + 64 + lane]; } }
        else { const int off = 2 * WSP(int, WS_SX)[t];
#pragma unroll
            for (int s = 0; s < 8; ++s) { s0 += PD[((size_t)s * TOK + t) * 128 + lane]; s1 += PD[((size_t)s * TOK + t) * 128 + 64 + lane]; }
            s0 -= off; s1 -= off; }
        const int e0 = EXPi[(size_t)t * 128 + lane], e1 = EXPi[(size_t)t * 128 + 64 + lane]; const float xs = XS[t];
        const float w0 = gelu_f((float)s0 * 4.f * USC[e0] * xs) * GATEi[(size_t)t * 128 + lane] * VSC[e0], w1 = gelu_f((float)s1 * 4.f * USC[e1] * xs) * GATEi[(size_t)t * 128 + 64 + lane] * VSC[e1];
        float mx = fmaxf(fabsf(w0), fabsf(w1));
        mx = wave_max(mx);
        const float inv = mx > 0.f ? 127.f / mx : 0.f;
        const int q0 = (int)__builtin_rintf(w0 * inv), q1 = (int)__builtin_rintf(w1 * inv);
        if ((PEER_V4_MASK >> layer) & 1) { int sw = q0 + q1;
            sw = wave_sum_i(sw);
            if (lane == 0) WSP(int, WS_SW)[t] = sw; }
        int* pw = WSP(int, WS_PW) + (size_t)t * 128; pw[lane] = (e0 << 8) | (q0 & 0xff); pw[64 + lane] = (e1 << 8) | (q1 & 0xff);
        if (lane == 0) WSP(float, WS_PWS)[t] = mx * (1.f / 127.f); }
}
#define V_PW(dst, tok) do { const int* pp_ = PWq + (tok) * 128 + 16 * r; dst[0] = *(const u32x4*)pp_; dst[1] = *(const u32x4*)(pp_ + 4); dst[2] = *(const u32x4*)(pp_ + 8); dst[3] = *(const u32x4*)(pp_ + 12); } while (0)
__device__ __forceinline__ void p_peer_v(Frame& F, const Args& a, int layer, bool next_stats, unsigned* qbase, float fac) {
    const unsigned char* V8 = WSP(unsigned char, WS_V8) + (size_t)layer * PEER_E * 2048; const int* PWq = WSP(int, WS_PW); const float* PWS = WSP(float, WS_PWS); float* out = a.out;
    const int xcc = (int)xb_xcc_id();
#pragma unroll 1
    for (int ri = 0; ri < 16; ++ri) {
        const int sl = (xcc + 8 * (ri & 1) + (ri >> 1)) & 15;
        const unsigned char* Vs = V8 + (size_t)sl * PEER_E * 128;
#pragma unroll 1
        for (;;) {
            int lane = lane_id(); asm volatile("" : "+v"(lane));
            int chunk = 0; if (lane == 0) chunk = (int)__hip_atomic_fetch_add(qbase + sl * 64, 1u, __ATOMIC_RELAXED, __HIP_MEMORY_SCOPE_AGENT);
            chunk = __builtin_amdgcn_readfirstlane(chunk);
            if (chunk >= TOK / 32) break;
            const int r = lane >> 3, c = lane & 7; const bool b5 = lane & 32, b4 = lane & 16, b3 = lane & 8;
            u32x4 wn[4]; float wsn;
            { const size_t t_ = (size_t)chunk * 32; V_PW(wn, t_); wsn = PWS[t_]; }
#pragma unroll 1
            for (int ti = 0; ti < 32; ++ti) {
                const size_t t = (size_t)chunk * 32 + ti; const u32x4 w0 = wn[0], w1 = wn[1], w2 = wn[2], w3 = wn[3]; const float ws = wsn;
                if (ti + 1 < 32) { V_PW(wn, t + 1); wsn = PWS[t + 1]; }
                unsigned* xp = (unsigned*)(WSP(bf16_t, WS_XB) + t * 2048 + (sl * 128 + c * 16 + r * 2)); const unsigned xw = *xp; const f32x2 o0 = {bf_lo(xw), bf_hi(xw)};
                u32x4 R[16]; int wk[16];
#pragma unroll
                for (int g = 0; g < 16; ++g) { const u32x4 wv = g < 4 ? w0 : (g < 8 ? w1 : (g < 12 ? w2 : w3)); wk[g] = (int)wv[g & 3];
                    R[g] = *(const u32x4*)(Vs + ((wk[g] >> 8) * 128 + c * 16)); }
                int acc[16];
#pragma unroll
                for (int i = 0; i < 16; ++i) acc[i] = 0;
#pragma unroll
                for (int j = 0; j < 4; ++j) {
                    const unsigned W = ((unsigned)wk[4 * j] & 0xffu) | (((unsigned)wk[4 * j + 1] & 0xffu) << 8) | (((unsigned)wk[4 * j + 2] & 0xffu) << 16) | ((unsigned)wk[4 * j + 3] << 24);
#pragma unroll
                    for (int d = 0; d < 4; ++d) { const unsigned ra = ((const unsigned*)&R[4 * j])[d], rb = ((const unsigned*)&R[4 * j + 1])[d], rc = ((const unsigned*)&R[4 * j + 2])[d], rd = ((const unsigned*)&R[4 * j + 3])[d];
                        const unsigned ablo = __builtin_amdgcn_perm(rb, ra, 0x05010400u), abhi = __builtin_amdgcn_perm(rb, ra, 0x07030602u), cdlo = __builtin_amdgcn_perm(rd, rc, 0x05010400u), cdhi = __builtin_amdgcn_perm(rd, rc, 0x07030602u);
                        const unsigned t0 = __builtin_amdgcn_perm(cdlo, ablo, 0x05040100u), t1 = __builtin_amdgcn_perm(cdlo, ablo, 0x07060302u), t2 = __builtin_amdgcn_perm(cdhi, abhi, 0x05040100u), t3 = __builtin_amdgcn_perm(cdhi, abhi, 0x07060302u);
                        acc[4 * d] = __builtin_amdgcn_sdot4((int)t0, (int)W, acc[4 * d], false); acc[4 * d + 1] = __builtin_amdgcn_sdot4((int)t1, (int)W, acc[4 * d + 1], false);
                        acc[4 * d + 2] = __builtin_amdgcn_sdot4((int)t2, (int)W, acc[4 * d + 2], false); acc[4 * d + 3] = __builtin_amdgcn_sdot4((int)t3, (int)W, acc[4 * d + 3], false); }
                }
                int a8[8], a4[4], a2[2];
#pragma unroll
                for (int i = 0; i < 8; ++i) a8[i] = rs_bit5(acc[i], acc[8 + i]);
#pragma unroll
                for (int i = 0; i < 4; ++i) a4[i] = rs_bit4(a8[i], a8[4 + i]);
#pragma unroll
                for (int i = 0; i < 2; ++i) a2[i] = rs_bit3(a4[i], a4[2 + i], b3);
                const int s0 = a2[0], s1 = a2[1];
                const float sc = ws * fac; const f32x2 nv = {o0.x + (float)s0 * sc, o0.y + (float)s1 * sc};
                if (!next_stats) { if (fac != 0.f) *(f32x2*)(out + t * 2048 + (sl * 128 + c * 16 + r * 2)) = nv; }
                else { *xp = cvt_pk_bf16(nv.x, nv.y);
                    const float ssq = wave_sum(nv.x * nv.x + nv.y * nv.y, lane); if (lane < 2) WSP(float, WS_SSQ1)[t * 32 + 2 * sl + lane] = lane == 0 ? ssq : 0.f; }
            }
        }
    }
}
__device__ __forceinline__ void p_peer_v4(Frame& F, const Args& a, int layer, bool next_stats, unsigned* qbase, float fac) {
    const unsigned char* V8 = WSP(unsigned char, WS_V8) + (size_t)layer * PEER_E * 2048; const int* PWq = WSP(int, WS_PW); const float* PWS = WSP(float, WS_PWS); const int* SW = WSP(int, WS_SW); float* out = a.out;
    const int xcc = (int)xb_xcc_id();
#pragma unroll 1
    for (int ri = 0; ri < 8; ++ri) {
        const int sl = (xcc + ri) & 7;
        const unsigned char* Vs = V8 + (size_t)sl * PEER_E * 128;
#pragma unroll 1
        for (;;) {
            int lane = lane_id(); asm volatile("" : "+v"(lane));
            int chunk = 0; if (lane == 0) chunk = (int)__hip_atomic_fetch_add(qbase + sl * 64, 1u, __ATOMIC_RELAXED, __HIP_MEMORY_SCOPE_AGENT);
            chunk = __builtin_amdgcn_readfirstlane(chunk);
            if (chunk >= TOK / 32) break;
            const int r = lane >> 3, c = lane & 7; const bool b5 = lane & 32, b4 = lane & 16, b3 = lane & 8;
            u32x4 wn[4]; float wsn; int swn;
            { const size_t t_ = (size_t)chunk * 32; V_PW(wn, t_); wsn = PWS[t_]; swn = SW[t_]; }
#pragma unroll 1
            for (int ti = 0; ti < 32; ++ti) {
                const size_t t = (size_t)chunk * 32 + ti; const u32x4 w0 = wn[0], w1 = wn[1], w2 = wn[2], w3 = wn[3]; const float ws = wsn; const int sw8 = 8 * swn;
                if (ti + 1 < 32) { V_PW(wn, t + 1); wsn = PWS[t + 1]; swn = SW[t + 1]; }
                unsigned* xp = (unsigned*)(WSP(bf16_t, WS_XB) + t * 2048 + (sl * 256 + c * 32 + 8 * (r >> 1) + 2 * (r & 1))); u32x2 xw; xw.x = xp[0]; xw.y = xp[2];
                u32x4 R[16]; int wk[16];
#pragma unroll
                for (int g = 0; g < 16; ++g) { const u32x4 wv = g < 4 ? w0 : (g < 8 ? w1 : (g < 12 ? w2 : w3)); wk[g] = (int)wv[g & 3];
                    R[g] = *(const u32x4*)(Vs + ((wk[g] >> 8) * 128 + c * 16)); }
                int acc[32];
#pragma unroll
                for (int i = 0; i < 32; ++i) acc[i] = 0;
#pragma unroll
                for (int j = 0; j < 4; ++j) {
                    const unsigned W = ((unsigned)wk[4 * j] & 0xffu) | (((unsigned)wk[4 * j + 1] & 0xffu) << 8) | (((unsigned)wk[4 * j + 2] & 0xffu) << 16) | ((unsigned)wk[4 * j + 3] << 24);
#pragma unroll
                    for (int d = 0; d < 4; ++d) { const unsigned ra = ((const unsigned*)&R[4 * j])[d], rb = ((const unsigned*)&R[4 * j + 1])[d], rc = ((const unsigned*)&R[4 * j + 2])[d], rd = ((const unsigned*)&R[4 * j + 3])[d];
                        const unsigned ablo = __builtin_amdgcn_perm(rb, ra, 0x05010400u), abhi = __builtin_amdgcn_perm(rb, ra, 0x07030602u), cdlo = __builtin_amdgcn_perm(rd, rc, 0x05010400u), cdhi = __builtin_amdgcn_perm(rd, rc, 0x07030602u);
                        const unsigned t0 = __builtin_amdgcn_perm(cdlo, ablo, 0x05040100u), t1 = __builtin_amdgcn_perm(cdlo, ablo, 0x07060302u), t2 = __builtin_amdgcn_perm(cdhi, abhi, 0x05040100u), t3 = __builtin_amdgcn_perm(cdhi, abhi, 0x07060302u);
                        const int b = 8 * d;
#define V4_COL(tt, i) acc[b + 2 * (i)] = __builtin_amdgcn_sdot4((int)(tt), (int)W, acc[b + 2 * (i)], false); acc[b + 2 * (i) + 1] = __builtin_amdgcn_sdot4((int)((tt) & 0xF0F0F0F0u), (int)W, acc[b + 2 * (i) + 1], false)
                        V4_COL(t0, 0); V4_COL(t1, 1); V4_COL(t2, 2); V4_COL(t3, 3);
#undef V4_COL
                    }
                }
                int a16[16], a8[8], a4[4];
#pragma unroll
                for (int i = 0; i < 16; ++i) a16[i] = rs_bit5(acc[i], acc[16 + i]);
#pragma unroll
                for (int i = 0; i < 8; ++i) a8[i] = rs_bit4(a16[i], a16[8 + i]);
#pragma unroll
                for (int i = 0; i < 4; ++i) a4[i] = rs_bit3(a8[i], a8[4 + i], b3);

                const float sc = ws * fac; f32x4 nv;
                const int lo0 = a4[0] - a4[1] - sw8, hi0 = a4[1] >> 4, lo1 = a4[2] - a4[3] - sw8, hi1 = a4[3] >> 4;
                nv.x = bf_lo(xw.x) + (float)lo0 * sc; nv.y = bf_hi(xw.x) + (float)lo1 * sc; nv.z = bf_lo(xw.y) + (float)hi0 * sc; nv.w = bf_hi(xw.y) + (float)hi1 * sc;
                if (!next_stats) { if (fac != 0.f) { float* op = out + t * 2048 + (sl * 256 + c * 32 + 8 * (r >> 1) + 2 * (r & 1)); *(f32x2*)op = (f32x2){nv.x, nv.y}; *(f32x2*)(op + 4) = (f32x2){nv.z, nv.w}; } }
                else { xp[0] = cvt_pk_bf16(nv.x, nv.y); xp[2] = cvt_pk_bf16(nv.z, nv.w);
                    const float ssq = wave_sum((nv.x * nv.x + nv.y * nv.y) + (nv.z * nv.z + nv.w * nv.w), lane); if (lane < 4) WSP(float, WS_SSQ1)[t * 32 + 4 * sl + lane] = lane == 0 ? ssq : 0.f; }
            }
        }
    }
}
__device__ __forceinline__ void p_diff_prep(Frame& F, const Args& a) {
    const f32x2* R64 = WSP(f32x2, WS_ROPE64); const int lane = F.lane, d0 = (lane & 15) * 8; const float* gn = a.in[32] + d0;
    for (int t = F.gw; t < TOK; t += F.NGW) {
        u32x4 raw[4]; f32x2 cs[8]; bf16_t* base = WSP(bf16_t, WS_KD) + (size_t)t * 2048;
#pragma unroll
        for (int i = 0; i < 4; ++i) raw[i] = *(const u32x4*)(base + (lane + 64 * i) * 8);
#pragma unroll
        for (int e = 0; e < 8; ++e) cs[e] = R64[(size_t)t * 64 + (lane & 7) * 8 + e];
#pragma unroll
        for (int i = 0; i < 4; ++i) { bf16_t* p = base + (lane + 64 * i) * 8; float f[8]; unpack8(raw[i], f); float s = 0.f;
#pragma unroll
            for (int e = 0; e < 8; ++e) s += f[e] * f[e];
            s = row16_sum(s);
            const float rs = 1.0f / sqrtf(s * (1.f / 128.f) + EPS); float o[8];
#pragma unroll
            for (int e = 0; e < 8; ++e) f[e] *= rs * gn[e];
#pragma unroll
            for (int e = 0; e < 8; ++e) { const float pv = dppf<0x128>(f[e]); o[e] = (lane & 8) ? f[e] * cs[e].x + pv * cs[e].y : f[e] * cs[e].x - pv * cs[e].y; }
            u32x4 pk; pk.x = cvt_pk_bf16(o[0], o[1]); pk.y = cvt_pk_bf16(o[2], o[3]); pk.z = cvt_pk_bf16(o[4], o[5]); pk.w = cvt_pk_bf16(o[6], o[7]); *(u32x4*)p = pk; }
    }
}
__device__ __forceinline__ void p_attn_diff(Frame& F, const Args& a) {
    const bf16_t* QD = WSP(bf16_t, WS_QD); const bf16_t* KD = WSP(bf16_t, WS_KD); const bf16_t* VD = WSP(bf16_t, WS_VD); bf16_t* OD = WSP(bf16_t, WS_OD); bf16_t* MIX = WSP(bf16_t, WS_MIX);
    const float scale = 0.08838834764831845f;
    const float lam_init = 0.8f - 0.6f * 0.7408182206817179f;
    for (int it = F.bid; it < 256; it += F.G) {
        const int x = it & 7, y = it >> 3, pairidx = y & 7, bh = x * 4 + (y >> 3), h = bh & 7, b = bh >> 3;
#pragma unroll 1
        for (int s = 0; s < 4; ++s) { const int qb = (s >> 1) ? pairidx : 15 - pairidx, m = s & 1, q0 = qb * 256; const size_t row0 = (size_t)b * SEQ + q0, kr0 = (size_t)b * SEQ;
            float lam = 0.f;
            if (m) { const int ln = lane_id(); const float d1 = wave_sum(a.in[33][ln] * a.in[34][ln] + a.in[33][64 + ln] * a.in[34][64 + ln], ln), d2 = wave_sum(a.in[35][ln] * a.in[36][ln] + a.in[35][64 + ln] * a.in[36][64 + ln], ln);
                     lam = expf(d1) - expf(d2) + lam_init; }
            att::attn_unit<128, 256, true, false, 64, true>(F.lds, QD + row0 * 2048 + h * 256 + m * 128, 2048, KD + kr0 * 2048 + h * 256 + m * 128, 2048, VD + kr0 * 2048 + h * 256, 2048,
                                           OD + row0 * 4096 + h * 512 + m * 256, 4096, 4 * (qb + 1), q0, scale * 1.4426950408889634f, (F.wave << 6) | lane_id(), a.in[31], WSP(f32x2, WS_ROPE64) + row0 * 64,
                                           OD + row0 * 4096 + h * 512, MIX + row0 * 2048 + h * 256, 2048, lam, a.in[37], 1.0f - lam_init); }
    }
}

constexpr int PH_LAST = 35;
__global__ void __launch_bounds__(NTHREADS, 2) mega_fwd(Args args) {
    extern __shared__ __attribute__((aligned(16))) unsigned char lds_raw[];
    Frame F;
    F.lds = (LAS unsigned char*)lds_raw; F.tid = threadIdx.x; F.lane = F.tid & 63; F.wave = __builtin_amdgcn_readfirstlane(F.tid >> 6);
    F.G = gridDim.x; F.bid = blockIdx.x; F.gw = F.bid * NWAVES + F.wave; F.NGW = F.G * NWAVES; F.ws = (GAS unsigned char*)args.ws;
    volatile LAS unsigned* MISC = (volatile LAS unsigned*)(F.lds + MISC_OFF);
    if (F.tid < 64) MISC[F.tid] = 0u;
    __syncthreads();
    const int lo = args.ph_lo, hi = args.ph_hi;
    XcdBarrier bar; bar.bar = (unsigned*)(F.ws + WS_CTL) + CW_BAR; bar.x = 0; bar.st = nullptr;
    if (hi - lo > 1) bar = xcd_barrier_post((unsigned*)(F.ws + WS_CTL) + CW_BAR, MISC + 8);
#ifdef ONLY
#define IN(k) ((k) == ONLY && lo <= (k) && (k) < hi)
#else
#define IN(k) (lo <= (k) && (k) < hi)
#endif
#define SEAM(k) do { if (IN((k) + 1)) { XcdBarrier bb_ = bar; unsigned* b_ = bar.bar; asm volatile("" : "+s"(b_)); bb_.bar = (unsigned*)(GAS unsigned*)b_; xcd_barrier(bb_, ((F.wave << 6) | lane_id()) == 0); } } while (0)
#define REFRESH() do { int t_ = (F.wave << 6) | lane_id(); asm volatile("" : "+v"(t_)); F.tid = t_; F.lane = t_ & 63; unsigned char* w_ = args.ws; asm volatile("" : "+s"(w_)); F.ws = (GAS unsigned char*)w_; } while (0)
#define GEMM_STORE(Ap, Bp, Mv, Nv, Kv, Op, ldcv, rs, scv, ssv, invn, slotsv) do { pg8::Gemm g_{Ap, Bp, Mv, Nv, Kv}; pg8::StaticOrder S_; S_.init(Mv, Nv, F.G, F.bid); pg8::EpiStore E_{Op, ldcv, rs, scv, ssv, invn, slotsv}; \
        pg8::gemm_phase<pg8::EpiStore, pg8::StaticOrder, true, true>(F.lds, g_, S_, E_, F.tid); } while (0)
#define GEMM_RESID(Ap, Bp, Kv, ssqp) do { pg8::Gemm g_{Ap, Bp, TOK, DM, Kv}; pg8::StaticOrder S_; S_.init(TOK, DM, F.G, F.bid); pg8::EpiResid E_{WSP(bf16_t, WS_XB), dry ? nullptr : (ssqp), fac}; \
        pg8::gemm_phase<pg8::EpiResid, pg8::StaticOrder, true, true>(F.lds, g_, S_, E_, F.tid); } while (0)
#ifndef REPEAT_MASK
#define REPEAT_MASK 0ull
#endif
#define PHASE(k, ...) if (IN(k)) { REFRESH(); { const float fac = 1.f; const bool dry = false; (void)fac; (void)dry; __VA_ARGS__ } \
        if ((REPEAT_MASK >> ((k) > 24 ? (k) - 16 : (k))) & 1ull) { const float fac = 0.f; const bool dry = true; (void)fac; (void)dry; __VA_ARGS__ } SEAM(k); }
    PHASE(0, p_prologue(F, args);)
    PHASE(1,
        { pg8::Gemm g{WSP(bf16_t, WS_XB), WSP(bf16_t, WS_WIN), TOK, 4096, 2048}; pg8::StaticOrder S; S.init(TOK, 4096, F.G, F.bid);
          pg8::EpiWin E{WSP(bf16_t, WS_CQ), WSP(bf16_t, WS_CKV), WSP(bf16_t, WS_Z), WSP(bf16_t, WS_XBC), WSP(float, WS_TAIL), WSP(float, WS_RSTD)};
          pg8::gemm_phase<pg8::EpiWin, pg8::StaticOrder, true, true>(F.lds, g, S, E, F.tid); })
    PHASE(2,
        { pg8::Gemm g{WSP(bf16_t, WS_XB), WSP(bf16_t, WS_WIN) + (size_t)4096 * 2048, TOK, 256, 2048}; pg8::StaticOrder S; S.init(TOK, 256, F.G, F.bid);
          pg8::EpiTail E{{WSP(bf16_t, WS_CQ), WSP(bf16_t, WS_CKV), WSP(bf16_t, WS_Z), WSP(bf16_t, WS_XBC), WSP(float, WS_TAIL), WSP(float, WS_RSTD)}};
          pg8::gemm_phase<pg8::EpiTail, pg8::StaticOrder, true, true>(F.lds, g, S, E, F.tid); }
        _Pragma("unroll 1")
        for (int l = 0; l < 2; ++l) { pg8::Gemm g{WSP(bf16_t, WS_MEMB), WSP(bf16_t, WS_WMEMKV) + (size_t)l * 1024 * 2048, 1024, 1024, 2048}; pg8::StaticOrder S; S.init(1024, 1024, F.G, (F.bid + 2 * F.G - 64 - 16 * l) % F.G);
          pg8::EpiStore E{WSP(bf16_t, WS_MEMKV) + (size_t)l * 1024 * 1024, 1024, WSP(float, WS_RSTD_MEM), 0, 0, 1.f / 2048.f, false};
          pg8::gemm_phase<pg8::EpiStore, pg8::StaticOrder, true, true>(F.lds, g, S, E, F.tid); }
        if (!dry) { const int first = F.G > 96 ? 96 : 0; if (F.bid >= first) p_prepA(F, args, F.bid - first, F.G - first); })
    PHASE(3,
        GEMM_STORE(WSP(bf16_t, WS_CQ), WSP(bf16_t, WS_WUQ), TOK, 1536, 512, WSP(bf16_t, WS_QM), 1536, WSP(float, WS_RSTD_CQ), 0, 0, 0.f, false);
        GEMM_STORE(WSP(bf16_t, WS_CKV), WSP(bf16_t, WS_WUKV), TOK, 2048, 512, WSP(bf16_t, WS_KV), 2048, WSP(float, WS_RSTD_CKV), 0, 0, 0.f, false);)
    PHASE(4, if (!dry) { p_prepB(F, args); p_prep_late(F, args); })
    PHASE(5, if (!dry) p_mla_ssd(F, args, (unsigned*)(F.ws + WS_CTL) + 64, (volatile LAS int*)(F.lds + MISC_OFF + 128));)
    PHASE(7, p_ssd_norm(F, args);)
    PHASE(8, GEMM_RESID(WSP(bf16_t, WS_MIX), WSP(bf16_t, WS_WOUT), 2048, WSP(float, WS_SSQ1));)
#pragma unroll 1
    for (int layer = 0; layer < 2; ++layer) {
        const int pb = layer ? 25 : 9;
        if (layer == 1) {
            PHASE(20, GEMM_STORE(WSP(bf16_t, WS_XB), WSP(bf16_t, WS_WQKV), TOK, 6144, 2048, WSP(bf16_t, WS_QD), 2048, WSP(float, WS_SSQ1), 2048, (size_t)TOK * 2048, 1.f / 2048.f, true);)
            PHASE(21, if (!dry) p_diff_prep(F, args);)
            PHASE(22, p_attn_diff(F, args);)
            PHASE(24, GEMM_RESID(WSP(bf16_t, WS_MIX), WSP(bf16_t, WS_WO), 2048, WSP(float, WS_SSQ1));)
        }
        PHASE(pb + 1,
                      { pg8::Gemm g_{WSP(bf16_t, WS_XB), WSP(bf16_t, WS_WMEMQ) + (size_t)layer * 512 * 2048, TOK, 512, 2048}; pg8::StaticOrder S_; S_.init(TOK, 2 * 512, F.G, F.bid);
                        pg8::EpiStore E_{WSP(bf16_t, WS_MEMQ), 512, WSP(float, WS_SSQ1), 0, 0, 1.f / 2048.f, true, true};
                        pg8::gemm_phase<pg8::EpiStore, pg8::StaticOrder, true, true, true>(F.lds, g_, S_, E_, F.tid); })
        PHASE(pb + 3, p_attn_mem(F, layer);)
        PHASE(pb + 4, GEMM_RESID(WSP(bf16_t, WS_MEMO), WSP(bf16_t, WS_WMEMO) + (size_t)layer * 2048 * 512, 512, WSP(float, WS_SSQ2));)
        PHASE(pb + 6, GEMM_STORE(WSP(bf16_t, WS_XB), WSP(bf16_t, WS_WPEERQ) + (size_t)layer * 2048 * 2048, TOK, 2048, 2048, WSP(bf16_t, WS_PQ), 2048, WSP(float, WS_SSQ2), 0, 0, 1.f / 2048.f, true);)
        if ((PEER_U4_MASK >> layer) & 1) {
            PHASE(pb + 7, p_peer_topk(F, layer, 0, TOK / 2, F.gw, F.NGW, F.bid & 1);)
            PHASE(pb + 2, if (!dry) { if (F.wave < 4) p_peer_topk(F, layer, TOK / 2, TOK, F.bid * 4 + F.wave, F.G * 4, 0); }
                          p_peer_u<true>(F, layer, (unsigned*)(F.ws + WS_CTL) + 8192 + layer * 2048 + (dry ? 8192 : 0), 0, TOK / 64);)
            PHASE(pb + 8, p_peer_u<true>(F, layer, (unsigned*)(F.ws + WS_CTL) + 8192 + layer * 2048 + 512 + (dry ? 8192 : 0), TOK / 64, TOK / 64);)
        } else {
            PHASE(pb + 7, p_peer_topk(F, layer, 0, TOK, F.gw, F.NGW, F.bid & 1);)
            PHASE(pb + 8, p_peer_u<false>(F, layer, (unsigned*)(F.ws + WS_CTL) + 8192 + layer * 2048 + (dry ? 8192 : 0), 0, TOK / 32);)
        }
        PHASE(pb + 9, p_peer_fin(F, layer);)
        PHASE(pb + 10, if ((PEER_V4_MASK >> layer) & 1) p_peer_v4(F, args, layer, layer == 0, (unsigned*)(F.ws + WS_CTL) + 8192 + layer * 2048 + 1024 + (dry ? 8192 : 0), fac);
                       else p_peer_v(F, args, layer, layer == 0, (unsigned*)(F.ws + WS_CTL) + 8192 + layer * 2048 + 1024 + (dry ? 8192 : 0), fac);)
    }
}

extern "C" void kernel_launch(void* const* d_in, const int* in_sizes, int n_in, void* d_out, int out_size, void* d_ws, size_t ws_size, hipStream_t stream) {
    static int grid = 0;
    if (grid == 0) {
        if (n_in != 39 || out_size != TOK * DM || ws_size < WS_END) { fprintf(stderr, "kernel_launch: unexpected shapes (n_in %d out %d ws %zu need %zu)\n", n_in, out_size, ws_size, (size_t)WS_END); grid = -1; return; }
        int dev = 0, cus = 0, per_cu = 0;
        if (hipGetDevice(&dev) != hipSuccess || hipDeviceGetAttribute(&cus, hipDeviceAttributeMultiprocessorCount, dev) != hipSuccess) { grid = -1; return; }
        if (hipFuncSetAttribute((const void*)mega_fwd, hipFuncAttributeMaxDynamicSharedMemorySize, LDS_BYTES) != hipSuccess) { fprintf(stderr, "kernel_launch: hipFuncSetAttribute failed\n"); grid = -1; return; }
        if (hipOccupancyMaxActiveBlocksPerMultiprocessor(&per_cu, (const void*)mega_fwd, NTHREADS, LDS_BYTES) != hipSuccess || per_cu < 1) { fprintf(stderr, "kernel_launch: occupancy query says %d\n", per_cu); grid = -1; return; }
        (void)hipGetLastError();
        grid = cus;
    }
    if (grid < 0) return;
    (void)hipMemsetAsync((char*)d_ws + WS_CTL, 0, CTL_ZERO_BYTES, stream);
    Args a{};
    for (int i = 0; i < 39; ++i) a.in[i] = (const float*)d_in[i];
    a.pos = (const int*)d_in[2]; a.out = (float*)d_out; a.ws = (unsigned char*)d_ws;
#if MK_ONE_LAUNCH
    a.ph_lo = 0; a.ph_hi = PH_LAST + 1;
    hipLaunchKernelGGL(mega_fwd, dim3(grid), dim3(NTHREADS), LDS_BYTES, stream, a);
#else
    for (int ph = 0; ph <= PH_LAST; ++ph) { a.ph_lo = ph; a.ph_hi = ph + 1; hipLaunchKernelGGL(mega_fwd, dim3(grid), dim3(NTHREADS), LDS_BYTES, stream, a); }
#endif
}
```

```cpp
#include <hip/hip_runtime.h>
#include <cstdio>
#include <cstdint>

#ifndef MK_ONE_LAUNCH
#define MK_ONE_LAUNCH 1
#endif

#define LAS __attribute__((address_space(3)))
#define GAS __attribute__((address_space(1)))
typedef unsigned short bf16_t;
typedef short bf16x8 __attribute__((ext_vector_type(8)));
typedef short s16x4 __attribute__((ext_vector_type(4)));
typedef float f32x4 __attribute__((ext_vector_type(4)));
typedef float f32x2 __attribute__((ext_vector_type(2)));
typedef float f32x16 __attribute__((ext_vector_type(16)));
typedef unsigned u32x4 __attribute__((ext_vector_type(4)));
typedef unsigned u32x2 __attribute__((ext_vector_type(2)));
typedef __bf16 bf16x2_t __attribute__((ext_vector_type(2)));

constexpr int BATCH = 4, SEQ = 4096, DM = 2048, TOK = BATCH * SEQ;
constexpr int NMEM = 256;
constexpr float EPS = 1e-6f;
constexpr int MLA_H = 8, MLA_QK = 192, MLA_NOPE = 128, MLA_ROPE = 64, MLA_V = 128, MLA_RANK = 512;
constexpr int SSD_H = 16, SSD_P = 64, SSD_INNER = 1024, SSD_G = 4, SSD_N = 128, SSD_CONVD = 2048;
constexpr int EVEN_IN = 4176, WIN_N = 4352;
constexpr int DIFF_H = 8, DIFF_HD = 128, DIFF_V = 256;
constexpr int MEM_H = 4, MEM_HD = 128, MEM_W = 512;
constexpr int PEER_H = 8, PEER_KEYS = 128, PEER_E = 16384, PEER_K = 16, PEER_HK = 128;

constexpr size_t MiB = 1u << 20;
constexpr size_t WS_CTL = 0, CTL_ZERO_BYTES = 1 * MiB;
constexpr size_t WS_WIN = 1 * MiB;
constexpr size_t WS_WUQ = 18 * MiB;
constexpr size_t WS_WUKV = 20 * MiB;
constexpr size_t WS_WOUT = 22 * MiB;
constexpr size_t WS_WMEMQ = 30 * MiB;
constexpr size_t WS_WMEMKV = 34 * MiB;
constexpr size_t WS_WMEMO = 42 * MiB;
constexpr size_t WS_WPEERQ = 46 * MiB;
constexpr size_t WS_WQKV = 62 * MiB;
constexpr size_t WS_WO = 86 * MiB;
constexpr size_t WS_KEYS = 94 * MiB;
constexpr size_t WS_U8 = 96 * MiB;
constexpr size_t WS_V8 = 160 * MiB;
constexpr size_t WS_TSC = 224 * MiB;
constexpr size_t WS_ROPE32 = 352 * MiB;
constexpr size_t WS_ROPE64 = 356 * MiB;
constexpr size_t WS_XB = 364 * MiB;
constexpr size_t WS_RSTD = 428 * MiB;
constexpr size_t WS_RSTD_CQ = WS_RSTD + 65536;
constexpr size_t WS_RSTD_CKV = WS_RSTD + 2 * 65536;
constexpr size_t WS_RSTD_MEM = WS_RSTD + 3 * 65536;
constexpr size_t WS_SSQ1 = 925 * MiB, WS_SSQ2 = 927 * MiB;
constexpr size_t WS_MEMB = 429 * MiB;
constexpr size_t WS_MEMKV = 433 * MiB;
constexpr size_t WS_MIX = 437 * MiB;
constexpr size_t WS_LR = 501 * MiB;
constexpr size_t WS_CQ = WS_LR;
constexpr size_t WS_CKV = WS_LR + 16 * MiB;
constexpr size_t WS_Z = WS_LR + 32 * MiB;
constexpr size_t WS_XBC = WS_LR + 64 * MiB;
constexpr size_t WS_XBCC = WS_LR + 128 * MiB;
constexpr size_t WS_TAIL = WS_LR + 192 * MiB;
constexpr size_t WS_DT = WS_LR + 198 * MiB;
constexpr size_t WS_QM = WS_LR + 200 * MiB;
constexpr size_t WS_KV = WS_LR + 248 * MiB;
constexpr size_t WS_KM = WS_LR + 312 * MiB;
constexpr size_t WS_YG = WS_LR + 360 * MiB;
constexpr size_t WS_QD = WS_LR;
constexpr size_t WS_KD = WS_LR + 64 * MiB;
constexpr size_t WS_VD = WS_LR + 128 * MiB;
constexpr size_t WS_OD = WS_LR + 192 * MiB;
constexpr size_t WS_MEMQ = WS_LR;
constexpr size_t WS_MEMO = WS_LR + 16 * MiB;
constexpr size_t WS_PQ = WS_LR + 32 * MiB;
constexpr size_t WS_EXP = WS_LR + 96 * MiB;
constexpr size_t WS_GATE = WS_LR + 104 * MiB;
constexpr size_t WS_PW = WS_LR + 112 * MiB;
constexpr size_t WS_PWS = WS_LR + 158 * MiB;
constexpr size_t WS_XQ = WS_LR + 120 * MiB;
constexpr size_t WS_SW = WS_LR + 152 * MiB + 131072;
constexpr size_t WS_SX = WS_LR + 152 * MiB + 65536;
constexpr size_t WS_XS = WS_LR + 152 * MiB;
constexpr size_t WS_PD = WS_LR + 160 * MiB;
constexpr size_t WS_END = WS_LR + 428 * MiB;
constexpr int CW_BAR = 4096;

constexpr int RING_BYTES = 131072;
constexpr int MISC_OFF = RING_BYTES;
constexpr int LDS_BYTES = 147456;
constexpr int NWAVES = 8, NTHREADS = 512;

__device__ __forceinline__ unsigned cvt_pk_bf16(float lo, float hi) { unsigned r; asm volatile("v_cvt_pk_bf16_f32 %0, %1, %2" : "=v"(r) : "v"(lo), "v"(hi)); return r; }
__device__ __forceinline__ float bf_lo(unsigned w) { return __uint_as_float(w << 16); }
__device__ __forceinline__ float bf_hi(unsigned w) { return __uint_as_float(w & 0xffff0000u); }
__device__ __forceinline__ float bf2f(bf16_t h) { return __uint_as_float(((unsigned)h) << 16); }
__device__ __forceinline__ bf16_t f2bf(float f) { return (bf16_t)(cvt_pk_bf16(f, 0.f) & 0xffffu); }
__device__ __forceinline__ int lane_id() { int l; asm volatile("v_mbcnt_lo_u32_b32 %0, -1, 0\n\tv_mbcnt_hi_u32_b32 %0, -1, %0" : "=v"(l)); return l; }
__device__ __forceinline__ float shx(float v, int m, int lane) { return __int_as_float(__builtin_amdgcn_ds_bpermute((lane ^ m) << 2, __float_as_int(v))); }
__device__ __forceinline__ unsigned shxu(unsigned v, int m, int lane) { return (unsigned)__builtin_amdgcn_ds_bpermute((lane ^ m) << 2, (int)v); }
__device__ __forceinline__ float shf(float v, int src) { return __int_as_float(__builtin_amdgcn_ds_bpermute(src << 2, __float_as_int(v))); }
__device__ __forceinline__ int rs_bit5(int lo, int hi) { auto r = __builtin_amdgcn_permlane32_swap((unsigned)lo, (unsigned)hi, false, false); return (int)r[0] + (int)r[1]; }
__device__ __forceinline__ int rs_bit4(int lo, int hi) { auto r = __builtin_amdgcn_permlane16_swap((unsigned)lo, (unsigned)hi, false, false); return (int)r[0] + (int)r[1]; }
__device__ __forceinline__ int rs_bit3(int lo, int hi, bool b3) { const int keep = b3 ? hi : lo, send = b3 ? lo : hi; return keep + __builtin_amdgcn_update_dpp(0, send, 0x128, 0xf, 0xf, false); }
template <int CTRL> __device__ __forceinline__ float dppf(float v) { return __int_as_float(__builtin_amdgcn_update_dpp(0, __float_as_int(v), CTRL, 0xf, 0xf, false)); }
template <int CTRL> __device__ __forceinline__ int dppi(int v) { return __builtin_amdgcn_update_dpp(0, v, CTRL, 0xf, 0xf, false); }
__device__ __forceinline__ float row8_sum(float v) { v += dppf<0xB1>(v); v += dppf<0x4E>(v); v += dppf<0x141>(v); return v; }
__device__ __forceinline__ float row16_sum(float v) { v = row8_sum(v); v += dppf<0x140>(v); return v; }
__device__ __forceinline__ float half_sum(float v) { v = row16_sum(v); auto s = __builtin_amdgcn_permlane16_swap(__float_as_uint(v), __float_as_uint(v), false, false); return __uint_as_float(s[0]) + __uint_as_float(s[1]); }
__device__ __forceinline__ float wave_sum(float v, int) { v = half_sum(v); auto t = __builtin_amdgcn_permlane32_swap(__float_as_uint(v), __float_as_uint(v), false, false); return __uint_as_float(t[0]) + __uint_as_float(t[1]); }
__device__ __forceinline__ float wave_max(float v) { v = fmaxf(v, dppf<0xB1>(v)); v = fmaxf(v, dppf<0x4E>(v)); v = fmaxf(v, dppf<0x141>(v)); v = fmaxf(v, dppf<0x140>(v));
    auto s = __builtin_amdgcn_permlane16_swap(__float_as_uint(v), __float_as_uint(v), false, false); v = fmaxf(__uint_as_float(s[0]), __uint_as_float(s[1]));
    auto t = __builtin_amdgcn_permlane32_swap(__float_as_uint(v), __float_as_uint(v), false, false); return fmaxf(__uint_as_float(t[0]), __uint_as_float(t[1])); }
__device__ __forceinline__ int wave_sum_i(int v) { v += dppi<0xB1>(v); v += dppi<0x4E>(v); v += dppi<0x141>(v); v += dppi<0x140>(v);
    auto s = __builtin_amdgcn_permlane16_swap((unsigned)v, (unsigned)v, false, false); v = (int)s[0] + (int)s[1];
    auto t = __builtin_amdgcn_permlane32_swap((unsigned)v, (unsigned)v, false, false); return (int)t[0] + (int)t[1]; }
__device__ __forceinline__ u32x4 pack8(f32x4 a, f32x4 b) { u32x4 w; w.x = cvt_pk_bf16(a.x, a.y); w.y = cvt_pk_bf16(a.z, a.w); w.z = cvt_pk_bf16(b.x, b.y); w.w = cvt_pk_bf16(b.z, b.w); return w; }
__device__ __forceinline__ void unpack8(u32x4 w, float (&f)[8]) { f[0] = bf_lo(w.x); f[1] = bf_hi(w.x); f[2] = bf_lo(w.y); f[3] = bf_hi(w.y); f[4] = bf_lo(w.z); f[5] = bf_hi(w.z); f[6] = bf_lo(w.w); f[7] = bf_hi(w.w); }
__device__ __forceinline__ float fast_exp(float x) { return __builtin_amdgcn_exp2f(x * 1.4426950408889634f); }
__device__ __forceinline__ float silu_f(float v) { return v * __builtin_amdgcn_rcpf(1.f + fast_exp(-v)); }
__device__ __forceinline__ float gelu_f(float v) {
    const float av = fabsf(v), t = __builtin_amdgcn_rcpf(av * 0.2316418882f + 1.0f);
    float q = t * 0.5307027145f + (-0.7265760135f); q = q * t + 0.7107068705f; q = q * t + (-0.142248368f); q = q * t + 0.127414796f; q = q * t;
    const float e = __builtin_amdgcn_exp2f((v * v) * (-0.72134752044f));
    const float m = v * (q * e);
    return v < 0.f ? m : v - m;
}

__device__ __forceinline__ float ld_ssq(const float* p) { return __hip_atomic_fetch_add(const_cast<float*>(p), 0.0f, __ATOMIC_RELAXED, __HIP_MEMORY_SCOPE_AGENT); }
namespace pg8 {
constexpr int BM = 256, BK = 64, HALF = 128, HTB = HALF * BK * 2, STAGE_BYTES = 8 * HTB, NXCD = 8, WGM = 4;
__host__ __device__ __forceinline__ int lds_byte(int r, int c) { const int st = (r >> 4) * 2 + (c >> 5), rr = r & 15, cc = c & 31, ob = rr * 64 + cc * 2; return st * 1024 + (ob ^ (((ob >> 9) & 1) << 5)); }
__host__ __device__ __forceinline__ void stage_rc(int b, int& R, int& C) { const int st = b / 1024, sb = b % 1024, swz = sb ^ (((sb >> 9) & 1) << 5); R = (st >> 1) * 16 + swz / 64; C = (st & 1) * 32 + (swz % 64) / 2; }
__host__ __device__ __forceinline__ int perm32(int rho) { const int n = rho >> 4, i = rho & 15; return 8 * (i >> 2) + 4 * n + (i & 3); }
struct Unit { int pm, pn; };
struct Gemm { const bf16_t* A; const bf16_t* Bt; int M, N, K; };
struct StaticOrder {
    int nM, nN, nwg, G, c;
    __host__ __device__ void init(int M, int N, int G_, int c_) { nM = M / BM; nN = N / BM; nwg = nM * nN; G = G_; c = c_; }
    __host__ __device__ bool next(int i, Unit& u) const {
        const long L = (long)i * G + c; if (L >= nwg) return false;
        int wgid = (int)L; { const int q = nwg / NXCD, r = nwg % NXCD, xcd = wgid % NXCD, off = wgid / NXCD; wgid = (xcd < r ? xcd * (q + 1) : r * (q + 1) + (xcd - r) * q) + off; }
        const int nig = WGM * nN, gid = wgid / nig, fm = gid * WGM, gsz = (nM - fm) < WGM ? (nM - fm) : WGM;
        u.pm = fm + ((wgid % nig) % gsz); u.pn = (wgid % nig) / gsz; return true;
    }
    __device__ __forceinline__ void a_ready(const Unit&) const {}
    __device__ __forceinline__ void done(const Unit&) const {}
};
template <class Epi, class Sched, bool ALIGN_EPI = false, bool SP2 = false, bool HALFN = false>
__device__ __forceinline__ void gemm_phase(LAS unsigned char* lds, const Gemm g, const Sched& S, const Epi& E, int tid_in) {
    static_assert(!HALFN || SP2, "HALFN is written for the SP2 schedule");
    int tid = tid_in; asm volatile("" : "+v"(tid));
    const int wid = __builtin_amdgcn_readfirstlane(tid >> 6), lane = tid & 63, wr = wid >> 2, wc = wid & 3, fr = lane & 15, fq = lane >> 4;
    const int K = g.K, nt = K / BK;
    unsigned voffA[2], voffB[2];
#pragma unroll
    for (int i = 0; i < 2; ++i) { int R, C; stage_rc(tid * 16 + i * 8192, R, C); const int Rb = Epi::PERM ? ((R & ~31) + perm32(R & 31)) : R;
        voffA[i] = (unsigned)(R * K + C) * 2u; voffB[i] = (unsigned)(Rb * K + C) * 2u; }
    const size_t kstep = (size_t)(BK * 2);
    const size_t hstep = (size_t)HALF * K * 2;
    const size_t tstep = 2 * hstep;
    const unsigned ldsw = (unsigned)wid * 1024u;
    const int aoff = lds_byte(wr * 64 + fr, fq * 8), boff = lds_byte(wc * 32 + fr, fq * 8);
#define PG8_SA(b, h) (((b) * 2 + (h)) * HTB)
#define PG8_SB(b, h) ((4 + (b) * 2 + (h)) * HTB)
#define PG8_STAGE(bufoff, gbase, voff) do { _Pragma("unroll") for (int _i = 0; _i < 2; ++_i) \
        __builtin_amdgcn_global_load_lds((const unsigned*)((const char*)(gbase) + (voff)[_i]), (LAS unsigned*)(lds + (bufoff) + ldsw + _i * 8192), 16, 0, 0); } while (0)
#define PG8_LDA(dst, b, h) do { _Pragma("unroll") for (int m = 0; m < 4; ++m) _Pragma("unroll") for (int k = 0; k < 2; ++k) dst[m][k] = *(const LAS bf16x8*)(lds + PG8_SA(b, h) + aoff + m * 2048 + k * 1024); } while (0)
#define PG8_LDB(dst, b, h) do { _Pragma("unroll") for (int n = 0; n < 2; ++n) _Pragma("unroll") for (int k = 0; k < 2; ++k) dst[n][k] = *(const LAS bf16x8*)(lds + PG8_SB(b, h) + boff + n * 2048 + k * 1024); } while (0)
#define PG8_MMA(ai, bj, At, Bt) do { __builtin_amdgcn_s_setprio(1); _Pragma("unroll") for (int m = 0; m < 4; ++m) _Pragma("unroll") for (int n = 0; n < 2; ++n) _Pragma("unroll") for (int k = 0; k < 2; ++k) \
        acc[ai][bj][m][n] = __builtin_amdgcn_mfma_f32_16x16x32_bf16(Bt[n][k], At[m][k], acc[ai][bj][m][n], 0, 0, 0); __builtin_amdgcn_s_setprio(0); } while (0)
#define PG8_WAIT_V(n) asm volatile("s_waitcnt vmcnt(" #n ")" ::: "memory")
#define PG8_WAIT_L(n) asm volatile("s_waitcnt lgkmcnt(" #n ")" ::: "memory")
#define PG8_BAR __builtin_amdgcn_s_barrier()
#define PG8_SCHED __builtin_amdgcn_sched_barrier(0)
    Unit cur, nxt; int ui = 0;
    if (!S.next(0, cur)) return;
    f32x4 acc[2][2][4][2];
#pragma unroll
    for (int a = 0; a < 2; ++a)
#pragma unroll
        for (int b = 0; b < 2; ++b)
#pragma unroll
            for (int m = 0; m < 4; ++m)
#pragma unroll
                for (int n = 0; n < 2; ++n) acc[a][b][m][n] = (f32x4){0.f, 0.f, 0.f, 0.f};
    bf16x8 At[4][2], B0[2][2], B1[2][2];
    const size_t bstep = HALFN ? hstep : tstep;
    const char* cA = (const char*)g.A + (size_t)cur.pm * tstep; const char* cB = (const char*)g.Bt + (size_t)cur.pn * bstep;
    S.a_ready(cur);
    if constexpr (HALFN) {
        PG8_STAGE(PG8_SB(0, 0), cB, voffB); PG8_STAGE(PG8_SA(0, 0), cA, voffA); PG8_STAGE(PG8_SA(0, 1), cA + hstep, voffA);
        if (wr == 1) PG8_BAR;
        PG8_WAIT_V(2); PG8_BAR;
        PG8_STAGE(PG8_SB(1, 0), cB + kstep, voffB); PG8_STAGE(PG8_SA(1, 0), cA + kstep, voffA);
        PG8_WAIT_V(4); PG8_BAR;
    } else if constexpr (SP2) {
        PG8_STAGE(PG8_SB(0, 0), cB, voffB); PG8_STAGE(PG8_SB(0, 1), cB + hstep, voffB); PG8_STAGE(PG8_SA(0, 0), cA, voffA); PG8_STAGE(PG8_SA(0, 1), cA + hstep, voffA);
        if (wr == 1) PG8_BAR;
        PG8_WAIT_V(2); PG8_BAR;
        PG8_STAGE(PG8_SB(1, 0), cB + kstep, voffB); PG8_STAGE(PG8_SA(1, 0), cA + kstep, voffA); PG8_STAGE(PG8_SB(1, 1), cB + hstep + kstep, voffB);
        PG8_WAIT_V(6); PG8_BAR;
    } else {
        PG8_STAGE(PG8_SB(0, 0), cB, voffB); PG8_STAGE(PG8_SA(0, 0), cA, voffA); PG8_STAGE(PG8_SB(0, 1), cB + hstep, voffB); PG8_STAGE(PG8_SA(0, 1), cA + hstep, voffA);
        if (wr == 1) PG8_BAR;
        PG8_WAIT_V(4); PG8_BAR;
        PG8_STAGE(PG8_SB(1, 0), cB + kstep, voffB); PG8_STAGE(PG8_SA(1, 0), cA + kstep, voffA); PG8_STAGE(PG8_SB(1, 1), cB + hstep + kstep, voffB);
        PG8_WAIT_V(6); PG8_BAR;
    }
    for (;;) {
        const bool has_next = S.next(ui + 1, nxt);
        const char* nA = has_next ? (const char*)g.A + (size_t)nxt.pm * tstep : cA; const char* nB = has_next ? (const char*)g.Bt + (size_t)nxt.pn * bstep : cB;
        for (int t = 0; t < nt; t += 2) {
            const bool last = (t == nt - 2);
            const char* a1 = cA + (size_t)(t + 1) * kstep;
            const char* a2 = last ? nA : cA + (size_t)(t + 2) * kstep; const char* b2 = last ? nB : cB + (size_t)(t + 2) * kstep;
            const char* a3 = a2 + kstep; const char* b3 = b2 + kstep;
            if (last && has_next) S.a_ready(nxt);
            if constexpr (HALFN) {
            PG8_LDB(B0, 0, 0); PG8_SCHED; PG8_LDA(At, 0, 0); PG8_STAGE(PG8_SA(1, 1), a1 + hstep, voffA);
            PG8_WAIT_V(6); PG8_WAIT_L(0); PG8_BAR; PG8_MMA(0, 0, At, B0); PG8_BAR; PG8_SCHED;
            PG8_LDA(At, 0, 1); PG8_STAGE(PG8_SB(0, 0), b2, voffB); PG8_STAGE(PG8_SA(0, 0), a2, voffA);
            PG8_WAIT_V(6); PG8_WAIT_L(0); PG8_BAR; PG8_MMA(1, 0, At, B0); PG8_BAR; PG8_SCHED;
            PG8_LDB(B0, 1, 0); PG8_SCHED; PG8_LDA(At, 1, 0); PG8_STAGE(PG8_SA(0, 1), a2 + hstep, voffA);
            PG8_WAIT_V(6); PG8_WAIT_L(0); PG8_BAR; PG8_MMA(0, 0, At, B0); PG8_BAR; PG8_SCHED;
            PG8_LDA(At, 1, 1); PG8_STAGE(PG8_SB(1, 0), b3, voffB); PG8_STAGE(PG8_SA(1, 0), a3, voffA);
            PG8_WAIT_V(6); PG8_WAIT_L(0); PG8_BAR; PG8_MMA(1, 0, At, B0); PG8_BAR; PG8_SCHED;
            } else if constexpr (SP2) {
            PG8_LDB(B0, 0, 0); PG8_LDB(B1, 0, 1); PG8_SCHED; PG8_LDA(At, 0, 0); PG8_STAGE(PG8_SA(1, 1), a1 + hstep, voffA);
            PG8_WAIT_V(8); PG8_WAIT_L(0); PG8_BAR; PG8_MMA(0, 0, At, B0); PG8_MMA(0, 1, At, B1); PG8_BAR; PG8_SCHED;
            PG8_LDA(At, 0, 1); PG8_STAGE(PG8_SB(0, 0), b2, voffB); PG8_STAGE(PG8_SB(0, 1), b2 + hstep, voffB); PG8_STAGE(PG8_SA(0, 0), a2, voffA);
            PG8_WAIT_V(8); PG8_WAIT_L(0); PG8_BAR; PG8_MMA(1, 0, At, B0); PG8_MMA(1, 1, At, B1); PG8_BAR; PG8_SCHED;
            PG8_LDB(B0, 1, 0); PG8_LDB(B1, 1, 1); PG8_SCHED; PG8_LDA(At, 1, 0); PG8_STAGE(PG8_SA(0, 1), a2 + hstep, voffA);
            PG8_WAIT_V(8); PG8_WAIT_L(0); PG8_BAR; PG8_MMA(0, 0, At, B0); PG8_MMA(0, 1, At, B1); PG8_BAR; PG8_SCHED;
            PG8_LDA(At, 1, 1); PG8_STAGE(PG8_SB(1, 0), b3, voffB); PG8_STAGE(PG8_SB(1, 1), b3 + hstep, voffB); PG8_STAGE(PG8_SA(1, 0), a3, voffA);
            PG8_WAIT_V(8); PG8_WAIT_L(0); PG8_BAR; PG8_MMA(1, 0, At, B0); PG8_MMA(1, 1, At, B1); PG8_BAR; PG8_SCHED;
            } else {
            PG8_LDB(B0, 0, 0); PG8_SCHED; PG8_LDA(At, 0, 0); PG8_STAGE(PG8_SA(1, 1), a1 + hstep, voffA);
            PG8_WAIT_L(8); PG8_BAR; PG8_WAIT_L(0); PG8_MMA(0, 0, At, B0); PG8_BAR; PG8_SCHED;
            PG8_LDB(B1, 0, 1); PG8_STAGE(PG8_SB(0, 0), b2, voffB);
            PG8_BAR; PG8_WAIT_L(0); PG8_MMA(0, 1, At, B1); PG8_BAR;
            PG8_LDA(At, 0, 1); PG8_STAGE(PG8_SA(0, 0), a2, voffA);
            PG8_BAR; PG8_WAIT_L(0); PG8_MMA(1, 0, At, B0); PG8_BAR; PG8_SCHED;
            PG8_STAGE(PG8_SB(0, 1), b2 + hstep, voffB);
            PG8_WAIT_V(6); PG8_BAR; PG8_MMA(1, 1, At, B1); PG8_BAR;
            PG8_LDB(B0, 1, 0); PG8_SCHED; PG8_LDA(At, 1, 0); PG8_STAGE(PG8_SA(0, 1), a2 + hstep, voffA);
            PG8_WAIT_L(8); PG8_BAR; PG8_WAIT_L(0); PG8_MMA(0, 0, At, B0); PG8_BAR; PG8_SCHED;
            PG8_LDB(B1, 1, 1); PG8_STAGE(PG8_SB(1, 0), b3, voffB);
            PG8_BAR; PG8_WAIT_L(0); PG8_MMA(0, 1, At, B1); PG8_BAR;
            PG8_LDA(At, 1, 1); PG8_STAGE(PG8_SA(1, 0), a3, voffA);
            PG8_BAR; PG8_WAIT_L(0); PG8_MMA(1, 0, At, B0); PG8_BAR; PG8_SCHED;
            PG8_STAGE(PG8_SB(1, 1), b3 + hstep, voffB);
            PG8_WAIT_V(6); PG8_BAR; PG8_MMA(1, 1, At, B1); PG8_BAR;
            }
        }
        if constexpr (ALIGN_EPI) { if (wr == 0) PG8_BAR; }
        if constexpr (!Epi::AFTER_DRAIN) { E(acc, cur, wr, wc, fr, fq); S.done(cur); }
        if (!has_next) break;
#pragma unroll
        for (int a = 0; a < 2; ++a)
#pragma unroll
            for (int b = 0; b < 2; ++b)
#pragma unroll
                for (int m = 0; m < 4; ++m)
#pragma unroll
                    for (int n = 0; n < 2; ++n) acc[a][b][m][n] = (f32x4){0.f, 0.f, 0.f, 0.f};
        cur = nxt; cA = nA; cB = nB; ++ui;
        if constexpr (ALIGN_EPI) { if (wr == 1) PG8_BAR; }
    }
    PG8_WAIT_V(0);
    if constexpr (!ALIGN_EPI) { if (wr == 0) PG8_BAR; }
    PG8_BAR;
#undef PG8_SA
#undef PG8_SB
#undef PG8_STAGE
#undef PG8_LDA
#undef PG8_LDB
#undef PG8_MMA
#undef PG8_WAIT_V
#undef PG8_WAIT_L
#undef PG8_BAR
#undef PG8_SCHED
}

__device__ __forceinline__ float xrow16_sum(float x) {
    auto s = __builtin_amdgcn_permlane16_swap(__float_as_uint(x), __float_as_uint(x), false, false); x = __uint_as_float(s[0]) + __uint_as_float(s[1]);
    auto t = __builtin_amdgcn_permlane32_swap(__float_as_uint(x), __float_as_uint(x), false, false); return __uint_as_float(t[0]) + __uint_as_float(t[1]);
}
struct EpiStore {
    static constexpr bool PERM = true, AFTER_DRAIN = false;
    bf16_t* O; int ldc; const float* rscale; int split_cols; size_t split_stride; float inv_n; bool slots; bool halfn = false;
    __device__ __forceinline__ void operator()(const f32x4 (&acc)[2][2][4][2], const Unit& u, int wr, int wc, int fr, int fq) const {
        const int row0 = u.pm * BM + wr * 64 + fr; int colt = u.pn * (halfn ? HALF : BM); bf16_t* base = O;
        if (split_cols) { const int t = colt / split_cols; base += (size_t)t * split_stride; colt -= t * split_cols; }
        const int col0 = colt + wc * 32 + 8 * fq;
#pragma unroll
        for (int ai = 0; ai < 2; ++ai)
#pragma unroll
            for (int m = 0; m < 4; ++m) { const int row = row0 + ai * HALF + m * 16; float sc = 1.f; if (slots) { const f32x4 s0 = *(const f32x4*)(rscale + (size_t)row * 32 + fq * 8), s1 = *(const f32x4*)(rscale + (size_t)row * 32 + fq * 8 + 4); sc = 1.0f / sqrtf(xrow16_sum((s0.x + s0.y) + (s0.z + s0.w) + (s1.x + s1.y) + (s1.z + s1.w)) * inv_n + EPS); } else if (inv_n > 0.f) sc = 1.0f / sqrtf(rscale[row] * inv_n + EPS); else if (rscale) sc = rscale[row]; bf16_t* rowp = base + (size_t)row * ldc + col0;
#pragma unroll
                for (int bj = 0; bj < 2; ++bj) if (bj == 0 || !halfn) *(u32x4*)(rowp + bj * HALF) = pack8(acc[ai][bj][m][0] * sc, acc[ai][bj][m][1] * sc); }
    }
};
struct EpiWin {
    static constexpr bool PERM = true, AFTER_DRAIN = false;
    bf16_t *CQ, *CKV, *Z, *XBC; float* TAIL; const float* rscale;
    __device__ __forceinline__ void operator()(const f32x4 (&acc)[2][2][4][2], const Unit& u, int wr, int wc, int fr, int fq) const {
        const int row0 = u.pm * BM + wr * 64 + fr, pn = u.pn;
        bf16_t* base; int ldc, colt;
        if (pn < 2) { base = CQ; ldc = 512; colt = pn * 256; } else if (pn < 4) { base = CKV; ldc = 512; colt = (pn - 2) * 256; }
        else if (pn < 8) { base = Z; ldc = 1024; colt = (pn - 4) * 256; } else { base = XBC; ldc = 2048; colt = (pn - 8) * 256; }
        const int cl = wc * 32 + 8 * fq;
#pragma unroll
        for (int ai = 0; ai < 2; ++ai)
#pragma unroll
            for (int m = 0; m < 4; ++m) { const int row = row0 + ai * HALF + m * 16; const float sc = 1.0f / sqrtf(rscale[row] * (1.f / 2048.f) + EPS);
                if (pn < 16) { bf16_t* rowp = base + (size_t)row * ldc + colt + cl;
#pragma unroll
                    for (int bj = 0; bj < 2; ++bj) *(u32x4*)(rowp + bj * HALF) = pack8(acc[ai][bj][m][0] * sc, acc[ai][bj][m][1] * sc); }
                else if (cl < 80) { float* rowp = TAIL + (size_t)row * 80 + cl; *(f32x4*)rowp = acc[ai][0][m][0] * sc; *(f32x4*)(rowp + 4) = acc[ai][0][m][1] * sc; } }
    }
};
struct EpiResid {
    static constexpr bool PERM = true, AFTER_DRAIN = false;
    bf16_t* X; float* SSQ; float fac;
    __device__ __forceinline__ void operator()(const f32x4 (&acc)[2][2][4][2], const Unit& u, int wr, int wc, int fr, int fq) const {
        const int row0 = u.pm * BM + wr * 64 + fr, col0 = u.pn * BM + wc * 32 + 8 * fq;
#pragma unroll
        for (int ai = 0; ai < 2; ++ai)
#pragma unroll
            for (int m = 0; m < 4; ++m) { const int row = row0 + ai * HALF + m * 16; const size_t off = (size_t)row * DM + col0; float ss = 0.f;
#pragma unroll
                for (int bj = 0; bj < 2; ++bj) { float f[8]; unpack8(*(const u32x4*)(X + off + bj * HALF), f);
                    const f32x4 v0 = (f32x4){f[0], f[1], f[2], f[3]} + acc[ai][bj][m][0] * fac, v1 = (f32x4){f[4], f[5], f[6], f[7]} + acc[ai][bj][m][1] * fac;
                    *(u32x4*)(X + off + bj * HALF) = pack8(v0, v1);
                    ss += ((v0.x * v0.x + v0.y * v0.y) + (v0.z * v0.z + v0.w * v0.w)) + ((v1.x * v1.x + v1.y * v1.y) + (v1.z * v1.z + v1.w * v1.w)); }
                ss = xrow16_sum(ss);
                if (SSQ && fq == 0) SSQ[(size_t)row * 32 + u.pn * 4 + wc] = ss; }
    }
};
struct EpiTail {
    static constexpr bool PERM = true, AFTER_DRAIN = false;
    EpiWin in;
    __device__ __forceinline__ void operator()(const f32x4 (&acc)[2][2][4][2], const Unit& u, int wr, int wc, int fr, int fq) const { const Unit t{u.pm, 16}; in(acc, t, wr, wc, fr, fq); }
};
}

#define XB_TMO      128
#define XB_XCNT(j)  (256  + 64 * (j))
#define XB_XSUB(j)  (1280 + 64 * (j))
#define XB_XGEN(j)  (2304 + 64 * (j))
#define XB_TOP      3328
#define XB_TOPGEN   3392
#define XCD_BAR_WORDS 3456
#define XB_SPIN_CAP (1u << 25)
__device__ __forceinline__ unsigned xb_ld(unsigned* p)              { return __hip_atomic_load(p, __ATOMIC_RELAXED, __HIP_MEMORY_SCOPE_AGENT); }
__device__ __forceinline__ unsigned xb_add(unsigned* p, unsigned v) { return __hip_atomic_fetch_add(p, v, __ATOMIC_RELAXED, __HIP_MEMORY_SCOPE_AGENT); }
__device__ __forceinline__ unsigned xb_xcc_id() { return (unsigned)__builtin_amdgcn_s_getreg((3 << 11) | 20) & 0xFu; }
#define XB_SPIN(cond, bar) do { unsigned _sp = 0; while (cond) { __builtin_amdgcn_s_sleep(1); \
    if ((++_sp & 255u) == 0u) { if (xb_ld(&(bar)[XB_TMO])) break; if (_sp > XB_SPIN_CAP) { atomicAdd(&(bar)[XB_TMO], 1u); break; } } } } while (0)
struct XcdBarrier { unsigned* bar; unsigned x; volatile LAS unsigned* st; };
__device__ __forceinline__ XcdBarrier xcd_barrier_post(unsigned* bar, volatile LAS unsigned* st) {
    XcdBarrier b; b.bar = bar; b.x = xb_xcc_id(); b.st = st;
    if (threadIdx.x == 0) (void)xb_add(&bar[XB_XCNT(b.x)], 1u);
    return b;
}
__device__ __forceinline__ void xcd_barrier_complete(unsigned* bar, unsigned x, unsigned& nloc, unsigned& nx) {
    const unsigned G = gridDim.x * gridDim.y * gridDim.z;
    unsigned sum, cnt, mine, sp = 0u;
    for (;;) {
        sum = 0u; cnt = 0u; mine = 0u;
#pragma unroll
        for (unsigned j = 0; j < 16; ++j) { const unsigned c = xb_ld(&bar[XB_XCNT(j)]); sum += c; cnt += (c > 0u) ? 1u : 0u; mine = (j == x) ? c : mine; }
        if (sum == G) break;
        __builtin_amdgcn_s_sleep(1);
        if ((++sp & 255u) == 0u) { if (xb_ld(&bar[XB_TMO])) break; if (sp > XB_SPIN_CAP) { atomicAdd(&bar[XB_TMO], 1u); break; } }
    }
    nloc = mine > 0u ? mine : 1u; nx = cnt > 0u ? cnt : 1u;
}
__device__ __forceinline__ void xcd_barrier(const XcdBarrier& b, bool is_t0) {
    asm volatile("s_waitcnt vmcnt(0)" ::: "memory");
    __syncthreads();
    if (is_t0) {
        unsigned* bar = b.bar;
        __builtin_amdgcn_s_waitcnt(0);
        unsigned nloc = b.st[0], nx = b.st[1];
        if (nloc == 0u) { xcd_barrier_complete(bar, b.x, nloc, nx); b.st[0] = nloc; b.st[1] = nx; }
        const unsigned old = xb_add(&bar[XB_XSUB(b.x)], 1u);
        const unsigned gen = old / nloc;
        if (old + 1u == (gen + 1u) * nloc) {
            __builtin_amdgcn_fence(__ATOMIC_RELEASE, "agent");
            asm volatile("s_waitcnt vmcnt(0)" ::: "memory");
            const unsigned og = xb_add(&bar[XB_TOP], 1u);
            const unsigned tg = og / nx;
            if (og + 1u == (tg + 1u) * nx) xb_add(&bar[XB_TOPGEN], 1u);
            else XB_SPIN(xb_ld(&bar[XB_TOPGEN]) == tg, bar);
            __builtin_amdgcn_fence(__ATOMIC_ACQUIRE, "agent");
            xb_add(&bar[XB_XGEN(b.x)], 1u);
            asm volatile("s_waitcnt vmcnt(0)" ::: "memory");
        } else {
            XB_SPIN(xb_ld(&bar[XB_XGEN(b.x)]) == gen, bar);
            __builtin_amdgcn_fence(__ATOMIC_ACQUIRE, "agent");
            asm volatile("s_waitcnt vmcnt(0)" ::: "memory");
        }
    }
    __syncthreads();
}

struct Args {
    const float* in[39]; const int* pos; float* out; unsigned char* ws; int ph_lo, ph_hi;
};
struct Frame {
    LAS unsigned char* lds; int tid, lane, wave, G, bid, gw, NGW;
    GAS unsigned char* ws;
};
#define WSP(T, off) ((T*)(F.ws + (off)))

__device__ __forceinline__ void transpose_item(const float* W, int K, int N, bf16_t* WT, int ldt, int dst_row0, const float* gain, LAS float* scr, int k0, int n0, int lane) {
    const int n4 = (lane & 7) * 4; const bool ok = n0 + n4 < N;
    f32x4 v[8];
#pragma unroll
    for (int i = 0; i < 8; ++i) { const int kk = (lane >> 3) + 8 * i; v[i] = ok ? *(const f32x4*)(W + (size_t)(k0 + kk) * N + n0 + n4) : (f32x4){0.f, 0.f, 0.f, 0.f}; }
#pragma unroll
    for (int i = 0; i < 8; ++i) { const int kk = (lane >> 3) + 8 * i; const float gg = gain ? gain[k0 + kk] : 1.f; LAS float* s = scr + kk * 33 + n4; s[0] = v[i].x * gg; s[1] = v[i].y * gg; s[2] = v[i].z * gg; s[3] = v[i].w * gg; }
    asm volatile("s_waitcnt lgkmcnt(0)" ::: "memory");
    const int c = lane & 7;
#pragma unroll
    for (int j = 0; j < 4; ++j) { const int n = (lane >> 3) + 8 * j; const LAS float* s = scr + (8 * c) * 33 + n;
        u32x4 o; o.x = cvt_pk_bf16(s[0 * 33], s[1 * 33]); o.y = cvt_pk_bf16(s[2 * 33], s[3 * 33]); o.z = cvt_pk_bf16(s[4 * 33], s[5 * 33]); o.w = cvt_pk_bf16(s[6 * 33], s[7 * 33]);
        *(u32x4*)(WT + (size_t)(dst_row0 + n) * ldt + k0 + 8 * c) = o; }
    asm volatile("s_waitcnt lgkmcnt(0)" ::: "memory");
}
__device__ __forceinline__ void transpose_matrix(Frame& F, const float* W, int K, int N, bf16_t* WT, int row_off, const float* gain, LAS float* scr) {
    const int nblk = (N + 31) / 32, items = (K / 64) * nblk;
    for (int it = F.gw; it < items; it += F.NGW) { const int kb = it / nblk, nb = it % nblk; transpose_item(W, K, N, WT, K, row_off + nb * 32, gain, scr, kb * 64, nb * 32, F.lane); }
}
__device__ __forceinline__ int win_dst_row(int n0) {
    if (n0 < 1024) return n0; if (n0 < 1088) return 4096 + (n0 - 1024); if (n0 < 2112) return 1024 + (n0 - 1088); if (n0 < 4160) return 2048 + (n0 - 2112); return 4160;
}
__device__ __forceinline__ void rowstat_row(const float* xrow, bf16_t* orow, float* rstd_out, int lane) {
    f32x4 v[8]; float s = 0.f;
#pragma unroll
    for (int j = 0; j < 8; ++j) v[j] = *(const f32x4*)(xrow + j * 256 + lane * 4);
#pragma unroll
    for (int j = 0; j < 8; ++j) s += (v[j].x * v[j].x + v[j].y * v[j].y) + (v[j].z * v[j].z + v[j].w * v[j].w);
    s = wave_sum(s, lane);
#pragma unroll
    for (int j = 0; j < 8; ++j) { u32x2 o; o.x = cvt_pk_bf16(v[j].x, v[j].y); o.y = cvt_pk_bf16(v[j].z, v[j].w); *(u32x2*)(orow + j * 256 + lane * 4) = o; }
    if (lane == 0) *rstd_out = s;
}
__device__ __forceinline__ void rowstat_phase(Frame& F, const float* X, bf16_t* XB, float* RSTD, int nrows) {
    for (int m = F.gw; m < nrows; m += F.NGW) rowstat_row(X + (size_t)m * DM, XB + (size_t)m * DM, RSTD + m, F.lane);
}

constexpr int PEER_V4_MASK = 3;
constexpr int PEER_U4_MASK = 3;
constexpr int TCONV_G = 256, TCONV_FIRST = 64, TCONV_BLOCKS = 128;
__device__ __forceinline__ void convert_table_rows(Frame& F, const Args& a, int r0, int r1, int w0, int nw) {
    if (r0 + w0 >= r1) return;
    const int l = r0 / PEER_E;
    const bool u4 = (PEER_U4_MASK >> l) & 1, v4 = (PEER_V4_MASK >> l) & 1;
    f32x4 vg[8];
    { const float* gain = a.in[6] + l * 2048;
#pragma unroll
      for (int q = 0; q < 8; ++q) vg[q] = *(const f32x4*)(gain + q * 256 + F.lane * 4); }
    f32x4 nu[8], nv[8];
#define CV_LOAD(row) do { _Pragma("unroll") for (int q = 0; q < 8; ++q) { const size_t o_ = (size_t)(row) * 2048 + q * 256 + F.lane * 4; nu[q] = *(const f32x4*)(a.in[14] + o_); nv[q] = *(const f32x4*)(a.in[15] + o_); } } while (0)
    unsigned pu[8], pv[8]; float su = 0.f, sv = 0.f; int rp = r0 + w0;
#define CV_STORE() do { const int er_ = rp % PEER_E; unsigned char* du_ = WSP(unsigned char, WS_U8) + (size_t)l * PEER_E * 2048 + (size_t)er_ * 128; unsigned char* dv_ = WSP(unsigned char, WS_V8) + (size_t)l * PEER_E * 2048 + (size_t)er_ * 128; \
        _Pragma("unroll") for (int q = 0; q < 8; ++q) { const size_t so_ = (size_t)(q * 2 + (F.lane >> 5)) * PEER_E * 128 + (F.lane & 31) * 4, s4_ = (size_t)q * PEER_E * 128 + (F.lane >> 1) * 4; \
            if (!u4) *(unsigned*)(du_ + so_) = pu[q]; else if ((F.lane & 1) == 0) *(unsigned*)(du_ + s4_) = pu[q]; \
            if (!v4) *(unsigned*)(dv_ + so_) = pv[q]; else if ((F.lane & 1) == 0) *(unsigned*)(dv_ + s4_) = pv[q]; } \
        if (F.lane == 0) { WSP(float, WS_TSC)[rp] = su; WSP(float, WS_TSC)[(size_t)2 * PEER_E + rp] = sv; } } while (0)
#define S8(x, s) (((unsigned)(int)__builtin_rintf((x) * (s))) & 0xffu)
#define T4(x, s) ((unsigned)(((int)__builtin_rintf((x) * (s)) + o8) & 0xF))
#define CV_PACK(row) do { float mu = 0.f, mv = 0.f; \
        _Pragma("unroll") for (int i = 0; i < 8; ++i) { vu[i] = vu[i] * vg[i]; \
            mu = fmaxf(fmaxf(mu, fmaxf(fabsf(vu[i].x), fabsf(vu[i].y))), fmaxf(fabsf(vu[i].z), fabsf(vu[i].w))); \
            mv = fmaxf(fmaxf(mv, fmaxf(fabsf(vv[i].x), fabsf(vv[i].y))), fmaxf(fabsf(vv[i].z), fabsf(vv[i].w))); } \
        mu = wave_max(mu); mv = wave_max(mv); \
        const float iu = mu > 0.f ? (u4 ? 7.f : 127.f) / mu : 0.f, iv = mv > 0.f ? (v4 ? 7.f : 127.f) / mv : 0.f; const int o8 = (F.lane & 1) ? 0 : 8; \
        _Pragma("unroll") for (int q = 0; q < 8; ++q) { const f32x4 x = vu[q], y = vv[q]; \
            if (!u4) pu[q] = S8(x.x, iu) | (S8(x.y, iu) << 8) | (S8(x.z, iu) << 16) | (S8(x.w, iu) << 24); \
            else { const unsigned nb = T4(x.x, iu) | (T4(x.y, iu) << 8) | (T4(x.z, iu) << 16) | (T4(x.w, iu) << 24); pu[q] = nb | ((unsigned)dppi<0xB1>((int)nb) << 4); }        \
            if (!v4) pv[q] = S8(y.x, iv) | (S8(y.y, iv) << 8) | (S8(y.z, iv) << 16) | (S8(y.w, iv) << 24); \
            else { const unsigned nb = T4(y.x, iv) | (T4(y.y, iv) << 8) | (T4(y.z, iv) << 16) | (T4(y.w, iv) << 24); pv[q] = nb | ((unsigned)dppi<0xB1>((int)nb) << 4); } } \
        su = mu * (u4 ? 1.f / 7.f : 1.f / 127.f); sv = mv * (v4 ? 1.f / 7.f : 1.f / 127.f); rp = (row); } while (0)
    CV_LOAD(r0 + w0);
    { f32x4 vu[8], vv[8];
#pragma unroll
      for (int q = 0; q < 8; ++q) { vu[q] = nu[q]; vv[q] = nv[q]; }
      { const int rn = r0 + w0 + nw < r1 ? r0 + w0 + nw : r0 + w0; CV_LOAD(rn); }
      CV_PACK(r0 + w0); }
#pragma unroll 1
    for (int r = r0 + w0 + nw; r < r1; r += nw) {
        f32x4 vu[8], vv[8];
#pragma unroll
        for (int q = 0; q < 8; ++q) { vu[q] = nu[q]; vv[q] = nv[q]; }
        CV_STORE();
        { const int rn = r + nw < r1 ? r + nw : r; CV_LOAD(rn); }
        CV_PACK(r);
    }
    CV_STORE();
#undef CV_LOAD
#undef CV_STORE
#undef CV_PACK
#undef S8
#undef T4
}
__device__ __forceinline__ void transpose_matrix_w(int w0, int nw, int lane, const float* W, int K, int N, bf16_t* WT, const float* gain, LAS float* scr) {
    const int nblk = (N + 31) / 32, items = (K / 64) * nblk;
    for (int it = w0; it < items; it += nw) { const int kb = it / nblk, nb = it % nblk; transpose_item(W, K, N, WT, K, nb * 32, gain, scr, kb * 64, nb * 32, lane); }
}
__device__ __forceinline__ void p_layer1_weights(Frame& F, const Args& a, int w0, int nw) {
    LAS float* scr = (LAS float*)(F.lds + F.wave * 16384);
    transpose_matrix_w(w0, nw, F.lane, a.in[30], 2048, 6144, WSP(bf16_t, WS_WQKV), a.in[3] + 2048, scr);
    transpose_matrix_w(w0, nw, F.lane, a.in[38], 2048, 2048, WSP(bf16_t, WS_WO), nullptr, scr);
    transpose_matrix_w(w0, nw, F.lane, a.in[7] + (size_t)2048 * 512, 2048, 512, WSP(bf16_t, WS_WMEMQ) + (size_t)512 * 2048, a.in[4] + 2048, scr);
    transpose_matrix_w(w0, nw, F.lane, a.in[11] + (size_t)512 * 2048, 512, 2048, WSP(bf16_t, WS_WMEMO) + (size_t)2048 * 512, nullptr, scr);
    transpose_matrix_w(w0, nw, F.lane, a.in[12] + (size_t)2048 * 2048, 2048, 2048, WSP(bf16_t, WS_WPEERQ) + (size_t)2048 * 2048, a.in[6] + 2048, scr);
}
__device__ __forceinline__ void p_layer0_late_weights(Frame& F, const Args& a, int w0, int nw) {
    LAS float* scr = (LAS float*)(F.lds + F.wave * 16384);
    transpose_matrix_w(w0, nw, F.lane, a.in[29], 2048, 2048, WSP(bf16_t, WS_WOUT), nullptr, scr);
    transpose_matrix_w(w0, nw, F.lane, a.in[7], 2048, 512, WSP(bf16_t, WS_WMEMQ), a.in[4], scr);
    transpose_matrix_w(w0, nw, F.lane, a.in[11], 512, 2048, WSP(bf16_t, WS_WMEMO), nullptr, scr);
    transpose_matrix_w(w0, nw, F.lane, a.in[12], 2048, 2048, WSP(bf16_t, WS_WPEERQ), a.in[6], scr);
}
__device__ __forceinline__ void p_prologue(Frame& F, const Args& a) {
    LAS float* scr = (LAS float*)(F.lds + F.wave * 16384);
    {
        const float* W = a.in[16]; const float* gain = a.in[3]; bf16_t* WT = WSP(bf16_t, WS_WIN);
        const int nblk = 131, items = 32 * nblk;
        for (int it = F.gw; it < items; it += F.NGW) { const int kb = it / nblk, nb = it % nblk; transpose_item(W, 2048, EVEN_IN, WT, 2048, win_dst_row(nb * 32), gain, scr, kb * 64, nb * 32, F.lane); }
        for (int i = F.gw * 64 + F.lane; i < (4352 - 4192) * 2048 / 8; i += F.NGW * 64) *(u32x4*)(WT + (size_t)4192 * 2048 + (size_t)i * 8) = (u32x4){0u, 0u, 0u, 0u};
    }
    transpose_matrix(F, a.in[19], 512, 1536, WSP(bf16_t, WS_WUQ), 0, a.in[17], scr);
    transpose_matrix(F, a.in[20], 512, 2048, WSP(bf16_t, WS_WUKV), 0, a.in[18], scr);
    if (F.G != TCONV_G) p_layer0_late_weights(F, a, F.gw, F.NGW);
    for (int l = 0; l < 2; ++l) transpose_matrix(F, a.in[8] + (size_t)l * 2048 * 1024, 2048, 1024, WSP(bf16_t, WS_WMEMKV) + (size_t)l * 1024 * 2048, 0, a.in[5] + l * 2048, scr);
    if (F.G != TCONV_G) p_layer1_weights(F, a, F.gw, F.NGW);
    { const float* src = a.in[13]; bf16_t* dst = WSP(bf16_t, WS_KEYS); const int n8 = 2 * 8 * 2 * 128 * 128 / 8;
      for (int i = F.gw * 64 + F.lane; i < n8; i += F.NGW * 64) *(u32x4*)(dst + (size_t)i * 8) = pack8(*(const f32x4*)(src + (size_t)i * 8), *(const f32x4*)(src + (size_t)i * 8 + 4)); }
    if (F.G != TCONV_G) { convert_table_rows(F, a, 0, PEER_E, F.gw, F.NGW); convert_table_rows(F, a, PEER_E, 2 * PEER_E, F.gw, F.NGW); }
    { f32x2* r32 = WSP(f32x2, WS_ROPE32); f32x2* r64 = WSP(f32x2, WS_ROPE64);
      for (int i = F.gw * 64 + F.lane; i < TOK * 96; i += F.NGW * 64) { const int t = i / 96, j = i % 96; const bool is32 = j < 32; const int jj = is32 ? j : j - 32; const float half = is32 ? 32.f : 64.f;
          const float inv = 1.0f / exp2f(((float)jj / half) * 13.287712379549449f);
          const float ang = (float)a.pos[t] * inv;
          double rv = (double)ang * 0.15915494309189535; rv -= __builtin_rint(rv);
          const float fr = (float)rv; const f32x2 cs = {__builtin_amdgcn_cosf(fr), __builtin_amdgcn_sinf(fr)};
          if (is32) r32[(size_t)t * 32 + jj] = cs; else r64[(size_t)t * 64 + jj] = cs; } }
    rowstat_phase(F, a.in[0], WSP(bf16_t, WS_XB), WSP(float, WS_RSTD), TOK);
    rowstat_phase(F, a.in[1], WSP(bf16_t, WS_MEMB), WSP(float, WS_RSTD_MEM), BATCH * NMEM);
}


namespace att {
__device__ __forceinline__ int crow(int r, int hi) { return (r & 3) + 8 * (r >> 2) + 4 * hi; }
template <int ND> __device__ __forceinline__ int v_st(int k, int c) { const int kk = (k & ~0xC) | ((k & 4) << 1) | ((k & 8) >> 1); return ((kk >> 3) * ND + (c >> 5)) * 512 + ((kk & 7) * 32 + (c & 31)) * 2; }
__device__ __forceinline__ int v_rd_base(int lane) { return ((lane & 3) << 3) | (((lane >> 2) & 3) << 6) | (((lane >> 4) & 1) << 5) | (((lane >> 5) & 1) << 8); }
#define ATT_TR(dst, off) asm volatile("ds_read_b64_tr_b16 %0, %1 offset:%2" : "=&v"(dst) : "v"(vb), "i"(off) : "memory")
#define ATT_PK(L, H) (bf16x8){L[0], L[1], L[2], L[3], H[0], H[1], H[2], H[3]}
template <int BASE> __device__ __forceinline__ bf16x8 att_pk4(const f32x16& P) {
    const unsigned a0 = cvt_pk_bf16(P[BASE + 0], P[BASE + 1]), a1 = cvt_pk_bf16(P[BASE + 2], P[BASE + 3]), b0 = cvt_pk_bf16(P[BASE + 4], P[BASE + 5]), b1 = cvt_pk_bf16(P[BASE + 6], P[BASE + 7]);
    auto r0 = __builtin_amdgcn_permlane32_swap(a0, b0, false, false); auto r1 = __builtin_amdgcn_permlane32_swap(a1, b1, false, false);
    const u32x4 w = {r0[0], r1[0], r0[1], r1[1]}; return __builtin_bit_cast(bf16x8, w);
}
template <int ND, int D0> __device__ __forceinline__ void sm_slice(f32x16& p1, float Cr, float mnC, float& ps1, bf16x8& pa2, bf16x8& pa3) {
    if constexpr (D0 + 1 < ND) { constexpr int R0 = D0 * 16 / (ND - 1), R1 = (D0 + 1) * 16 / (ND - 1);
#pragma unroll
        for (int r = R0; r < R1; ++r) p1[r] = __builtin_amdgcn_exp2f(fmaf(p1[r], Cr, mnC)); }
    else { ps1 = ((p1[0] + p1[1]) + (p1[2] + p1[3])) + ((p1[4] + p1[5]) + (p1[6] + p1[7])) + (((p1[8] + p1[9]) + (p1[10] + p1[11])) + ((p1[12] + p1[13]) + (p1[14] + p1[15])));
           pa2 = att_pk4<0>(p1); pa3 = att_pk4<8>(p1); }
}
template <int ND, int D0> struct PvB {
    static __device__ __forceinline__ void run(f32x16* o, int vb, bf16x8 pa2, bf16x8 pa3, s16x4& c0, s16x4& c1, s16x4& c2, s16x4& c3, s16x4& n0, s16x4& n1, s16x4& n2, s16x4& n3) {
        constexpr int KS = 2 * ND * 512, HF = ND * 512;
        if constexpr (D0 + 1 < ND) { constexpr int NB = (D0 + 1) * 512; ATT_TR(n0, NB + 2 * KS); ATT_TR(n1, NB + 2 * KS + HF); ATT_TR(n2, NB + 3 * KS); ATT_TR(n3, NB + 3 * KS + HF); asm volatile("s_waitcnt lgkmcnt(4)" ::: "memory"); }
        else asm volatile("s_waitcnt lgkmcnt(0)" ::: "memory");
        __builtin_amdgcn_sched_barrier(0);
        o[D0] = __builtin_amdgcn_mfma_f32_32x32x16_bf16(pa2, ATT_PK(c0, c1), o[D0], 0, 0, 0);
        o[D0] = __builtin_amdgcn_mfma_f32_32x32x16_bf16(pa3, ATT_PK(c2, c3), o[D0], 0, 0, 0);
        __builtin_amdgcn_sched_barrier(0);
        if constexpr (D0 + 1 < ND) PvB<ND, D0 + 1>::run(o, vb, pa2, pa3, n0, n1, n2, n3, c0, c1, c2, c3);
    }
};
template <int ND, int D0> struct PvA {
    static __device__ __forceinline__ void run(f32x16* o, int vb, bf16x8 pa0, bf16x8 pa1, bf16x8& pa2, bf16x8& pa3, f32x16& p1, float Cr, float mnC, float& ps1,
                                               s16x4& c0, s16x4& c1, s16x4& c2, s16x4& c3, s16x4& n0, s16x4& n1, s16x4& n2, s16x4& n3) {
        constexpr int KS = 2 * ND * 512, HF = ND * 512;
        if constexpr (D0 + 1 < ND) { constexpr int NB = (D0 + 1) * 512; ATT_TR(n0, NB); ATT_TR(n1, NB + HF); ATT_TR(n2, NB + KS); ATT_TR(n3, NB + KS + HF); }
        else { ATT_TR(n0, 2 * KS); ATT_TR(n1, 2 * KS + HF); ATT_TR(n2, 3 * KS); ATT_TR(n3, 3 * KS + HF); }
        asm volatile("s_waitcnt lgkmcnt(4)" ::: "memory"); __builtin_amdgcn_sched_barrier(0);
        o[D0] = __builtin_amdgcn_mfma_f32_32x32x16_bf16(pa0, ATT_PK(c0, c1), o[D0], 0, 0, 0);
        o[D0] = __builtin_amdgcn_mfma_f32_32x32x16_bf16(pa1, ATT_PK(c2, c3), o[D0], 0, 0, 0);
        __builtin_amdgcn_sched_barrier(0);
        sm_slice<ND, D0>(p1, Cr, mnC, ps1, pa2, pa3);
        __builtin_amdgcn_sched_barrier(0);
        if constexpr (D0 + 1 < ND) PvA<ND, D0 + 1>::run(o, vb, pa0, pa1, pa2, pa3, p1, Cr, mnC, ps1, n0, n1, n2, n3, c0, c1, c2, c3);
        else PvB<ND, 0>::run(o, vb, pa2, pa3, n0, n1, n2, n3, c0, c1, c2, c3);
    }
};
template <int ND> __device__ __forceinline__ void pv_all(f32x16* o, int vb, bf16x8 pa0, bf16x8 pa1, f32x16& p1, float Cr, float mnC, float& ps1) {
    constexpr int KS = 2 * ND * 512, HF = ND * 512;
    s16x4 a0, a1, a2, a3, b0, b1, b2, b3; bf16x8 pa2, pa3;
    ATT_TR(a0, 0); ATT_TR(a1, HF); ATT_TR(a2, KS); ATT_TR(a3, KS + HF);
    PvA<ND, 0>::run(o, vb, pa0, pa1, pa2, pa3, p1, Cr, mnC, ps1, a0, a1, a2, a3, b0, b1, b2, b3);
}
template <int DQK, int DV, bool CAUSAL, bool QNORM = false, int NRP = 0, bool DIFFC = false>
__device__ __forceinline__ void attn_unit(LAS unsigned char* lds, const bf16_t* __restrict__ Qb, int ldq, const bf16_t* __restrict__ Kh, int ldk, const bf16_t* __restrict__ Vh, int ldv,
                                          bf16_t* __restrict__ Ob, int ldo, int NT, int q0, float C, int tid_in, const float* __restrict__ qgain = nullptr, const f32x2* __restrict__ qrope = nullptr,
                                          const bf16_t* O1b = nullptr, bf16_t* Mb = nullptr, int ldm = 0, float dlam = 0.f, const float* __restrict__ cgain = nullptr, float cscale = 1.f) {
    constexpr int NQ = DQK / 16, ND = DV / 32, RBK = DQK * 2, SHM_K = 64 * RBK, SHM_V = 64 * DV * 2;
    constexpr int KCH = DQK / 8, VCH = DV / 8, NKS = 64 * KCH / 512, NVS = 64 * VCH / 512, OST = 128 + 8;
    int tid = tid_in; asm volatile("" : "+v"(tid));
    const int wid = tid >> 6, lane = tid & 63, r32 = lane & 31, hi = lane >> 5;
    LAS float* wsf = (LAS float*)lds + wid * 64; LAS float* li_l = wsf; LAS float* al_l = wsf + 32;
    LAS unsigned char* V_lds = lds + 2048; LAS unsigned char* K_lds = lds + 2048 + 2 * SHM_V;
    float m_reg = -1e30f, l_reg = 0.f; f32x16 o[ND]; bf16x8 qr[NQ];
#pragma unroll
    for (int d = 0; d < ND; ++d)
#pragma unroll
        for (int r = 0; r < 16; ++r) o[d][r] = 0.f;
    { const int qoff = (wid * 32 + r32) * ldq + hi * 8;
#pragma unroll
      for (int d0 = 0; d0 < NQ; ++d0) qr[d0] = *(const bf16x8*)(Qb + (qoff + d0 * 16)); }
    if constexpr (NRP > 0) {
        constexpr int D0R = (DQK - 2 * NRP) / 16, NRD = NRP / 16;
        f32x4 cs[NRD][4];
#pragma unroll
        for (int dd = 0; dd < NRD; ++dd)
#pragma unroll
            for (int e2 = 0; e2 < 4; ++e2) cs[dd][e2] = *(const f32x4*)(qrope + ((wid * 32 + r32) * NRP + dd * 16 + hi * 8 + e2 * 2));
        float ss = 0.f;
#pragma unroll
        for (int d0 = 0; d0 < NQ; ++d0) { float f[8]; unpack8(__builtin_bit_cast(u32x4, qr[d0]), f);
#pragma unroll
            for (int e = 0; e < 8; ++e) ss += f[e] * f[e]; }
        { auto rr = __builtin_amdgcn_permlane32_swap(__float_as_uint(ss), __float_as_uint(ss), false, false); ss = __uint_as_float(rr[0]) + __uint_as_float(rr[1]); }
        const float rs = 1.0f / sqrtf(ss * (1.f / DQK) + EPS);
#define ATT_QG(f, d0) do { const f32x4 g0_ = *(const f32x4*)(qgain + (d0) * 16 + hi * 8), g1_ = *(const f32x4*)(qgain + (d0) * 16 + hi * 8 + 4); \
            f[0] *= rs * g0_.x; f[1] *= rs * g0_.y; f[2] *= rs * g0_.z; f[3] *= rs * g0_.w; f[4] *= rs * g1_.x; f[5] *= rs * g1_.y; f[6] *= rs * g1_.z; f[7] *= rs * g1_.w; } while (0)
#define ATT_QP(f) __builtin_bit_cast(bf16x8, pack8((f32x4){f[0], f[1], f[2], f[3]}, (f32x4){f[4], f[5], f[6], f[7]}))
#pragma unroll
        for (int d0 = 0; d0 < D0R; ++d0) { float f[8]; unpack8(__builtin_bit_cast(u32x4, qr[d0]), f); ATT_QG(f, d0); qr[d0] = ATT_QP(f); }
#pragma unroll
        for (int dd = 0; dd < NRD; ++dd) { const int d0 = D0R + dd, d1 = d0 + NRD; float fa[8], fb[8]; unpack8(__builtin_bit_cast(u32x4, qr[d0]), fa); unpack8(__builtin_bit_cast(u32x4, qr[d1]), fb); ATT_QG(fa, d0); ATT_QG(fb, d1);
#pragma unroll
            for (int e2 = 0; e2 < 4; ++e2) { const f32x4 c = cs[dd][e2];
                const float a0 = fa[2 * e2], b0 = fb[2 * e2], a1 = fa[2 * e2 + 1], b1 = fb[2 * e2 + 1];
                fa[2 * e2] = a0 * c.x - b0 * c.y; fb[2 * e2] = b0 * c.x + a0 * c.y; fa[2 * e2 + 1] = a1 * c.z - b1 * c.w; fb[2 * e2 + 1] = b1 * c.z + a1 * c.w; }
            qr[d0] = ATT_QP(fa); qr[d1] = ATT_QP(fb); }
#undef ATT_QG
#undef ATT_QP
    }
    float Cr = C;
    if constexpr (QNORM) { float ss = 0.f;
#pragma unroll
        for (int d0 = 0; d0 < NQ; ++d0) { float f[8]; unpack8(__builtin_bit_cast(u32x4, qr[d0]), f);
#pragma unroll
            for (int e = 0; e < 8; ++e) ss += f[e] * f[e]; }
        { auto rr = __builtin_amdgcn_permlane32_swap(__float_as_uint(ss), __float_as_uint(ss), false, false); ss = __uint_as_float(rr[0]) + __uint_as_float(rr[1]); }
        Cr = C / sqrtf(ss * (1.f / DQK) + EPS); }
    const int widu = __builtin_amdgcn_readfirstlane(wid); int kgo[NKS], vgo[NVS];
#pragma unroll
    for (int i = 0; i < NKS; ++i) { const int s = (i * 8 + wid) * 64 + lane, row = s / KCH, pos = s % KCH, ch = pos ^ (row & 7); kgo[i] = row * ldk + ch * 8; }
#pragma unroll
    for (int i = 0; i < NVS; ++i) { const int s = (i * 8 + wid) * 64 + lane, sub = s >> 5, within = s & 31, kk = (sub / ND) * 8 + (within >> 2), k = (kk & ~0xC) | ((kk & 4) << 1) | ((kk & 8) >> 1), c = (sub % ND) * 32 + (within & 3) * 8; vgo[i] = k * ldv + c; }
#define ATT_DMA(b, k0) do { const bf16_t* kb_ = Kh + (size_t)(k0) * ldk; const bf16_t* vb_ = Vh + (size_t)(k0) * ldv; \
        _Pragma("unroll") for (int i = 0; i < NKS; ++i) __builtin_amdgcn_global_load_lds((const unsigned*)(kb_ + kgo[i]), (LAS unsigned*)(K_lds + (b) * SHM_K + (i * 8 + widu) * 1024), 16, 0, 0); \
        _Pragma("unroll") for (int i = 0; i < NVS; ++i) __builtin_amdgcn_global_load_lds((const unsigned*)(vb_ + vgo[i]), (LAS unsigned*)(V_lds + (b) * SHM_V + (i * 8 + widu) * 1024), 16, 0, 0); } while (0)
    const int vb0 = (int)(uintptr_t)V_lds + v_rd_base(lane);
    ATT_DMA(0, 0);
    if (widu >= 4) __builtin_amdgcn_s_setprio(1);
    for (int j = 0; j < NT; ++j) {
        asm volatile("s_waitcnt vmcnt(0)" ::: "memory");
        __syncthreads();
        if (j + 1 < NT) ATT_DMA((j + 1) & 1, (j + 1) * 64);
        if (CAUSAL && 64 * j > q0 + widu * 32 + 31) continue;
        __builtin_amdgcn_sched_barrier(0);
        f32x16 p0, p1;
#pragma unroll
        for (int r = 0; r < 16; ++r) { p0[r] = 0.f; p1[r] = 0.f; }
        { const LAS unsigned char* Ks = K_lds + (j & 1) * SHM_K;
          bf16x8 kb0 = *(const LAS bf16x8*)(Ks + r32 * RBK + ((hi * 16) ^ ((r32 & 7) << 4))), kb1 = *(const LAS bf16x8*)(Ks + (32 + r32) * RBK + ((hi * 16) ^ ((r32 & 7) << 4)));
          __builtin_amdgcn_sched_barrier(0);
#pragma unroll
          for (int d0 = 0; d0 < NQ; ++d0) { const int cb = ((d0 + 1) * 16 + hi * 8) * 2; bf16x8 nb0 = kb0, nb1 = kb1;
              if (d0 + 1 < NQ) { nb0 = *(const LAS bf16x8*)(Ks + r32 * RBK + (cb ^ ((r32 & 7) << 4))); nb1 = *(const LAS bf16x8*)(Ks + (32 + r32) * RBK + (cb ^ ((r32 & 7) << 4))); }
              p0 = __builtin_amdgcn_mfma_f32_32x32x16_bf16(kb0, qr[d0], p0, 0, 0, 0);
              p1 = __builtin_amdgcn_mfma_f32_32x32x16_bf16(kb1, qr[d0], p1, 0, 0, 0);
              __builtin_amdgcn_sched_group_barrier(0x100, 2, 0); __builtin_amdgcn_sched_group_barrier(0x008, 2, 0);
              kb0 = nb0; kb1 = nb1; } }
        if (CAUSAL) {
            if (64 * j + 63 > q0 + wid * 32) { const int lim = q0 + wid * 32 + r32 - 64 * j - 4 * hi;
#pragma unroll
                for (int r = 0; r < 16; ++r) { if ((r & 3) + 8 * (r >> 2) > lim) p0[r] = -1e30f; if ((r & 3) + 8 * (r >> 2) + 32 > lim) p1[r] = -1e30f; } } }
        __builtin_amdgcn_sched_barrier(0);
        float pmax = p0[0];
#pragma unroll
        for (int r = 1; r < 16; ++r) pmax = fmaxf(pmax, p0[r]);
#pragma unroll
        for (int r = 0; r < 16; ++r) pmax = fmaxf(pmax, p1[r]);
        { auto rr = __builtin_amdgcn_permlane32_swap(__float_as_uint(pmax), __float_as_uint(pmax), false, false); pmax = fmaxf(__uint_as_float(rr[0]), __uint_as_float(rr[1])); }
        float alpha = 1.f;
        if (!__all((pmax - m_reg) * Cr <= 11.541560327f)) { const float mn = fmaxf(m_reg, pmax); alpha = __builtin_amdgcn_exp2f((m_reg - mn) * Cr); m_reg = mn; }
        if (__any(alpha < 1.f)) { if (hi == 0) al_l[r32] = alpha; asm volatile("s_waitcnt lgkmcnt(0)" ::: "memory");
#pragma unroll
            for (int r = 0; r < 16; ++r) { const float af = al_l[crow(r, hi)];
#pragma unroll
                for (int d = 0; d < ND; ++d) o[d][r] *= af; } }
        const float mnC = -m_reg * Cr; float ps = 0.f, ps1 = 0.f;
#pragma unroll
        for (int r = 0; r < 16; ++r) { p0[r] = __builtin_amdgcn_exp2f(fmaf(p0[r], Cr, mnC)); ps += p0[r]; }
        const bf16x8 pa0 = att_pk4<0>(p0), pa1 = att_pk4<8>(p0);
        __builtin_amdgcn_sched_barrier(0);
        pv_all<ND>(o, vb0 + (j & 1) * SHM_V, pa0, pa1, p1, Cr, mnC, ps1);
        ps += ps1;
        { auto rr = __builtin_amdgcn_permlane32_swap(__float_as_uint(ps), __float_as_uint(ps), false, false); ps = __uint_as_float(rr[0]) + __uint_as_float(rr[1]); }
        l_reg = l_reg * alpha + ps;
    }
#undef ATT_DMA
    __builtin_amdgcn_s_setprio(0);
    __syncthreads();
    {
    const int lane = lane_id(), r32 = lane & 31, hi = lane >> 5, wid = widu; LAS float* li_l = (LAS float*)lds + widu * 64;
    if (hi == 0) li_l[r32] = l_reg;
    asm volatile("s_waitcnt lgkmcnt(0)" ::: "memory");
    LAS bf16_t* ost = (LAS bf16_t*)(lds + 2048) + wid * (32 * OST);
    if constexpr (DIFFC) { if (dlam != 0.f) {
        u32x4 vp[2][8]; float ss[8];
        __builtin_amdgcn_fence(__ATOMIC_ACQUIRE, "workgroup");
#pragma unroll
        for (int i = 0; i < 8; ++i) ss[i] = 0.f;
#pragma unroll
        for (int hb = 0; hb < 2; ++hb) {
#pragma unroll
            for (int r = 0; r < 16; ++r) { const int row = crow(r, hi); const float inv = __builtin_amdgcn_rcpf(li_l[row]);
#pragma unroll
                for (int d = 0; d < 4; ++d) ost[row * OST + d * 32 + r32] = f2bf(o[4 * hb + d][r] * inv); }
            asm volatile("s_waitcnt lgkmcnt(0)" ::: "memory");
            u32x4 w1[8];
#pragma unroll
            for (int i = 0; i < 8; ++i) { const int cc = lane + 64 * i, row = cc / 16, ch = cc % 16;
                w1[i] = *(const u32x4*)(O1b + ((wid * 32 + row) * ldo + hb * 128 + ch * 8)); }
#pragma unroll
            for (int i = 0; i < 8; ++i) { const int cc = lane + 64 * i, row = cc / 16, ch = cc % 16; float f1[8], f2[8];
                unpack8(w1[i], f1); unpack8(*(const LAS u32x4*)(ost + row * OST + ch * 8), f2);
#pragma unroll
                for (int e = 0; e < 8; ++e) { f1[e] -= dlam * f2[e]; ss[i] += f1[e] * f1[e]; }
                vp[hb][i] = pack8((f32x4){f1[0], f1[1], f1[2], f1[3]}, (f32x4){f1[4], f1[5], f1[6], f1[7]}); }
            asm volatile("s_waitcnt lgkmcnt(0)" ::: "memory");
        }
#pragma unroll
        for (int i = 0; i < 8; ++i) { float t = row16_sum(ss[i]); ss[i] = cscale / sqrtf(t * (1.f / 256.f) + EPS); }
#pragma unroll
        for (int hb = 0; hb < 2; ++hb)
#pragma unroll
            for (int i = 0; i < 8; ++i) { const int cc = lane + 64 * i, row = cc / 16, ch = cc % 16; float f[8]; unpack8(vp[hb][i], f);
                const f32x4 g0 = *(const f32x4*)(cgain + hb * 128 + ch * 8), g1 = *(const f32x4*)(cgain + hb * 128 + ch * 8 + 4); const float rs = ss[i];
                *(u32x4*)(Mb + ((wid * 32 + row) * ldm + hb * 128 + ch * 8)) = pack8((f32x4){f[0], f[1], f[2], f[3]} * rs * g0, (f32x4){f[4], f[5], f[6], f[7]} * rs * g1); }
        __syncthreads();
        return; } }
#pragma unroll
    for (int hb = 0; hb < ND / 4; ++hb) {
#pragma unroll
        for (int r = 0; r < 16; ++r) { const int row = crow(r, hi); const float inv = __builtin_amdgcn_rcpf(li_l[row]);
#pragma unroll
            for (int d = 0; d < 4; ++d) ost[row * OST + d * 32 + r32] = f2bf(o[4 * hb + d][r] * inv); }
        asm volatile("s_waitcnt lgkmcnt(0)" ::: "memory");
#pragma unroll
        for (int i = 0; i < 32 * 16 / 64; ++i) { const int cc = lane + 64 * i, row = cc / 16, ch = cc % 16;
            const u32x4 w = *(const LAS u32x4*)(ost + row * OST + ch * 8); const int ooff = (wid * 32 + row) * ldo + hb * 128 + ch * 8; *(u32x4*)(Ob + ooff) = w; }
        asm volatile("s_waitcnt lgkmcnt(0)" ::: "memory");
    }
    }
    __syncthreads();
}
}

__device__ __forceinline__ void p_prepA(Frame& F, const Args& a, int u0, int nu) {
    const bf16_t* XBC = WSP(bf16_t, WS_XBC); bf16_t* XC = WSP(bf16_t, WS_XBCC);
    const bf16_t* CQ = WSP(bf16_t, WS_CQ); const bf16_t* CKV = WSP(bf16_t, WS_CKV);
    float* RCQ = WSP(float, WS_RSTD_CQ); float* RCKV = WSP(float, WS_RSTD_CKV); const float* TAIL = WSP(float, WS_TAIL); float* DT = WSP(float, WS_DT);
    const float* cw = a.in[23]; const float* cb = a.in[24]; const float* dtb = a.in[25];
    const int cg = F.tid & 255, half = F.tid >> 8, c0 = cg * 8;
    float w[4][8], bs[8];
#pragma unroll
    for (int e = 0; e < 8; ++e) { bs[e] = cb[c0 + e];
#pragma unroll
        for (int j = 0; j < 4; ++j) w[j][e] = cw[j * 2048 + c0 + e]; }
    for (int u = u0; u < TOK / 64; u += nu) {
        const int t0 = u * 64 + half * 32;
        float x0[8], x1[8], x2[8], x3[8];
        if ((t0 & (SEQ - 1)) == 0) {
#pragma unroll
            for (int e = 0; e < 8; ++e) { x0[e] = 0.f; x1[e] = 0.f; x2[e] = 0.f; }
        } else {
            unpack8(*(const u32x4*)(XBC + (size_t)(t0 - 3) * 2048 + c0), x0); unpack8(*(const u32x4*)(XBC + (size_t)(t0 - 2) * 2048 + c0), x1); unpack8(*(const u32x4*)(XBC + (size_t)(t0 - 1) * 2048 + c0), x2);
        }
#pragma unroll 1
        for (int i8 = 0; i8 < 32; i8 += 16) {
            u32x4 rr[16];
#pragma unroll
            for (int q = 0; q < 16; ++q) rr[q] = *(const u32x4*)(XBC + (size_t)(t0 + i8 + q) * 2048 + c0);
#pragma unroll
            for (int q = 0; q < 16; ++q) { unpack8(rr[q], x3); float o[8];
#pragma unroll
                for (int e = 0; e < 8; ++e) { o[e] = silu_f(bs[e] + w[0][e] * x0[e] + w[1][e] * x1[e] + w[2][e] * x2[e] + w[3][e] * x3[e]); x0[e] = x1[e]; x1[e] = x2[e]; x2[e] = x3[e]; }
                u32x4 pk; pk.x = cvt_pk_bf16(o[0], o[1]); pk.y = cvt_pk_bf16(o[2], o[3]); pk.z = cvt_pk_bf16(o[4], o[5]); pk.w = cvt_pk_bf16(o[6], o[7]);
                *(u32x4*)(XC + (size_t)(t0 + i8 + q) * 2048 + c0) = pk; }
        }
        { u32x4 rq[8], rk[8];
#pragma unroll
          for (int k = 0; k < 8; ++k) { const size_t t = (size_t)u * 64 + F.wave * 8 + k; rq[k] = *(const u32x4*)(CQ + t * 512 + F.lane * 8); rk[k] = *(const u32x4*)(CKV + t * 512 + F.lane * 8); }
#pragma unroll
          for (int k = 0; k < 8; ++k) { const int t = u * 64 + F.wave * 8 + k; float f[8], g[8]; unpack8(rq[k], f); unpack8(rk[k], g); float sq = 0.f, sk = 0.f;
#pragma unroll
              for (int e = 0; e < 8; ++e) { sq += f[e] * f[e]; sk += g[e] * g[e]; }
              sq = wave_sum(sq, F.lane); sk = wave_sum(sk, F.lane);
              if (F.lane == 0) { RCQ[t] = 1.0f / sqrtf(sq * (1.f / 512.f) + EPS); RCKV[t] = 1.0f / sqrtf(sk * (1.f / 512.f) + EPS); } } }
    }
}
__device__ __forceinline__ void p_prep_late(Frame& F, const Args& a) {
    const float* TAIL = WSP(float, WS_TAIL); float* DT = WSP(float, WS_DT); const float* dtb = a.in[25];
    for (int i = F.gw * 64 + F.lane; i < TOK * 16; i += F.NGW * 64) { const int t = i >> 4, h = i & 15; const float v = TAIL[(size_t)t * 80 + 64 + h] + dtb[h];
        DT[i] = fmaxf(v, 0.f) + log1pf(expf(-fabsf(v))); }
    for (int r = F.gw; r < 2 * BATCH * NMEM; r += F.NGW) { const int l = r / (BATCH * NMEM); bf16_t* p = WSP(bf16_t, WS_MEMKV) + (size_t)r * 1024 + F.lane * 8; const float* kg = a.in[10] + l * 128 + (F.lane & 15) * 8; const float* qg = a.in[9] + l * 128 + (F.lane & 15) * 8;
        float f[8]; unpack8(*(const u32x4*)p, f); float s = 0.f;
#pragma unroll
        for (int e = 0; e < 8; ++e) s += f[e] * f[e];
        s = row16_sum(s);
        const float rs = 1.0f / sqrtf(s * (1.f / 128.f) + EPS);
        u32x4 pk; pk.x = cvt_pk_bf16(f[0] * rs * kg[0] * qg[0], f[1] * rs * kg[1] * qg[1]); pk.y = cvt_pk_bf16(f[2] * rs * kg[2] * qg[2], f[3] * rs * kg[3] * qg[3]); pk.z = cvt_pk_bf16(f[4] * rs * kg[4] * qg[4], f[5] * rs * kg[5] * qg[5]); pk.w = cvt_pk_bf16(f[6] * rs * kg[6] * qg[6], f[7] * rs * kg[7] * qg[7]);
        *(u32x4*)p = pk; }
}
__device__ __forceinline__ void p_prepB(Frame& F, const Args& a) {
    const bf16_t* KV = WSP(bf16_t, WS_KV); bf16_t* KM = WSP(bf16_t, WS_KM); const float* TAIL = WSP(float, WS_TAIL); const f32x2* R32 = WSP(f32x2, WS_ROPE32);
    const float* kg = a.in[22];
    const int g = F.lane >> 3, i = F.lane & 7;
    for (int t = F.gw; t < TOK; t += F.NGW) {
        f32x2 cs[8];
        const bf16_t* ksrc = KV + (size_t)t * 2048 + g * 256;
        const u32x4 rk0 = *(const u32x4*)(ksrc + 8 * i), rk1 = *(const u32x4*)(ksrc + 64 + 8 * i);
        const f32x4 r0 = *(const f32x4*)(TAIL + (size_t)t * 80 + 8 * i), r1 = *(const f32x4*)(TAIL + (size_t)t * 80 + 8 * i + 4);
#pragma unroll
        for (int e = 0; e < 8; ++e) cs[e] = R32[(size_t)t * 32 + 8 * (i & 3) + e];
        float v0[8], v1[8], v2[8];
        unpack8(rk0, v0); unpack8(rk1, v1);
        v2[0] = r0.x; v2[1] = r0.y; v2[2] = r0.z; v2[3] = r0.w; v2[4] = r1.x; v2[5] = r1.y; v2[6] = r1.z; v2[7] = r1.w;
        float s = 0.f;
#pragma unroll
        for (int e = 0; e < 8; ++e) s += v0[e] * v0[e] + v1[e] * v1[e] + v2[e] * v2[e];
        s = row8_sum(s);
        const float rs = 1.0f / sqrtf(s * (1.f / 192.f) + EPS);
        float o2[8];
#pragma unroll
        for (int e = 0; e < 8; ++e) { v0[e] *= rs * kg[8 * i + e]; v1[e] *= rs * kg[64 + 8 * i + e]; v2[e] *= rs * kg[128 + 8 * i + e]; }
#pragma unroll
        for (int e = 0; e < 8; ++e) { const float pv = shx(v2[e], 4, F.lane); o2[e] = (i < 4) ? v2[e] * cs[e].x - pv * cs[e].y : v2[e] * cs[e].x + pv * cs[e].y; }
        bf16_t* dst = KM + (size_t)t * 1536 + g * 192;
        u32x4 pk; pk.x = cvt_pk_bf16(v0[0], v0[1]); pk.y = cvt_pk_bf16(v0[2], v0[3]); pk.z = cvt_pk_bf16(v0[4], v0[5]); pk.w = cvt_pk_bf16(v0[6], v0[7]); *(u32x4*)(dst + 8 * i) = pk;
        pk.x = cvt_pk_bf16(v1[0], v1[1]); pk.y = cvt_pk_bf16(v1[2], v1[3]); pk.z = cvt_pk_bf16(v1[4], v1[5]); pk.w = cvt_pk_bf16(v1[6], v1[7]); *(u32x4*)(dst + 64 + 8 * i) = pk;
        pk.x = cvt_pk_bf16(o2[0], o2[1]); pk.y = cvt_pk_bf16(o2[2], o2[3]); pk.z = cvt_pk_bf16(o2[4], o2[5]); pk.w = cvt_pk_bf16(o2[6], o2[7]); *(u32x4*)(dst + 128 + 8 * i) = pk;
    }
}
__device__ __forceinline__ bf16x8 tr_frag(int a0, int a1) {
    s16x4 lo, hi2; asm volatile("ds_read_b64_tr_b16 %0, %2\n\tds_read_b64_tr_b16 %1, %3\n\ts_waitcnt lgkmcnt(0)" : "=&v"(lo), "=&v"(hi2) : "v"(a0), "v"(a1) : "memory");
    return (bf16x8){lo[0], lo[1], lo[2], lo[3], hi2[0], hi2[1], hi2[2], hi2[3]};
}
__device__ __forceinline__ void ssd_item(Frame& F, const Args& a, int it) {
    const bf16_t* XC = WSP(bf16_t, WS_XBCC); const float* DT = WSP(float, WS_DT); const bf16_t* Z = WSP(bf16_t, WS_Z); bf16_t* YG = WSP(bf16_t, WS_YG);
    constexpr int SBN = 272, SXD = 144;
    constexpr int O_BN = 0, O_CN = 17408, O_XD = 34816, O_HB = 44032, O_ACS = 61440, O_YO = 61952, O_XR = 78336, O_ZR = 78336 + 2 * 9216, NCH = SEQ / 64;
    int tid = F.tid; asm volatile("" : "+v"(tid));
    const int lane = tid & 63, wave = tid >> 6, r32 = lane & 31, hi = lane >> 5, gq = lane >> 4, li = lane & 15;
    const int h = it & 15, b = it >> 4, g = h >> 2;
    const float a_h = -expf(a.in[26][h]), dskip = a.in[27][h];
    LAS unsigned char* L = F.lds; const int Lb = (int)(uintptr_t)L;
    const int sl = tid >> 4, sc = tid & 15, xl = tid >> 3, xc = tid & 7;
    for (int i = tid; i < 64 * SBN / 4; i += NTHREADS) *(LAS unsigned*)(L + O_HB + i * 4) = 0u;
    f32x16 HT;
#pragma unroll
    for (int r = 0; r < 16; ++r) HT[r] = 0.f;
    u32x4 rb0, rb1, rc0, rc1, rx, rz; float rdt, rdtx;
#define SSD_LOAD(c) do { const size_t t0_ = (size_t)b * SEQ + (size_t)(c) * 64; \
        rb0 = *(const u32x4*)(XC + (t0_ + sl) * 2048 + 1024 + g * 128 + sc * 8); rb1 = *(const u32x4*)(XC + (t0_ + 32 + sl) * 2048 + 1024 + g * 128 + sc * 8); \
        rc0 = *(const u32x4*)(XC + (t0_ + sl) * 2048 + 1536 + g * 128 + sc * 8); rc1 = *(const u32x4*)(XC + (t0_ + 32 + sl) * 2048 + 1536 + g * 128 + sc * 8); \
        rx = *(const u32x4*)(XC + (t0_ + xl) * 2048 + h * 64 + xc * 8); rz = *(const u32x4*)(Z + (t0_ + xl) * 1024 + h * 64 + xc * 8); rdtx = DT[(t0_ + xl) * 16 + h]; rdt = DT[(t0_ + lane) * 16 + h]; } while (0)
    SSD_LOAD(0);
    f32x16 yd; float dAtot = 1.f; f32x16 ST;
#pragma unroll
    for (int r = 0; r < 16; ++r) { yd[r] = 0.f; ST[r] = 0.f; }
    const int trB = (li >> 2) * SBN + (16 * (gq & 1) + 4 * (li & 3)) * 2, trX = (li >> 2) * SXD + (16 * (gq & 1) + 4 * (li & 3)) * 2;
    for (int c = 0; c <= NCH; ++c) {
        if (c > 0) {
            if (wave < 4) { const int lb = wave & 1, pb = wave >> 1; const size_t t0_ = (size_t)b * SEQ + (size_t)(c - 1) * 64;
#pragma unroll
                for (int r = 0; r < 16; ++r) { const int l = 32 * lb + att::crow(r, hi), p = 32 * pb + r32; const size_t tr = t0_ + l;
                    const float yv = yd[r] + *(const LAS float*)(L + O_YO + (l * 64 + p) * 4);
                    const bf16_t xv = *(const LAS bf16_t*)(L + O_XR + ((c - 1) & 1) * 9216 + l * SXD + p * 2), zv = *(const LAS bf16_t*)(L + O_ZR + ((c - 1) & 1) * 9216 + l * SXD + p * 2);
                    YG[tr * 1024 + h * 64 + p] = f2bf((yv + dskip * bf2f(xv)) * silu_f(bf2f(zv))); } }
            const int nb = wave & 3, ph = wave >> 2;
#pragma unroll
            for (int r = 0; r < 16; ++r) HT[r] = HT[r] * dAtot + ST[r];
#pragma unroll
            for (int q = 0; q < 4; ++q) { u32x2 w; w.x = cvt_pk_bf16(HT[4 * q], HT[4 * q + 1]); w.y = cvt_pk_bf16(HT[4 * q + 2], HT[4 * q + 3]);
                *(LAS u32x2*)(L + O_HB + (32 * ph + r32) * SBN + (32 * nb + 8 * q + 4 * hi) * 2) = w; }
        }
        if (c == NCH) break;
        { *(LAS u32x4*)(L + O_BN + sl * SBN + sc * 16) = rb0; *(LAS u32x4*)(L + O_BN + (32 + sl) * SBN + sc * 16) = rb1;
          *(LAS u32x4*)(L + O_CN + sl * SBN + sc * 16) = rc0; *(LAS u32x4*)(L + O_CN + (32 + sl) * SBN + sc * 16) = rc1;
          float fx[8]; unpack8(rx, fx); u32x4 xw; xw.x = cvt_pk_bf16(fx[0] * rdtx, fx[1] * rdtx); xw.y = cvt_pk_bf16(fx[2] * rdtx, fx[3] * rdtx); xw.z = cvt_pk_bf16(fx[4] * rdtx, fx[5] * rdtx); xw.w = cvt_pk_bf16(fx[6] * rdtx, fx[7] * rdtx);
          *(LAS u32x4*)(L + O_XD + xl * SXD + xc * 16) = xw;
          *(LAS u32x4*)(L + O_XR + (c & 1) * 9216 + xl * SXD + xc * 16) = rx; *(LAS u32x4*)(L + O_ZR + (c & 1) * 9216 + xl * SXD + xc * 16) = rz;
          if (wave == 0) { float v = rdt * a_h;
              v += __int_as_float(__builtin_amdgcn_update_dpp(0, __float_as_int(v), 0x111, 0xf, 0xf, false)); v += __int_as_float(__builtin_amdgcn_update_dpp(0, __float_as_int(v), 0x112, 0xf, 0xf, false));
              v += __int_as_float(__builtin_amdgcn_update_dpp(0, __float_as_int(v), 0x114, 0xf, 0xf, false)); v += __int_as_float(__builtin_amdgcn_update_dpp(0, __float_as_int(v), 0x118, 0xf, 0xf, false));
              v += __int_as_float(__builtin_amdgcn_update_dpp(0, __float_as_int(v), 0x142, 0xa, 0xf, false)); v += __int_as_float(__builtin_amdgcn_update_dpp(0, __float_as_int(v), 0x143, 0xc, 0xf, false));
              *(LAS float*)(L + O_ACS + lane * 4) = v; } }
        __syncthreads();
        if (c + 1 < NCH) SSD_LOAD(c + 1);
        dAtot = fast_exp(*(const LAS float*)(L + O_ACS + 63 * 4));
        if (wave < 4) {
            const int lb = wave & 1, pb = wave >> 1;
#pragma unroll
            for (int r = 0; r < 16; ++r) yd[r] = 0.f;
            const float acl = *(const LAS float*)(L + O_ACS + (32 * lb + r32) * 4);
#pragma unroll
            for (int sb = 0; sb < 2; ++sb) { if (sb <= lb) {
                f32x16 X;
#pragma unroll
                for (int r = 0; r < 16; ++r) X[r] = 0.f;
#pragma unroll
                for (int ks = 0; ks < 8; ++ks) { const bf16x8 af = *(const LAS bf16x8*)(L + O_BN + (32 * sb + r32) * SBN + (16 * ks + 8 * hi) * 2), bfr = *(const LAS bf16x8*)(L + O_CN + (32 * lb + r32) * SBN + (16 * ks + 8 * hi) * 2);
                    X = __builtin_amdgcn_mfma_f32_32x32x16_bf16(af, bfr, X, 0, 0, 0); }
#pragma unroll
                for (int q = 0; q < 4; ++q) { const f32x4 as = *(const LAS f32x4*)(L + O_ACS + (32 * sb + 8 * q + 4 * hi) * 4);
#pragma unroll
                    for (int e = 0; e < 4; ++e) { const int r = 4 * q + e; float gv = X[r] * fast_exp(acl - as[e]); if (sb == lb && (8 * q + 4 * hi + e) > r32) gv = 0.f; X[r] = gv; } }
#pragma unroll
                for (int k2 = 0; k2 < 2; ++k2) { u32x4 aw; aw.x = cvt_pk_bf16(X[8 * k2], X[8 * k2 + 1]); aw.y = cvt_pk_bf16(X[8 * k2 + 2], X[8 * k2 + 3]); aw.z = cvt_pk_bf16(X[8 * k2 + 4], X[8 * k2 + 5]); aw.w = cvt_pk_bf16(X[8 * k2 + 6], X[8 * k2 + 7]);
                    const int xa = Lb + O_XD + (32 * sb + 16 * k2 + 4 * hi) * SXD + (32 * pb) * 2 + trX;
                    const bf16x8 bw = tr_frag(xa, xa + 8 * SXD);
                    yd = __builtin_amdgcn_mfma_f32_32x32x16_bf16(__builtin_bit_cast(bf16x8, aw), bw, yd, 0, 0, 0); } } }
        } else {
            const int lb = wave & 1, pb = (wave >> 1) & 1; f32x16 Y;
#pragma unroll
            for (int r = 0; r < 16; ++r) Y[r] = 0.f;
#pragma unroll
            for (int ks = 0; ks < 8; ++ks) { const bf16x8 af = *(const LAS bf16x8*)(L + O_CN + (32 * lb + r32) * SBN + (16 * ks + 8 * hi) * 2), bfr = *(const LAS bf16x8*)(L + O_HB + (32 * pb + r32) * SBN + (16 * ks + 8 * hi) * 2);
                Y = __builtin_amdgcn_mfma_f32_32x32x16_bf16(af, bfr, Y, 0, 0, 0); }
#pragma unroll
            for (int q = 0; q < 4; ++q) { const f32x4 al = *(const LAS f32x4*)(L + O_ACS + (32 * lb + 8 * q + 4 * hi) * 4);
#pragma unroll
                for (int e = 0; e < 4; ++e) *(LAS float*)(L + O_YO + ((32 * lb + 8 * q + 4 * hi + e) * 64 + 32 * pb + r32) * 4) = Y[4 * q + e] * fast_exp(al[e]); }
        }
        { const int nb = wave & 3, ph = wave >> 2; const float ac63 = *(const LAS float*)(L + O_ACS + 63 * 4);
#pragma unroll
          for (int r = 0; r < 16; ++r) ST[r] = 0.f;
#pragma unroll
          for (int ks = 0; ks < 4; ++ks) { const int l0 = 16 * ks + 8 * hi;
              const int ba = Lb + O_BN + l0 * SBN + (32 * nb) * 2 + trB; const bf16x8 af = tr_frag(ba, ba + 4 * SBN);
              const int xa = Lb + O_XD + l0 * SXD + (32 * ph) * 2 + trX; const bf16x8 xf = tr_frag(xa, xa + 4 * SXD);
              float fx[8]; unpack8(__builtin_bit_cast(u32x4, xf), fx);
              const f32x4 a0 = *(const LAS f32x4*)(L + O_ACS + l0 * 4), a1 = *(const LAS f32x4*)(L + O_ACS + (l0 + 4) * 4);
              u32x4 bw; bw.x = cvt_pk_bf16(fx[0] * fast_exp(ac63 - a0.x), fx[1] * fast_exp(ac63 - a0.y)); bw.y = cvt_pk_bf16(fx[2] * fast_exp(ac63 - a0.z), fx[3] * fast_exp(ac63 - a0.w));
              bw.z = cvt_pk_bf16(fx[4] * fast_exp(ac63 - a1.x), fx[5] * fast_exp(ac63 - a1.y)); bw.w = cvt_pk_bf16(fx[6] * fast_exp(ac63 - a1.z), fx[7] * fast_exp(ac63 - a1.w));
              ST = __builtin_amdgcn_mfma_f32_32x32x16_bf16(af, __builtin_bit_cast(bf16x8, bw), ST, 0, 0, 0); } }
        __syncthreads();
    }
    __syncthreads();
#undef SSD_LOAD
}
__device__ __forceinline__ void p_mla_ssd(Frame& F, const Args& a, unsigned* qctr, volatile LAS int* slot) {
    for (int it = F.bid; it < 64; it += F.G) ssd_item(F, a, it);
    if (F.G == TCONV_G && F.bid >= TCONV_FIRST && F.bid < TCONV_FIRST + TCONV_BLOCKS) { constexpr int RPB = (PEER_E + TCONV_BLOCKS - 1) / TCONV_BLOCKS; const int cb = F.bid - TCONV_FIRST;
        __syncthreads();
        p_layer0_late_weights(F, a, cb * 8 + F.wave, TCONV_BLOCKS * 8);
        p_layer1_weights(F, a, cb * 8 + F.wave, TCONV_BLOCKS * 8);
#pragma unroll 1
        for (int l = 0; l < 2; ++l) { const int rb = l * PEER_E + cb * RPB, re = rb + RPB < (l + 1) * PEER_E ? rb + RPB : (l + 1) * PEER_E; convert_table_rows(F, a, rb, re, F.wave, 8); }
        __syncthreads(); }
    const bf16_t* QM = WSP(bf16_t, WS_QM); const bf16_t* KM = WSP(bf16_t, WS_KM); const bf16_t* KV = WSP(bf16_t, WS_KV); bf16_t* MIX = WSP(bf16_t, WS_MIX);
    const float scale = 0.07216878364870322f;
#pragma unroll 1
    for (;;) {
        __syncthreads();
        if (F.tid == 0) *slot = (int)__hip_atomic_fetch_add(qctr, 1u, __ATOMIC_RELAXED, __HIP_MEMORY_SCOPE_AGENT);
        __syncthreads();
        const int idx = *slot;
        if (idx >= 512) break;
        const int qb = 15 - (idx >> 5), bh = idx & 31, b = bh >> 3, h = bh & 7, q0 = qb * 256; const size_t row0 = (size_t)b * SEQ + q0, kr0 = (size_t)b * SEQ;
        att::attn_unit<192, 128, true, false, 32>(F.lds, QM + row0 * 1536 + h * 192, 1536, KM + kr0 * 1536 + h * 192, 1536, KV + kr0 * 2048 + h * 256 + 128, 2048, MIX + row0 * 2048 + h * 128, 2048,
                                       4 * (qb + 1), q0, scale * 1.4426950408889634f, F.tid, a.in[21], WSP(f32x2, WS_ROPE32) + row0 * 32);
    }
}
__device__ __forceinline__ void p_ssd_norm(Frame& F, const Args& a) {
    const bf16_t* YG = WSP(bf16_t, WS_YG); bf16_t* MIX = WSP(bf16_t, WS_MIX); const float* gn = a.in[28] + F.lane * 8;
    for (int t = F.gw; t < TOK; t += F.NGW) { const bf16_t* p = YG + (size_t)t * 1024 + F.lane * 8;
        const u32x4 w0 = *(const u32x4*)p, w1 = *(const u32x4*)(p + 512); float f0[8], f1[8]; unpack8(w0, f0); unpack8(w1, f1); float s0 = 0.f, s1 = 0.f;
#pragma unroll
        for (int e = 0; e < 8; ++e) { s0 += f0[e] * f0[e]; s1 += f1[e] * f1[e]; }
        s0 = half_sum(s0); s1 = half_sum(s1);
        const float r0 = 1.0f / sqrtf(s0 * (1.f / 256.f) + EPS), r1 = 1.0f / sqrtf(s1 * (1.f / 256.f) + EPS);
        const f32x4 g00 = *(const f32x4*)gn, g01 = *(const f32x4*)(gn + 4), g10 = *(const f32x4*)(gn + 512), g11 = *(const f32x4*)(gn + 516);
        bf16_t* d = MIX + (size_t)t * 2048 + 1024 + F.lane * 8;
        *(u32x4*)d = pack8((f32x4){f0[0], f0[1], f0[2], f0[3]} * r0 * g00, (f32x4){f0[4], f0[5], f0[6], f0[7]} * r0 * g01);
        *(u32x4*)(d + 512) = pack8((f32x4){f1[0], f1[1], f1[2], f1[3]} * r1 * g10, (f32x4){f1[4], f1[5], f1[6], f1[7]} * r1 * g11); }
}
__device__ __forceinline__ void p_attn_mem(Frame& F, int layer) {
    const bf16_t* MQ = WSP(bf16_t, WS_MEMQ); const bf16_t* MKV = WSP(bf16_t, WS_MEMKV) + (size_t)layer * 1024 * 1024; bf16_t* MO = WSP(bf16_t, WS_MEMO);
    const float scale = 0.08838834764831845f;
    for (int it = F.bid; it < 256; it += F.G) { const int h = it & 3, qb = (it >> 2) & 15, b = it >> 6; const size_t row0 = (size_t)b * SEQ + qb * 256;
        att::attn_unit<128, 128, false, true>(F.lds, MQ + row0 * 512 + h * 128, 512, MKV + (size_t)b * 256 * 1024 + h * 128, 1024, MKV + (size_t)b * 256 * 1024 + 512 + h * 128, 1024, MO + row0 * 512 + h * 128, 512,
                                              4, 0, scale * 1.4426950408889634f, F.tid); }
}
__device__ __forceinline__ unsigned ordf(float x) { const unsigned u = __float_as_uint(x); return u ^ ((unsigned)((int)u >> 31) | 0x80000000u); }
__device__ __forceinline__ float unordf(unsigned k) { return __uint_as_float((k & 0x80000000u) ? (k ^ 0x80000000u) : ~k); }
#define TK_CS(a, b) do { const unsigned hi_ = (a) > (b) ? (a) : (b); const unsigned lo_ = (a) > (b) ? (b) : (a); (a) = hi_; (b) = lo_; } while (0)
__device__ __forceinline__ void tk_sort16(unsigned (&a)[16]) {
#pragma unroll
    for (int k = 2; k <= 16; k <<= 1)
#pragma unroll
        for (int j = k >> 1; j > 0; j >>= 1)
#pragma unroll
            for (int i = 0; i < 16; ++i) { const int l = i ^ j; if (l > i) { if ((i & k) == 0) TK_CS(a[i], a[l]); else TK_CS(a[l], a[i]); } }
}
__device__ __forceinline__ void tk_merge16(unsigned (&L)[16], const unsigned (&B)[16]) {
#pragma unroll
    for (int i = 0; i < 16; ++i) L[i] = L[i] > B[15 - i] ? L[i] : B[15 - i];
#pragma unroll
    for (int j = 8; j > 0; j >>= 1)
#pragma unroll
        for (int i = 0; i < 16; ++i) { const int l = i ^ j; if (l > i) TK_CS(L[i], L[l]); }
}
__device__ __forceinline__ void p_peer_topk(Frame& F, int layer) {
    const bf16_t* PQ = WSP(bf16_t, WS_PQ); const bf16_t* KEYS = WSP(bf16_t, WS_KEYS) + (size_t)layer * 8 * 2 * 128 * 128; int* EXPo = WSP(int, WS_EXP); float* GATEo = WSP(float, WS_GATE);
    LAS float* sc = (LAS float*)(F.lds + F.wave * 16384);
    const bool u4 = (PEER_U4_MASK >> layer) & 1;
#pragma unroll 1
    for (int pass = 0; pass < 2; ++pass) {
    if ((pass ^ (F.bid & 1)) == 0) {
    for (int t = F.gw; t < TOK; t += F.NGW) { const int lane = F.lane; const bf16_t* xrow = WSP(bf16_t, WS_XB) + (size_t)t * 2048; float f[32]; float mx = 0.f; int xsum = 0;
#pragma unroll
        for (int c = 0; c < 2; ++c) { float g8[8]; unpack8(*(const u32x4*)(xrow + (c * 1024 + lane * 16)), g8);
#pragma unroll
            for (int j = 0; j < 8; ++j) f[c * 16 + j] = g8[j];
            unpack8(*(const u32x4*)(xrow + (c * 1024 + lane * 16 + 8)), g8);
#pragma unroll
            for (int j = 0; j < 8; ++j) f[c * 16 + 8 + j] = g8[j]; }
#pragma unroll
        for (int j = 0; j < 32; ++j) mx = fmaxf(mx, fabsf(f[j]));
        mx = wave_max(mx);
        const float inv = mx > 0.f ? 127.f / mx : 0.f;
#pragma unroll
        for (int c = 0; c < 2; ++c) { u32x4 w; unsigned* wp = (unsigned*)&w;
#pragma unroll
            for (int q = 0; q < 4; ++q) { unsigned v = 0u;
#pragma unroll
                for (int e = 0; e < 4; ++e) v |= (((unsigned)(int)__builtin_rintf(f[c * 16 + q * 4 + e] * inv)) & 0xffu) << (8 * e);
                wp[q] = v; }
            if (!u4) *(u32x4*)(WSP(unsigned char, WS_XQ) + ((size_t)(c * 8 + (lane >> 3)) * TOK + t) * 128 + (lane & 7) * 16) = w;
            else *(u32x4*)(WSP(unsigned char, WS_XQ) + ((size_t)(c * 4 + (lane >> 4)) * TOK + t) * 256 + (lane & 15) * 16) = w;
#pragma unroll
            for (int q = 0; q < 4; q += 2) xsum = __builtin_amdgcn_sdot4((int)wp[q], 0x01010101, xsum, false); }
        if (u4) {
            xsum = wave_sum_i(xsum);
            if (lane == 0) WSP(int, WS_SX)[t] = xsum; }
        const float ssq = wave_sum(lane < 32 ? WSP(float, WS_SSQ2)[(size_t)t * 32 + lane] : 0.f, lane);
        if (lane == 0) WSP(float, WS_XS)[t] = mx * (1.f / 127.f) / sqrtf(ssq * (1.f / 2048.f) + EPS); }
    } else {
    for (int it = F.gw; it < (TOK / 32) * 8; it += F.NGW) {
        int lane = lane_id(); asm volatile("" : "+v"(lane));
        const int r32 = lane & 31, hi = lane >> 5, h = it & 7, t0 = (it >> 3) * 32;
        unsigned KF[2][16];
#pragma unroll 1
        for (int p = 0; p < 2; ++p) {
            const bf16_t* qp = PQ + (size_t)(t0) * 2048 + h * 256 + p * 128; const int qo = r32 * 2048 + hi * 8; bf16x8 qf[8], af[8], an[8];
#pragma unroll
            for (int k = 0; k < 8; ++k) qf[k] = *(const bf16x8*)(qp + (qo + k * 16));
            const bf16_t* kp = KEYS + (size_t)(h * 2 + p) * 128 * 128; const int ko = r32 * 128 + hi * 8;
#pragma unroll
            for (int k = 0; k < 8; ++k) af[k] = *(const bf16x8*)(kp + (ko + k * 16));
            unsigned L[16];
#pragma unroll
            for (int i = 0; i < 16; ++i) L[i] = 0u;
#pragma unroll 1
            for (int nb = 0; nb < 4; ++nb) { f32x16 acc;
#pragma unroll
                for (int r = 0; r < 16; ++r) acc[r] = 0.f;
#pragma unroll
                for (int k = 0; k < 8; ++k) acc = __builtin_amdgcn_mfma_f32_32x32x16_bf16(af[k], qf[k], acc, 0, 0, 0);
                if (nb < 3) {
#pragma unroll
                    for (int k = 0; k < 8; ++k) an[k] = *(const bf16x8*)(kp + ((nb + 1) * 32 * 128 + ko + k * 16)); }
                const int nbase = 127 - (nb * 32 + 4 * hi); unsigned Bk[16];
#pragma unroll
                for (int r = 0; r < 16; ++r) Bk[r] = (ordf(acc[r]) & 0xFFFFFF80u) | (unsigned)(nbase - ((r & 3) + 8 * (r >> 2)));
                tk_sort16(Bk); tk_merge16(L, Bk);
#pragma unroll
                for (int k = 0; k < 8; ++k) af[k] = an[k];
            }
            unsigned P[16];
#pragma unroll
            for (int i = 0; i < 16; ++i) { auto sw_ = __builtin_amdgcn_permlane32_swap(L[i], L[i], false, false); P[i] = hi ? sw_[0] : sw_[1]; }
            tk_merge16(L, P);
            if (p == 0) {
#pragma unroll
                for (int i = 0; i < 16; ++i) KF[0][i] = L[i];
            } else {
#pragma unroll
                for (int i = 0; i < 16; ++i) KF[1][i] = L[i]; }
        }
        float s0[16], s1[16];
#pragma unroll
        for (int i = 0; i < 16; ++i) { s0[i] = unordf(KF[0][i] & 0xFFFFFF80u); s1[i] = unordf(KF[1][i] & 0xFFFFFF80u);
            sc[i * 64 + lane] = __int_as_float(127 - (int)(KF[0][i] & 127u)); sc[(16 + i) * 64 + lane] = __int_as_float(127 - (int)(KF[1][i] & 127u)); }
        unsigned Cn[16], Cb[16];
#define TK_CAND(i, j) ((ordf(s0[i] + s1[j]) & 0xFFFFFF00u) | (unsigned)(255 - ((i) * 16 + (j))))
        { int c = 0;
#pragma unroll
          for (int i = 0; i < 16; ++i)
#pragma unroll
              for (int j = 0; j < 16; ++j) if ((i + 1) * (j + 1) <= 16) { if (c < 16) Cn[c] = TK_CAND(i, j); ++c; } }
        tk_sort16(Cn);
#pragma unroll
        for (int grp = 1; grp < 4; ++grp) { int c = 0;
#pragma unroll
            for (int q = 0; q < 16; ++q) Cb[q] = 0u;
#pragma unroll
            for (int i = 0; i < 16; ++i)
#pragma unroll
                for (int j = 0; j < 16; ++j) if ((i + 1) * (j + 1) <= 16) { if (c >= grp * 16 && c < grp * 16 + 16) Cb[c - grp * 16] = TK_CAND(i, j); ++c; }
            tk_sort16(Cb); tk_merge16(Cn, Cb); }
#undef TK_CAND
        float bs[16]; int ex[16]; float mx = unordf(Cn[0] & 0xFFFFFF00u), sum = 0.f;
#pragma unroll
        for (int k = 0; k < 16; ++k) { const int c = 255 - (int)(Cn[k] & 255u); const int n0 = __float_as_int(sc[(c >> 4) * 64 + lane]), n1 = __float_as_int(sc[(16 + (c & 15)) * 64 + lane]);
            ex[k] = n0 * 128 + n1; bs[k] = fast_exp(unordf(Cn[k] & 0xFFFFFF00u) - mx); sum += bs[k]; }
        const float inv = 1.0f / sum;
        if (hi == 0) { int* ep = EXPo + (size_t)(t0 + r32) * 128 + h * 16; float* gp = GATEo + (size_t)(t0 + r32) * 128 + h * 16;
#pragma unroll
            for (int k = 0; k < 16; k += 4) { *(int4*)(ep + k) = make_int4(ex[k], ex[k + 1], ex[k + 2], ex[k + 3]); *(f32x4*)(gp + k) = (f32x4){bs[k] * inv, bs[k + 1] * inv, bs[k + 2] * inv, bs[k + 3] * inv}; } }
    }
    } }
}
#define UB0(x) ((float)((x) & 0xffu))
#define UB1(x) ((float)(((x) >> 8) & 0xffu))
#define UB2(x) ((float)(((x) >> 16) & 0xffu))
#define UB3(x) ((float)((x) >> 24))
template <bool U4> __device__ __forceinline__ void p_peer_u(Frame& F, int layer, unsigned* qbase) {
    const unsigned char* U8 = WSP(unsigned char, WS_U8) + (size_t)layer * PEER_E * 2048; const unsigned char* XQ = WSP(unsigned char, WS_XQ); const int* EXPi = WSP(int, WS_EXP); short* PD = WSP(short, WS_PD);
    const int xcc = (int)xb_xcc_id();
#pragma unroll 1
    for (int ri = 0; ri < (U4 ? 8 : 16); ++ri) {
        const int sl = U4 ? ((xcc + ri) & 7) : ((xcc + 8 * (ri & 1) + (ri >> 1)) & 15);
        const unsigned char* Us = U8 + (size_t)sl * PEER_E * 128; const unsigned char* Xs = XQ + (size_t)sl * TOK * (U4 ? 256 : 128); short* PDs = PD + (size_t)sl * TOK * 128;
#pragma unroll 1
        for (;;) {
            int lane = lane_id(); asm volatile("" : "+v"(lane));
            int chunk = 0; if (lane == 0) chunk = (int)__hip_atomic_fetch_add(qbase + sl * 64, 1u, __ATOMIC_RELAXED, __HIP_MEMORY_SCOPE_AGENT);
            chunk = __builtin_amdgcn_readfirstlane(chunk);
            if (chunk >= TOK / 32) break;
            const int r = lane >> 3, c = lane & 7; const bool c4 = c & 4, c2 = c & 2, c1 = c & 1;
            u32x4 en[4]; u32x4 xn, xn2 = {0u, 0u, 0u, 0u};
#define U_EXP(dst, tok) do { const int* ep_ = EXPi + (tok) * 128 + 8 * r; dst[0] = *(const u32x4*)ep_; dst[1] = *(const u32x4*)(ep_ + 4); dst[2] = *(const u32x4*)(ep_ + 64); dst[3] = *(const u32x4*)(ep_ + 68); } while (0)
            { const size_t t_ = (size_t)chunk * 32; U_EXP(en, t_); if constexpr (U4) { xn = *(const u32x4*)(Xs + (t_ * 256 + c * 32)); xn2 = *(const u32x4*)(Xs + (t_ * 256 + c * 32 + 16)); } else xn = *(const u32x4*)(Xs + (t_ * 128 + c * 16)); }
#pragma unroll 1
            for (int ti = 0; ti < 32; ++ti) {
                const size_t t = (size_t)chunk * 32 + ti; const u32x4 e0 = en[0], e1 = en[1], e2 = en[2], e3 = en[3]; const u32x4 xv = xn, xv2 = xn2; (void)xv2;
                if (ti + 1 < 32) { U_EXP(en, t + 1); if constexpr (U4) { xn = *(const u32x4*)(Xs + ((t + 1) * 256 + c * 32)); xn2 = *(const u32x4*)(Xs + ((t + 1) * 256 + c * 32 + 16)); } else xn = *(const u32x4*)(Xs + ((t + 1) * 128 + c * 16)); }
                u32x4 R[16];
#pragma unroll
                for (int g = 0; g < 16; ++g) { const u32x4 ev = g < 4 ? e0 : (g < 8 ? e1 : (g < 12 ? e2 : e3)); const int ek = (int)ev[g & 3]; R[g] = *(const u32x4*)(Us + (ek * 128 + c * 16)); }
                int part[16];
#pragma unroll
                for (int g = 0; g < 16; ++g) {
                    if constexpr (U4) { int d = 0, dh = 0;
#define U4_DW(w, xa, xb) d = __builtin_amdgcn_sdot4((int)((w) & 0x0F0F0F0Fu), (int)(xa), d, false); dh = __builtin_amdgcn_sdot4((int)((w) & 0xF0F0F0F0u), (int)(xb), dh, false)
                        U4_DW(R[g].x, xv.x, xv.y); U4_DW(R[g].y, xv.z, xv.w); U4_DW(R[g].z, xv2.x, xv2.y); U4_DW(R[g].w, xv2.z, xv2.w);
#undef U4_DW
                        part[g] = d + (dh >> 4); }
                    else { int d = __builtin_amdgcn_sdot4((int)R[g].x, (int)xv.x, 0, false); d = __builtin_amdgcn_sdot4((int)R[g].y, (int)xv.y, d, false);
                        d = __builtin_amdgcn_sdot4((int)R[g].z, (int)xv.z, d, false); part[g] = __builtin_amdgcn_sdot4((int)R[g].w, (int)xv.w, d, false); } }
#pragma unroll
                for (int hh = 0; hh < 2; ++hh) { int q4[4], q2[2];
#pragma unroll
                    for (int i = 0; i < 4; ++i) q4[i] = (c4 ? part[8 * hh + 4 + i] : part[8 * hh + i]) + __builtin_amdgcn_update_dpp(0, c4 ? part[8 * hh + i] : part[8 * hh + 4 + i], 0x141, 0xf, 0xf, false);
#pragma unroll
                    for (int i = 0; i < 2; ++i) q2[i] = (c2 ? q4[2 + i] : q4[i]) + __builtin_amdgcn_update_dpp(0, c2 ? q4[i] : q4[2 + i], 0x4E, 0xf, 0xf, false);
                    const int q1 = (c1 ? q2[1] : q2[0]) + __builtin_amdgcn_update_dpp(0, c1 ? q2[0] : q2[1], 0xB1, 0xf, 0xf, false);
                    const int qs = (q1 + 2) >> 2; PDs[t * 128 + 64 * hh + lane] = (short)(qs > 32767 ? 32767 : (qs < -32767 ? -32767 : qs)); }
            }
        }
    }
}
#undef U_EXP
__device__ __forceinline__ void p_peer_fin(Frame& F, int layer) {
    const float* USC = WSP(float, WS_TSC) + (size_t)layer * PEER_E; const float* VSC = WSP(float, WS_TSC) + (size_t)(2 + layer) * PEER_E;
    const short* PD = WSP(short, WS_PD); const float* XS = WSP(float, WS_XS); const int* EXPi = WSP(int, WS_EXP); const float* GATEi = WSP(float, WS_GATE);
    const bool u4 = (PEER_U4_MASK >> layer) & 1;
    for (int t = F.gw; t < TOK; t += F.NGW) { const int lane = F.lane; int s0 = 0, s1 = 0;
        if (!u4) {
#pragma unroll
            for (int s = 0; s < 16; ++s) { s0 += PD[((size_t)s * TOK + t) * 128 + lane]; s1 += PD[((size_t)s * TOK + t) * 128 + 64 + lane]; } }
        else { const int off = 2 * WSP(int, WS_SX)[t];
#pragma unroll
            for (int s = 0; s < 8; ++s) { s0 += PD[((size_t)s * TOK + t) * 128 + lane]; s1 += PD[((size_t)s * TOK + t) * 128 + 64 + lane]; }
            s0 -= off; s1 -= off; }
        const int e0 = EXPi[(size_t)t * 128 + lane], e1 = EXPi[(size_t)t * 128 + 64 + lane]; const float xs = XS[t];
        const float w0 = gelu_f((float)s0 * 4.f * USC[e0] * xs) * GATEi[(size_t)t * 128 + lane] * VSC[e0], w1 = gelu_f((float)s1 * 4.f * USC[e1] * xs) * GATEi[(size_t)t * 128 + 64 + lane] * VSC[e1];
        float mx = fmaxf(fabsf(w0), fabsf(w1));
        mx = wave_max(mx);
        const float inv = mx > 0.f ? 127.f / mx : 0.f;
        const int q0 = (int)__builtin_rintf(w0 * inv), q1 = (int)__builtin_rintf(w1 * inv);
        if ((PEER_V4_MASK >> layer) & 1) { int sw = q0 + q1;
            sw = wave_sum_i(sw);
            if (lane == 0) WSP(int, WS_SW)[t] = sw; }
        int* pw = WSP(int, WS_PW) + (size_t)t * 128; pw[lane] = (e0 << 8) | (q0 & 0xff); pw[64 + lane] = (e1 << 8) | (q1 & 0xff);
        if (lane == 0) WSP(float, WS_PWS)[t] = mx * (1.f / 127.f); }
}
#define V_PW(dst, tok) do { const int* pp_ = PWq + (tok) * 128 + 16 * r; dst[0] = *(const u32x4*)pp_; dst[1] = *(const u32x4*)(pp_ + 4); dst[2] = *(const u32x4*)(pp_ + 8); dst[3] = *(const u32x4*)(pp_ + 12); } while (0)
__device__ __forceinline__ void p_peer_v(Frame& F, const Args& a, int layer, bool next_stats, unsigned* qbase, float fac) {
    const unsigned char* V8 = WSP(unsigned char, WS_V8) + (size_t)layer * PEER_E * 2048; const int* PWq = WSP(int, WS_PW); const float* PWS = WSP(float, WS_PWS); float* out = a.out;
    const int xcc = (int)xb_xcc_id();
#pragma unroll 1
    for (int ri = 0; ri < 16; ++ri) {
        const int sl = (xcc + 8 * (ri & 1) + (ri >> 1)) & 15;
        const unsigned char* Vs = V8 + (size_t)sl * PEER_E * 128;
#pragma unroll 1
        for (;;) {
            int lane = lane_id(); asm volatile("" : "+v"(lane));
            int chunk = 0; if (lane == 0) chunk = (int)__hip_atomic_fetch_add(qbase + sl * 64, 1u, __ATOMIC_RELAXED, __HIP_MEMORY_SCOPE_AGENT);
            chunk = __builtin_amdgcn_readfirstlane(chunk);
            if (chunk >= TOK / 32) break;
            const int r = lane >> 3, c = lane & 7; const bool b5 = lane & 32, b4 = lane & 16, b3 = lane & 8;
            u32x4 wn[4]; float wsn;
            { const size_t t_ = (size_t)chunk * 32; V_PW(wn, t_); wsn = PWS[t_]; }
#pragma unroll 1
            for (int ti = 0; ti < 32; ++ti) {
                const size_t t = (size_t)chunk * 32 + ti; const u32x4 w0 = wn[0], w1 = wn[1], w2 = wn[2], w3 = wn[3]; const float ws = wsn;
                if (ti + 1 < 32) { V_PW(wn, t + 1); wsn = PWS[t + 1]; }
                unsigned* xp = (unsigned*)(WSP(bf16_t, WS_XB) + t * 2048 + (sl * 128 + c * 16 + r * 2)); const unsigned xw = *xp; const f32x2 o0 = {bf_lo(xw), bf_hi(xw)};
                u32x4 R[16]; int wk[16];
#pragma unroll
                for (int g = 0; g < 16; ++g) { const u32x4 wv = g < 4 ? w0 : (g < 8 ? w1 : (g < 12 ? w2 : w3)); wk[g] = (int)wv[g & 3];
                    R[g] = *(const u32x4*)(Vs + ((wk[g] >> 8) * 128 + c * 16)); }
                int acc[16];
#pragma unroll
                for (int i = 0; i < 16; ++i) acc[i] = 0;
#pragma unroll
                for (int j = 0; j < 4; ++j) {
                    const unsigned W = ((unsigned)wk[4 * j] & 0xffu) | (((unsigned)wk[4 * j + 1] & 0xffu) << 8) | (((unsigned)wk[4 * j + 2] & 0xffu) << 16) | ((unsigned)wk[4 * j + 3] << 24);
#pragma unroll
                    for (int d = 0; d < 4; ++d) { const unsigned ra = ((const unsigned*)&R[4 * j])[d], rb = ((const unsigned*)&R[4 * j + 1])[d], rc = ((const unsigned*)&R[4 * j + 2])[d], rd = ((const unsigned*)&R[4 * j + 3])[d];
                        const unsigned ablo = __builtin_amdgcn_perm(rb, ra, 0x05010400u), abhi = __builtin_amdgcn_perm(rb, ra, 0x07030602u), cdlo = __builtin_amdgcn_perm(rd, rc, 0x05010400u), cdhi = __builtin_amdgcn_perm(rd, rc, 0x07030602u);
                        const unsigned t0 = __builtin_amdgcn_perm(cdlo, ablo, 0x05040100u), t1 = __builtin_amdgcn_perm(cdlo, ablo, 0x07060302u), t2 = __builtin_amdgcn_perm(cdhi, abhi, 0x05040100u), t3 = __builtin_amdgcn_perm(cdhi, abhi, 0x07060302u);
                        acc[4 * d] = __builtin_amdgcn_sdot4((int)t0, (int)W, acc[4 * d], false); acc[4 * d + 1] = __builtin_amdgcn_sdot4((int)t1, (int)W, acc[4 * d + 1], false);
                        acc[4 * d + 2] = __builtin_amdgcn_sdot4((int)t2, (int)W, acc[4 * d + 2], false); acc[4 * d + 3] = __builtin_amdgcn_sdot4((int)t3, (int)W, acc[4 * d + 3], false); }
                }
                int a8[8], a4[4], a2[2];
#pragma unroll
                for (int i = 0; i < 8; ++i) a8[i] = rs_bit5(acc[i], acc[8 + i]);
#pragma unroll
                for (int i = 0; i < 4; ++i) a4[i] = rs_bit4(a8[i], a8[4 + i]);
#pragma unroll
                for (int i = 0; i < 2; ++i) a2[i] = rs_bit3(a4[i], a4[2 + i], b3);
                const int s0 = a2[0], s1 = a2[1];
                const float sc = ws * fac; const f32x2 nv = {o0.x + (float)s0 * sc, o0.y + (float)s1 * sc};
                if (!next_stats) { if (fac != 0.f) *(f32x2*)(out + t * 2048 + (sl * 128 + c * 16 + r * 2)) = nv; }
                else { *xp = cvt_pk_bf16(nv.x, nv.y);
                    const float ssq = wave_sum(nv.x * nv.x + nv.y * nv.y, lane); if (lane < 2) WSP(float, WS_SSQ1)[t * 32 + 2 * sl + lane] = lane == 0 ? ssq : 0.f; }
            }
        }
    }
}
__device__ __forceinline__ void p_peer_v4(Frame& F, const Args& a, int layer, bool next_stats, unsigned* qbase, float fac) {
    const unsigned char* V8 = WSP(unsigned char, WS_V8) + (size_t)layer * PEER_E * 2048; const int* PWq = WSP(int, WS_PW); const float* PWS = WSP(float, WS_PWS); const int* SW = WSP(int, WS_SW); float* out = a.out;
    const int xcc = (int)xb_xcc_id();
#pragma unroll 1
    for (int ri = 0; ri < 8; ++ri) {
        const int sl = (xcc + ri) & 7;
        const unsigned char* Vs = V8 + (size_t)sl * PEER_E * 128;
#pragma unroll 1
        for (;;) {
            int lane = lane_id(); asm volatile("" : "+v"(lane));
            int chunk = 0; if (lane == 0) chunk = (int)__hip_atomic_fetch_add(qbase + sl * 64, 1u, __ATOMIC_RELAXED, __HIP_MEMORY_SCOPE_AGENT);
            chunk = __builtin_amdgcn_readfirstlane(chunk);
            if (chunk >= TOK / 32) break;
            const int r = lane >> 3, c = lane & 7; const bool b5 = lane & 32, b4 = lane & 16, b3 = lane & 8;
            u32x4 wn[4]; float wsn; int swn;
            { const size_t t_ = (size_t)chunk * 32; V_PW(wn, t_); wsn = PWS[t_]; swn = SW[t_]; }
#pragma unroll 1
            for (int ti = 0; ti < 32; ++ti) {
                const size_t t = (size_t)chunk * 32 + ti; const u32x4 w0 = wn[0], w1 = wn[1], w2 = wn[2], w3 = wn[3]; const float ws = wsn; const int sw8 = 8 * swn;
                if (ti + 1 < 32) { V_PW(wn, t + 1); wsn = PWS[t + 1]; swn = SW[t + 1]; }
                unsigned* xp = (unsigned*)(WSP(bf16_t, WS_XB) + t * 2048 + (sl * 256 + c * 32 + 8 * (r >> 1) + 2 * (r & 1))); u32x2 xw; xw.x = xp[0]; xw.y = xp[2];
                u32x4 R[16]; int wk[16];
#pragma unroll
                for (int g = 0; g < 16; ++g) { const u32x4 wv = g < 4 ? w0 : (g < 8 ? w1 : (g < 12 ? w2 : w3)); wk[g] = (int)wv[g & 3];
                    R[g] = *(const u32x4*)(Vs + ((wk[g] >> 8) * 128 + c * 16)); }
                int acc[32];
#pragma unroll
                for (int i = 0; i < 32; ++i) acc[i] = 0;
#pragma unroll
                for (int j = 0; j < 4; ++j) {
                    const unsigned W = ((unsigned)wk[4 * j] & 0xffu) | (((unsigned)wk[4 * j + 1] & 0xffu) << 8) | (((unsigned)wk[4 * j + 2] & 0xffu) << 16) | ((unsigned)wk[4 * j + 3] << 24);
#pragma unroll
                    for (int d = 0; d < 4; ++d) { const unsigned ra = ((const unsigned*)&R[4 * j])[d], rb = ((const unsigned*)&R[4 * j + 1])[d], rc = ((const unsigned*)&R[4 * j + 2])[d], rd = ((const unsigned*)&R[4 * j + 3])[d];
                        const unsigned ablo = __builtin_amdgcn_perm(rb, ra, 0x05010400u), abhi = __builtin_amdgcn_perm(rb, ra, 0x07030602u), cdlo = __builtin_amdgcn_perm(rd, rc, 0x05010400u), cdhi = __builtin_amdgcn_perm(rd, rc, 0x07030602u);
                        const unsigned t0 = __builtin_amdgcn_perm(cdlo, ablo, 0x05040100u), t1 = __builtin_amdgcn_perm(cdlo, ablo, 0x07060302u), t2 = __builtin_amdgcn_perm(cdhi, abhi, 0x05040100u), t3 = __builtin_amdgcn_perm(cdhi, abhi, 0x07060302u);
                        const int b = 8 * d;
#define V4_COL(tt, i) acc[b + 2 * (i)] = __builtin_amdgcn_sdot4((int)(tt), (int)W, acc[b + 2 * (i)], false); acc[b + 2 * (i) + 1] = __builtin_amdgcn_sdot4((int)((tt) & 0xF0F0F0F0u), (int)W, acc[b + 2 * (i) + 1], false)
                        V4_COL(t0, 0); V4_COL(t1, 1); V4_COL(t2, 2); V4_COL(t3, 3);
#undef V4_COL
                    }
                }
                int a16[16], a8[8], a4[4];
#pragma unroll
                for (int i = 0; i < 16; ++i) a16[i] = rs_bit5(acc[i], acc[16 + i]);
#pragma unroll
                for (int i = 0; i < 8; ++i) a8[i] = rs_bit4(a16[i], a16[8 + i]);
#pragma unroll
                for (int i = 0; i < 4; ++i) a4[i] = rs_bit3(a8[i], a8[4 + i], b3);

                const float sc = ws * fac; f32x4 nv;
                const int lo0 = a4[0] - a4[1] - sw8, hi0 = a4[1] >> 4, lo1 = a4[2] - a4[3] - sw8, hi1 = a4[3] >> 4;
                nv.x = bf_lo(xw.x) + (float)lo0 * sc; nv.y = bf_hi(xw.x) + (float)lo1 * sc; nv.z = bf_lo(xw.y) + (float)hi0 * sc; nv.w = bf_hi(xw.y) + (float)hi1 * sc;
                if (!next_stats) { if (fac != 0.f) { float* op = out + t * 2048 + (sl * 256 + c * 32 + 8 * (r >> 1) + 2 * (r & 1)); *(f32x2*)op = (f32x2){nv.x, nv.y}; *(f32x2*)(op + 4) = (f32x2){nv.z, nv.w}; } }
                else { xp[0] = cvt_pk_bf16(nv.x, nv.y); xp[2] = cvt_pk_bf16(nv.z, nv.w);
                    const float ssq = wave_sum((nv.x * nv.x + nv.y * nv.y) + (nv.z * nv.z + nv.w * nv.w), lane); if (lane < 4) WSP(float, WS_SSQ1)[t * 32 + 4 * sl + lane] = lane == 0 ? ssq : 0.f; }
            }
        }
    }
}
__device__ __forceinline__ void p_diff_prep(Frame& F, const Args& a) {
    const f32x2* R64 = WSP(f32x2, WS_ROPE64); const int lane = F.lane, d0 = (lane & 15) * 8; const float* gn = a.in[32] + d0;
    for (int t = F.gw; t < TOK; t += F.NGW) {
        u32x4 raw[4]; f32x2 cs[8]; bf16_t* base = WSP(bf16_t, WS_KD) + (size_t)t * 2048;
#pragma unroll
        for (int i = 0; i < 4; ++i) raw[i] = *(const u32x4*)(base + (lane + 64 * i) * 8);
#pragma unroll
        for (int e = 0; e < 8; ++e) cs[e] = R64[(size_t)t * 64 + (lane & 7) * 8 + e];
#pragma unroll
        for (int i = 0; i < 4; ++i) { bf16_t* p = base + (lane + 64 * i) * 8; float f[8]; unpack8(raw[i], f); float s = 0.f;
#pragma unroll
            for (int e = 0; e < 8; ++e) s += f[e] * f[e];
            s = row16_sum(s);
            const float rs = 1.0f / sqrtf(s * (1.f / 128.f) + EPS); float o[8];
#pragma unroll
            for (int e = 0; e < 8; ++e) f[e] *= rs * gn[e];
#pragma unroll
            for (int e = 0; e < 8; ++e) { const float pv = dppf<0x128>(f[e]); o[e] = (lane & 8) ? f[e] * cs[e].x + pv * cs[e].y : f[e] * cs[e].x - pv * cs[e].y; }
            u32x4 pk; pk.x = cvt_pk_bf16(o[0], o[1]); pk.y = cvt_pk_bf16(o[2], o[3]); pk.z = cvt_pk_bf16(o[4], o[5]); pk.w = cvt_pk_bf16(o[6], o[7]); *(u32x4*)p = pk; }
    }
}
__device__ __forceinline__ void p_attn_diff(Frame& F, const Args& a) {
    const bf16_t* QD = WSP(bf16_t, WS_QD); const bf16_t* KD = WSP(bf16_t, WS_KD); const bf16_t* VD = WSP(bf16_t, WS_VD); bf16_t* OD = WSP(bf16_t, WS_OD); bf16_t* MIX = WSP(bf16_t, WS_MIX);
    const float scale = 0.08838834764831845f;
    const float lam_init = 0.8f - 0.6f * 0.7408182206817179f;
    for (int it = F.bid; it < 256; it += F.G) {
        const int x = it & 7, y = it >> 3, pairidx = y & 7, bh = x * 4 + (y >> 3), h = bh & 7, b = bh >> 3;
#pragma unroll 1
        for (int s = 0; s < 4; ++s) { const int qb = (s >> 1) ? pairidx : 15 - pairidx, m = s & 1, q0 = qb * 256; const size_t row0 = (size_t)b * SEQ + q0, kr0 = (size_t)b * SEQ;
            float lam = 0.f;
            if (m) { const int ln = lane_id(); const float d1 = wave_sum(a.in[33][ln] * a.in[34][ln] + a.in[33][64 + ln] * a.in[34][64 + ln], ln), d2 = wave_sum(a.in[35][ln] * a.in[36][ln] + a.in[35][64 + ln] * a.in[36][64 + ln], ln);
                     lam = expf(d1) - expf(d2) + lam_init; }
            att::attn_unit<128, 256, true, false, 64, true>(F.lds, QD + row0 * 2048 + h * 256 + m * 128, 2048, KD + kr0 * 2048 + h * 256 + m * 128, 2048, VD + kr0 * 2048 + h * 256, 2048,
                                           OD + row0 * 4096 + h * 512 + m * 256, 4096, 4 * (qb + 1), q0, scale * 1.4426950408889634f, (F.wave << 6) | lane_id(), a.in[31], WSP(f32x2, WS_ROPE64) + row0 * 64,
                                           OD + row0 * 4096 + h * 512, MIX + row0 * 2048 + h * 256, 2048, lam, a.in[37], 1.0f - lam_init); }
    }
}

constexpr int PH_LAST = 35;
__global__ void __launch_bounds__(NTHREADS, 2) mega_fwd(Args args) {
    extern __shared__ __attribute__((aligned(16))) unsigned char lds_raw[];
    Frame F;
    F.lds = (LAS unsigned char*)lds_raw; F.tid = threadIdx.x; F.lane = F.tid & 63; F.wave = __builtin_amdgcn_readfirstlane(F.tid >> 6);
    F.G = gridDim.x; F.bid = blockIdx.x; F.gw = F.bid * NWAVES + F.wave; F.NGW = F.G * NWAVES; F.ws = (GAS unsigned char*)args.ws;
    volatile LAS unsigned* MISC = (volatile LAS unsigned*)(F.lds + MISC_OFF);
    if (F.tid < 64) MISC[F.tid] = 0u;
    __syncthreads();
    const int lo = args.ph_lo, hi = args.ph_hi;
    XcdBarrier bar; bar.bar = (unsigned*)(F.ws + WS_CTL) + CW_BAR; bar.x = 0; bar.st = nullptr;
    if (hi - lo > 1) bar = xcd_barrier_post((unsigned*)(F.ws + WS_CTL) + CW_BAR, MISC + 8);
#ifdef ONLY
#define IN(k) ((k) == ONLY && lo <= (k) && (k) < hi)
#else
#define IN(k) (lo <= (k) && (k) < hi)
#endif
#define SEAM(k) do { if (IN((k) + 1)) { XcdBarrier bb_ = bar; unsigned* b_ = bar.bar; asm volatile("" : "+s"(b_)); bb_.bar = (unsigned*)(GAS unsigned*)b_; xcd_barrier(bb_, ((F.wave << 6) | lane_id()) == 0); } } while (0)
#define REFRESH() do { int t_ = (F.wave << 6) | lane_id(); asm volatile("" : "+v"(t_)); F.tid = t_; F.lane = t_ & 63; unsigned char* w_ = args.ws; asm volatile("" : "+s"(w_)); F.ws = (GAS unsigned char*)w_; } while (0)
#define GEMM_STORE(Ap, Bp, Mv, Nv, Kv, Op, ldcv, rs, scv, ssv, invn, slotsv) do { pg8::Gemm g_{Ap, Bp, Mv, Nv, Kv}; pg8::StaticOrder S_; S_.init(Mv, Nv, F.G, F.bid); pg8::EpiStore E_{Op, ldcv, rs, scv, ssv, invn, slotsv}; \
        pg8::gemm_phase<pg8::EpiStore, pg8::StaticOrder, true, true>(F.lds, g_, S_, E_, F.tid); } while (0)
#define GEMM_RESID(Ap, Bp, Kv, ssqp) do { pg8::Gemm g_{Ap, Bp, TOK, DM, Kv}; pg8::StaticOrder S_; S_.init(TOK, DM, F.G, F.bid); pg8::EpiResid E_{WSP(bf16_t, WS_XB), dry ? nullptr : (ssqp), fac}; \
        pg8::gemm_phase<pg8::EpiResid, pg8::StaticOrder, true, true>(F.lds, g_, S_, E_, F.tid); } while (0)
#ifndef REPEAT_MASK
#define REPEAT_MASK 0ull
#endif
#define PHASE(k, ...) if (IN(k)) { REFRESH(); { const float fac = 1.f; const bool dry = false; (void)fac; (void)dry; __VA_ARGS__ } \
        if ((REPEAT_MASK >> ((k) > 24 ? (k) - 16 : (k))) & 1ull) { const float fac = 0.f; const bool dry = true; (void)fac; (void)dry; __VA_ARGS__ } SEAM(k); }
    PHASE(0, p_prologue(F, args);)
    PHASE(1,
        { pg8::Gemm g{WSP(bf16_t, WS_XB), WSP(bf16_t, WS_WIN), TOK, 4096, 2048}; pg8::StaticOrder S; S.init(TOK, 4096, F.G, F.bid);
          pg8::EpiWin E{WSP(bf16_t, WS_CQ), WSP(bf16_t, WS_CKV), WSP(bf16_t, WS_Z), WSP(bf16_t, WS_XBC), WSP(float, WS_TAIL), WSP(float, WS_RSTD)};
          pg8::gemm_phase<pg8::EpiWin, pg8::StaticOrder, true, true>(F.lds, g, S, E, F.tid); })
    PHASE(2,
        { pg8::Gemm g{WSP(bf16_t, WS_XB), WSP(bf16_t, WS_WIN) + (size_t)4096 * 2048, TOK, 256, 2048}; pg8::StaticOrder S; S.init(TOK, 256, F.G, F.bid);
          pg8::EpiTail E{{WSP(bf16_t, WS_CQ), WSP(bf16_t, WS_CKV), WSP(bf16_t, WS_Z), WSP(bf16_t, WS_XBC), WSP(float, WS_TAIL), WSP(float, WS_RSTD)}};
          pg8::gemm_phase<pg8::EpiTail, pg8::StaticOrder, true, true>(F.lds, g, S, E, F.tid); }
        _Pragma("unroll 1")
        for (int l = 0; l < 2; ++l) { pg8::Gemm g{WSP(bf16_t, WS_MEMB), WSP(bf16_t, WS_WMEMKV) + (size_t)l * 1024 * 2048, 1024, 1024, 2048}; pg8::StaticOrder S; S.init(1024, 1024, F.G, (F.bid + 2 * F.G - 64 - 16 * l) % F.G);
          pg8::EpiStore E{WSP(bf16_t, WS_MEMKV) + (size_t)l * 1024 * 1024, 1024, WSP(float, WS_RSTD_MEM), 0, 0, 1.f / 2048.f, false};
          pg8::gemm_phase<pg8::EpiStore, pg8::StaticOrder, true, true>(F.lds, g, S, E, F.tid); }
        if (!dry) { const int first = F.G > 96 ? 96 : 0; if (F.bid >= first) p_prepA(F, args, F.bid - first, F.G - first); })
    PHASE(3,
        GEMM_STORE(WSP(bf16_t, WS_CQ), WSP(bf16_t, WS_WUQ), TOK, 1536, 512, WSP(bf16_t, WS_QM), 1536, WSP(float, WS_RSTD_CQ), 0, 0, 0.f, false);
        GEMM_STORE(WSP(bf16_t, WS_CKV), WSP(bf16_t, WS_WUKV), TOK, 2048, 512, WSP(bf16_t, WS_KV), 2048, WSP(float, WS_RSTD_CKV), 0, 0, 0.f, false);)
    PHASE(4, if (!dry) { p_prepB(F, args); p_prep_late(F, args); })
    PHASE(5, if (!dry) p_mla_ssd(F, args, (unsigned*)(F.ws + WS_CTL) + 64, (volatile LAS int*)(F.lds + MISC_OFF + 128));)
    PHASE(7, p_ssd_norm(F, args);)
    PHASE(8, GEMM_RESID(WSP(bf16_t, WS_MIX), WSP(bf16_t, WS_WOUT), 2048, WSP(float, WS_SSQ1));)
#pragma unroll 1
    for (int layer = 0; layer < 2; ++layer) {
        const int pb = layer ? 25 : 9;
        if (layer == 1) {
            PHASE(20, GEMM_STORE(WSP(bf16_t, WS_XB), WSP(bf16_t, WS_WQKV), TOK, 6144, 2048, WSP(bf16_t, WS_QD), 2048, WSP(float, WS_SSQ1), 2048, (size_t)TOK * 2048, 1.f / 2048.f, true);)
            PHASE(21, if (!dry) p_diff_prep(F, args);)
            PHASE(22, p_attn_diff(F, args);)
            PHASE(24, GEMM_RESID(WSP(bf16_t, WS_MIX), WSP(bf16_t, WS_WO), 2048, WSP(float, WS_SSQ1));)
        }
        PHASE(pb + 1,
                      { pg8::Gemm g_{WSP(bf16_t, WS_XB), WSP(bf16_t, WS_WMEMQ) + (size_t)layer * 512 * 2048, TOK, 512, 2048}; pg8::StaticOrder S_; S_.init(TOK, 2 * 512, F.G, F.bid);
                        pg8::EpiStore E_{WSP(bf16_t, WS_MEMQ), 512, WSP(float, WS_SSQ1), 0, 0, 1.f / 2048.f, true, true};
                        pg8::gemm_phase<pg8::EpiStore, pg8::StaticOrder, true, true, true>(F.lds, g_, S_, E_, F.tid); })
        PHASE(pb + 3, p_attn_mem(F, layer);)
        PHASE(pb + 4, GEMM_RESID(WSP(bf16_t, WS_MEMO), WSP(bf16_t, WS_WMEMO) + (size_t)layer * 2048 * 512, 512, WSP(float, WS_SSQ2));)
        PHASE(pb + 6, GEMM_STORE(WSP(bf16_t, WS_XB), WSP(bf16_t, WS_WPEERQ) + (size_t)layer * 2048 * 2048, TOK, 2048, 2048, WSP(bf16_t, WS_PQ), 2048, WSP(float, WS_SSQ2), 0, 0, 1.f / 2048.f, true);)
        PHASE(pb + 7, p_peer_topk(F, layer);)
        PHASE(pb + 8, if ((PEER_U4_MASK >> layer) & 1) p_peer_u<true>(F, layer, (unsigned*)(F.ws + WS_CTL) + 8192 + layer * 2048 + (dry ? 8192 : 0));
                      else p_peer_u<false>(F, layer, (unsigned*)(F.ws + WS_CTL) + 8192 + layer * 2048 + (dry ? 8192 : 0));)
        PHASE(pb + 9, p_peer_fin(F, layer);)
        PHASE(pb + 10, if ((PEER_V4_MASK >> layer) & 1) p_peer_v4(F, args, layer, layer == 0, (unsigned*)(F.ws + WS_CTL) + 8192 + layer * 2048 + 1024 + (dry ? 8192 : 0), fac);
                       else p_peer_v(F, args, layer, layer == 0, (unsigned*)(F.ws + WS_CTL) + 8192 + layer * 2048 + 1024 + (dry ? 8192 : 0), fac);)
    }
}

extern "C" void kernel_launch(void* const* d_in, const int* in_sizes, int n_in, void* d_out, int out_size, void* d_ws, size_t ws_size, hipStream_t stream) {
    static int grid = 0;
    if (grid == 0) {
        if (n_in != 39 || out_size != TOK * DM || ws_size < WS_END) { fprintf(stderr, "kernel_launch: unexpected shapes (n_in %d out %d ws %zu need %zu)\n", n_in, out_size, ws_size, (size_t)WS_END); grid = -1; return; }
        int dev = 0, cus = 0, per_cu = 0;
        if (hipGetDevice(&dev) != hipSuccess || hipDeviceGetAttribute(&cus, hipDeviceAttributeMultiprocessorCount, dev) != hipSuccess) { grid = -1; return; }
        if (hipFuncSetAttribute((const void*)mega_fwd, hipFuncAttributeMaxDynamicSharedMemorySize, LDS_BYTES) != hipSuccess) { fprintf(stderr, "kernel_launch: hipFuncSetAttribute failed\n"); grid = -1; return; }
        if (hipOccupancyMaxActiveBlocksPerMultiprocessor(&per_cu, (const void*)mega_fwd, NTHREADS, LDS_BYTES) != hipSuccess || per_cu < 1) { fprintf(stderr, "kernel_launch: occupancy query says %d\n", per_cu); grid = -1; return; }
        (void)hipGetLastError();
        grid = cus;
    }
    if (grid < 0) return;
    (void)hipMemsetAsync((char*)d_ws + WS_CTL, 0, CTL_ZERO_BYTES, stream);
    Args a{};
    for (int i = 0; i < 39; ++i) a.in[i] = (const float*)d_in[i];
    a.pos = (const int*)d_in[2]; a.out = (float*)d_out; a.ws = (unsigned char*)d_ws;
#if MK_ONE_LAUNCH
    a.ph_lo = 0; a.ph_hi = PH_LAST + 1;
    hipLaunchKernelGGL(mega_fwd, dim3(grid), dim3(NTHREADS), LDS_BYTES, stream, a);
#else
    for (int ph = 0; ph <= PH_LAST; ++ph) { a.ph_lo = ph; a.ph_hi = ph + 1; hipLaunchKernelGGL(mega_fwd, dim3(grid), dim3(NTHREADS), LDS_BYTES, stream, a); }
#endif
}
```

```cpp
#include <hip/hip_runtime.h>
#include <cstdio>
#include <cstdint>

#ifndef MK_ONE_LAUNCH
#define MK_ONE_LAUNCH 1
#endif

#define LAS __attribute__((address_space(3)))
#define GAS __attribute__((address_space(1)))
typedef unsigned short bf16_t;
typedef short bf16x8 __attribute__((ext_vector_type(8)));
typedef short s16x4 __attribute__((ext_vector_type(4)));
typedef float f32x4 __attribute__((ext_vector_type(4)));
typedef float f32x2 __attribute__((ext_vector_type(2)));
typedef float f32x16 __attribute__((ext_vector_type(16)));
typedef unsigned u32x4 __attribute__((ext_vector_type(4)));
typedef unsigned u32x2 __attribute__((ext_vector_type(2)));
typedef __bf16 bf16x2_t __attribute__((ext_vector_type(2)));

constexpr int BATCH = 4, SEQ = 4096, DM = 2048, TOK = BATCH * SEQ;
constexpr int NMEM = 256;
constexpr float EPS = 1e-6f;
constexpr int MLA_H = 8, MLA_QK = 192, MLA_NOPE = 128, MLA_ROPE = 64, MLA_V = 128, MLA_RANK = 512;
constexpr int SSD_H = 16, SSD_P = 64, SSD_INNER = 1024, SSD_G = 4, SSD_N = 128, SSD_CONVD = 2048;
constexpr int EVEN_IN = 4176, WIN_N = 4352;
constexpr int DIFF_H = 8, DIFF_HD = 128, DIFF_V = 256;
constexpr int MEM_H = 4, MEM_HD = 128, MEM_W = 512;
constexpr int PEER_H = 8, PEER_KEYS = 128, PEER_E = 16384, PEER_K = 16, PEER_HK = 128;

constexpr size_t MiB = 1u << 20;
constexpr size_t WS_CTL = 0, CTL_ZERO_BYTES = 1 * MiB;
constexpr size_t WS_WIN = 1 * MiB;
constexpr size_t WS_WUQ = 18 * MiB;
constexpr size_t WS_WUKV = 20 * MiB;
constexpr size_t WS_WOUT = 22 * MiB;
constexpr size_t WS_WMEMQ = 30 * MiB;
constexpr size_t WS_WMEMKV = 34 * MiB;
constexpr size_t WS_WMEMO = 42 * MiB;
constexpr size_t WS_WPEERQ = 46 * MiB;
constexpr size_t WS_WQKV = 62 * MiB;
constexpr size_t WS_WO = 86 * MiB;
constexpr size_t WS_KEYS = 94 * MiB;
constexpr size_t WS_U8 = 96 * MiB;
constexpr size_t WS_V8 = 160 * MiB;
constexpr size_t WS_TSC = 224 * MiB;
constexpr size_t WS_ROPE32 = 352 * MiB;
constexpr size_t WS_ROPE64 = 356 * MiB;
constexpr size_t WS_XB = 364 * MiB;
constexpr size_t WS_RSTD = 428 * MiB;
constexpr size_t WS_RSTD_CQ = WS_RSTD + 65536;
constexpr size_t WS_RSTD_CKV = WS_RSTD + 2 * 65536;
constexpr size_t WS_RSTD_MEM = WS_RSTD + 3 * 65536;
constexpr size_t WS_SSQ1 = 925 * MiB, WS_SSQ2 = 927 * MiB;
constexpr size_t WS_MEMB = 429 * MiB;
constexpr size_t WS_MEMKV = 433 * MiB;
constexpr size_t WS_MIX = 437 * MiB;
constexpr size_t WS_LR = 501 * MiB;
constexpr size_t WS_CQ = WS_LR;
constexpr size_t WS_CKV = WS_LR + 16 * MiB;
constexpr size_t WS_Z = WS_LR + 32 * MiB;
constexpr size_t WS_XBC = WS_LR + 64 * MiB;
constexpr size_t WS_XBCC = WS_LR + 128 * MiB;
constexpr size_t WS_TAIL = WS_LR + 192 * MiB;
constexpr size_t WS_DT = WS_LR + 198 * MiB;
constexpr size_t WS_QM = WS_LR + 200 * MiB;
constexpr size_t WS_KV = WS_LR + 248 * MiB;
constexpr size_t WS_KM = WS_LR + 312 * MiB;
constexpr size_t WS_YG = WS_LR + 360 * MiB;
constexpr size_t WS_QD = WS_LR;
constexpr size_t WS_KD = WS_LR + 64 * MiB;
constexpr size_t WS_VD = WS_LR + 128 * MiB;
constexpr size_t WS_OD = WS_LR + 192 * MiB;
constexpr size_t WS_MEMQ = WS_LR;
constexpr size_t WS_MEMO = WS_LR + 16 * MiB;
constexpr size_t WS_PQ = WS_LR + 32 * MiB;
constexpr size_t WS_EXP = WS_LR + 96 * MiB;
constexpr size_t WS_GATE = WS_LR + 104 * MiB;
constexpr size_t WS_PW = WS_LR + 112 * MiB;
constexpr size_t WS_PWS = WS_LR + 158 * MiB;
constexpr size_t WS_XQ = WS_LR + 120 * MiB;
constexpr size_t WS_SW = WS_LR + 152 * MiB + 131072;
constexpr size_t WS_SX = WS_LR + 152 * MiB + 65536;
constexpr size_t WS_XS = WS_LR + 152 * MiB;
constexpr size_t WS_PD = WS_LR + 160 * MiB;
constexpr size_t WS_END = WS_LR + 428 * MiB;
constexpr int CW_BAR = 4096;

constexpr int RING_BYTES = 131072;
constexpr int MISC_OFF = RING_BYTES;
constexpr int LDS_BYTES = 147456;
constexpr int NWAVES = 8, NTHREADS = 512;

__device__ __forceinline__ unsigned cvt_pk_bf16(float lo, float hi) { unsigned r; asm volatile("v_cvt_pk_bf16_f32 %0, %1, %2" : "=v"(r) : "v"(lo), "v"(hi)); return r; }
__device__ __forceinline__ float bf_lo(unsigned w) { return __uint_as_float(w << 16); }
__device__ __forceinline__ float bf_hi(unsigned w) { return __uint_as_float(w & 0xffff0000u); }
__device__ __forceinline__ float bf2f(bf16_t h) { return __uint_as_float(((unsigned)h) << 16); }
__device__ __forceinline__ bf16_t f2bf(float f) { return (bf16_t)(cvt_pk_bf16(f, 0.f) & 0xffffu); }
__device__ __forceinline__ int lane_id() { int l; asm volatile("v_mbcnt_lo_u32_b32 %0, -1, 0\n\tv_mbcnt_hi_u32_b32 %0, -1, %0" : "=v"(l)); return l; }
__device__ __forceinline__ float shx(float v, int m, int lane) { return __int_as_float(__builtin_amdgcn_ds_bpermute((lane ^ m) << 2, __float_as_int(v))); }
__device__ __forceinline__ unsigned shxu(unsigned v, int m, int lane) { return (unsigned)__builtin_amdgcn_ds_bpermute((lane ^ m) << 2, (int)v); }
__device__ __forceinline__ float shf(float v, int src) { return __int_as_float(__builtin_amdgcn_ds_bpermute(src << 2, __float_as_int(v))); }
__device__ __forceinline__ int rs_bit5(int lo, int hi) { auto r = __builtin_amdgcn_permlane32_swap((unsigned)lo, (unsigned)hi, false, false); return (int)r[0] + (int)r[1]; }
__device__ __forceinline__ int rs_bit4(int lo, int hi) { auto r = __builtin_amdgcn_permlane16_swap((unsigned)lo, (unsigned)hi, false, false); return (int)r[0] + (int)r[1]; }
__device__ __forceinline__ int rs_bit3(int lo, int hi, bool b3) { const int keep = b3 ? hi : lo, send = b3 ? lo : hi; return keep + __builtin_amdgcn_update_dpp(0, send, 0x128, 0xf, 0xf, false); }
template <int CTRL> __device__ __forceinline__ float dppf(float v) { return __int_as_float(__builtin_amdgcn_update_dpp(0, __float_as_int(v), CTRL, 0xf, 0xf, false)); }
template <int CTRL> __device__ __forceinline__ int dppi(int v) { return __builtin_amdgcn_update_dpp(0, v, CTRL, 0xf, 0xf, false); }
__device__ __forceinline__ float row8_sum(float v) { v += dppf<0xB1>(v); v += dppf<0x4E>(v); v += dppf<0x141>(v); return v; }
__device__ __forceinline__ float row16_sum(float v) { v = row8_sum(v); v += dppf<0x140>(v); return v; }
__device__ __forceinline__ float half_sum(float v) { v = row16_sum(v); auto s = __builtin_amdgcn_permlane16_swap(__float_as_uint(v), __float_as_uint(v), false, false); return __uint_as_float(s[0]) + __uint_as_float(s[1]); }
__device__ __forceinline__ float wave_sum(float v, int) { v = half_sum(v); auto t = __builtin_amdgcn_permlane32_swap(__float_as_uint(v), __float_as_uint(v), false, false); return __uint_as_float(t[0]) + __uint_as_float(t[1]); }
__device__ __forceinline__ float wave_max(float v) { v = fmaxf(v, dppf<0xB1>(v)); v = fmaxf(v, dppf<0x4E>(v)); v = fmaxf(v, dppf<0x141>(v)); v = fmaxf(v, dppf<0x140>(v));
    auto s = __builtin_amdgcn_permlane16_swap(__float_as_uint(v), __float_as_uint(v), false, false); v = fmaxf(__uint_as_float(s[0]), __uint_as_float(s[1]));
    auto t = __builtin_amdgcn_permlane32_swap(__float_as_uint(v), __float_as_uint(v), false, false); return fmaxf(__uint_as_float(t[0]), __uint_as_float(t[1])); }
__device__ __forceinline__ int wave_sum_i(int v) { v += dppi<0xB1>(v); v += dppi<0x4E>(v); v += dppi<0x141>(v); v += dppi<0x140>(v);
    auto s = __builtin_amdgcn_permlane16_swap((unsigned)v, (unsigned)v, false, false); v = (int)s[0] + (int)s[1];
    auto t = __builtin_amdgcn_permlane32_swap((unsigned)v, (unsigned)v, false, false); return (int)t[0] + (int)t[1]; }
__device__ __forceinline__ u32x4 pack8(f32x4 a, f32x4 b) { u32x4 w; w.x = cvt_pk_bf16(a.x, a.y); w.y = cvt_pk_bf16(a.z, a.w); w.z = cvt_pk_bf16(b.x, b.y); w.w = cvt_pk_bf16(b.z, b.w); return w; }
__device__ __forceinline__ void unpack8(u32x4 w, float (&f)[8]) { f[0] = bf_lo(w.x); f[1] = bf_hi(w.x); f[2] = bf_lo(w.y); f[3] = bf_hi(w.y); f[4] = bf_lo(w.z); f[5] = bf_hi(w.z); f[6] = bf_lo(w.w); f[7] = bf_hi(w.w); }
__device__ __forceinline__ float fast_exp(float x) { return __builtin_amdgcn_exp2f(x * 1.4426950408889634f); }
__device__ __forceinline__ float silu_f(float v) { return v * __builtin_amdgcn_rcpf(1.f + fast_exp(-v)); }
__device__ __forceinline__ float gelu_f(float v) {
    const float av = fabsf(v), t = __builtin_amdgcn_rcpf(av * 0.2316418882f + 1.0f);
    float q = t * 0.5307027145f + (-0.7265760135f); q = q * t + 0.7107068705f; q = q * t + (-0.142248368f); q = q * t + 0.127414796f; q = q * t;
    const float e = __builtin_amdgcn_exp2f((v * v) * (-0.72134752044f));
    const float m = v * (q * e);
    return v < 0.f ? m : v - m;
}

__device__ __forceinline__ float ld_ssq(const float* p) { return __hip_atomic_fetch_add(const_cast<float*>(p), 0.0f, __ATOMIC_RELAXED, __HIP_MEMORY_SCOPE_AGENT); }
namespace pg8 {
constexpr int BM = 256, BK = 64, HALF = 128, HTB = HALF * BK * 2, STAGE_BYTES = 8 * HTB, NXCD = 8, WGM = 8;
__host__ __device__ __forceinline__ int lds_byte(int r, int c) { const int st = (r >> 4) * 2 + (c >> 5), rr = r & 15, cc = c & 31, ob = rr * 64 + cc * 2; return st * 1024 + (ob ^ (((ob >> 9) & 1) << 5)); }
__host__ __device__ __forceinline__ void stage_rc(int b, int& R, int& C) { const int st = b / 1024, sb = b % 1024, swz = sb ^ (((sb >> 9) & 1) << 5); R = (st >> 1) * 16 + swz / 64; C = (st & 1) * 32 + (swz % 64) / 2; }
__host__ __device__ __forceinline__ int perm32(int rho) { const int n = rho >> 4, i = rho & 15; return 8 * (i >> 2) + 4 * n + (i & 3); }
struct Unit { int pm, pn; };
struct Gemm { const bf16_t* A; const bf16_t* Bt; int M, N, K; };
struct StaticOrder {
    int nM, nN, nwg, G, c;
    __host__ __device__ void init(int M, int N, int G_, int c_) { nM = M / BM; nN = N / BM; nwg = nM * nN; G = G_; c = c_; }
    __host__ __device__ bool next(int i, Unit& u) const {
        const long L = (long)i * G + c; if (L >= nwg) return false;
        int wgid = (int)L; { const int q = nwg / NXCD, r = nwg % NXCD, xcd = wgid % NXCD, off = wgid / NXCD; wgid = (xcd < r ? xcd * (q + 1) : r * (q + 1) + (xcd - r) * q) + off; }
        const int nig = WGM * nN, gid = wgid / nig, fm = gid * WGM, gsz = (nM - fm) < WGM ? (nM - fm) : WGM;
        u.pm = fm + ((wgid % nig) % gsz); u.pn = (wgid % nig) / gsz; return true;
    }
    __device__ __forceinline__ void a_ready(const Unit&) const {}
    __device__ __forceinline__ void done(const Unit&) const {}
};
template <class Epi, class Sched, bool ALIGN_EPI = false, bool SP2 = false, bool HALFN = false>
__device__ __forceinline__ void gemm_phase(LAS unsigned char* lds, const Gemm g, const Sched& S, const Epi& E, int tid_in) {
    static_assert(!HALFN || SP2, "HALFN is written for the SP2 schedule");
    int tid = tid_in; asm volatile("" : "+v"(tid));
    const int wid = __builtin_amdgcn_readfirstlane(tid >> 6), lane = tid & 63, wr = wid >> 2, wc = wid & 3, fr = lane & 15, fq = lane >> 4;
    const int K = g.K, nt = K / BK;
    unsigned voffA[2], voffB[2];
#pragma unroll
    for (int i = 0; i < 2; ++i) { int R, C; stage_rc(tid * 16 + i * 8192, R, C); const int Rb = Epi::PERM ? ((R & ~31) + perm32(R & 31)) : R;
        voffA[i] = (unsigned)(R * K + C) * 2u; voffB[i] = (unsigned)(Rb * K + C) * 2u; }
    const size_t kstep = (size_t)(BK * 2);
    const size_t hstep = (size_t)HALF * K * 2;
    const size_t tstep = 2 * hstep;
    const unsigned ldsw = (unsigned)wid * 1024u;
    const int aoff = lds_byte(wr * 64 + fr, fq * 8), boff = lds_byte(wc * 32 + fr, fq * 8);
#define PG8_SA(b, h) (((b) * 2 + (h)) * HTB)
#define PG8_SB(b, h) ((4 + (b) * 2 + (h)) * HTB)
#define PG8_STAGE(bufoff, gbase, voff) do { _Pragma("unroll") for (int _i = 0; _i < 2; ++_i) \
        __builtin_amdgcn_global_load_lds((const unsigned*)((const char*)(gbase) + (voff)[_i]), (LAS unsigned*)(lds + (bufoff) + ldsw + _i * 8192), 16, 0, 0); } while (0)
#define PG8_LDA(dst, b, h) do { _Pragma("unroll") for (int m = 0; m < 4; ++m) _Pragma("unroll") for (int k = 0; k < 2; ++k) dst[m][k] = *(const LAS bf16x8*)(lds + PG8_SA(b, h) + aoff + m * 2048 + k * 1024); } while (0)
#define PG8_LDB(dst, b, h) do { _Pragma("unroll") for (int n = 0; n < 2; ++n) _Pragma("unroll") for (int k = 0; k < 2; ++k) dst[n][k] = *(const LAS bf16x8*)(lds + PG8_SB(b, h) + boff + n * 2048 + k * 1024); } while (0)
#define PG8_MMA(ai, bj, At, Bt) do { __builtin_amdgcn_s_setprio(1); _Pragma("unroll") for (int m = 0; m < 4; ++m) _Pragma("unroll") for (int n = 0; n < 2; ++n) _Pragma("unroll") for (int k = 0; k < 2; ++k) \
        acc[ai][bj][m][n] = __builtin_amdgcn_mfma_f32_16x16x32_bf16(Bt[n][k], At[m][k], acc[ai][bj][m][n], 0, 0, 0); __builtin_amdgcn_s_setprio(0); } while (0)
#define PG8_WAIT_V(n) asm volatile("s_waitcnt vmcnt(" #n ")" ::: "memory")
#define PG8_WAIT_L(n) asm volatile("s_waitcnt lgkmcnt(" #n ")" ::: "memory")
#define PG8_BAR __builtin_amdgcn_s_barrier()
#define PG8_SCHED __builtin_amdgcn_sched_barrier(0)
    Unit cur, nxt; int ui = 0;
    if (!S.next(0, cur)) return;
    f32x4 acc[2][2][4][2];
#pragma unroll
    for (int a = 0; a < 2; ++a)
#pragma unroll
        for (int b = 0; b < 2; ++b)
#pragma unroll
            for (int m = 0; m < 4; ++m)
#pragma unroll
                for (int n = 0; n < 2; ++n) acc[a][b][m][n] = (f32x4){0.f, 0.f, 0.f, 0.f};
    bf16x8 At[4][2], B0[2][2], B1[2][2];
    const size_t bstep = HALFN ? hstep : tstep;
    const char* cA = (const char*)g.A + (size_t)cur.pm * tstep; const char* cB = (const char*)g.Bt + (size_t)cur.pn * bstep;
    S.a_ready(cur);
    if constexpr (HALFN) {
        PG8_STAGE(PG8_SB(0, 0), cB, voffB); PG8_STAGE(PG8_SA(0, 0), cA, voffA); PG8_STAGE(PG8_SA(0, 1), cA + hstep, voffA);
        if (wr == 1) PG8_BAR;
        PG8_WAIT_V(2); PG8_BAR;
        PG8_STAGE(PG8_SB(1, 0), cB + kstep, voffB); PG8_STAGE(PG8_SA(1, 0), cA + kstep, voffA);
        PG8_WAIT_V(4); PG8_BAR;
    } else if constexpr (SP2) {
        PG8_STAGE(PG8_SB(0, 0), cB, voffB); PG8_STAGE(PG8_SB(0, 1), cB + hstep, voffB); PG8_STAGE(PG8_SA(0, 0), cA, voffA); PG8_STAGE(PG8_SA(0, 1), cA + hstep, voffA);
        if (wr == 1) PG8_BAR;
        PG8_WAIT_V(2); PG8_BAR;
        PG8_STAGE(PG8_SB(1, 0), cB + kstep, voffB); PG8_STAGE(PG8_SA(1, 0), cA + kstep, voffA); PG8_STAGE(PG8_SB(1, 1), cB + hstep + kstep, voffB);
        PG8_WAIT_V(6); PG8_BAR;
    } else {
        PG8_STAGE(PG8_SB(0, 0), cB, voffB); PG8_STAGE(PG8_SA(0, 0), cA, voffA); PG8_STAGE(PG8_SB(0, 1), cB + hstep, voffB); PG8_STAGE(PG8_SA(0, 1), cA + hstep, voffA);
        if (wr == 1) PG8_BAR;
        PG8_WAIT_V(4); PG8_BAR;
        PG8_STAGE(PG8_SB(1, 0), cB + kstep, voffB); PG8_STAGE(PG8_SA(1, 0), cA + kstep, voffA); PG8_STAGE(PG8_SB(1, 1), cB + hstep + kstep, voffB);
        PG8_WAIT_V(6); PG8_BAR;
    }
    for (;;) {
        const bool has_next = S.next(ui + 1, nxt);
        const char* nA = has_next ? (const char*)g.A + (size_t)nxt.pm * tstep : cA; const char* nB = has_next ? (const char*)g.Bt + (size_t)nxt.pn * bstep : cB;
        for (int t = 0; t < nt; t += 2) {
            const bool last = (t == nt - 2);
            const char* a1 = cA + (size_t)(t + 1) * kstep;
            const char* a2 = last ? nA : cA + (size_t)(t + 2) * kstep; const char* b2 = last ? nB : cB + (size_t)(t + 2) * kstep;
            const char* a3 = a2 + kstep; const char* b3 = b2 + kstep;
            if (last && has_next) S.a_ready(nxt);
            if constexpr (HALFN) {
            PG8_LDB(B0, 0, 0); PG8_SCHED; PG8_LDA(At, 0, 0); PG8_STAGE(PG8_SA(1, 1), a1 + hstep, voffA);
            PG8_WAIT_V(6); PG8_WAIT_L(0); PG8_BAR; PG8_MMA(0, 0, At, B0); PG8_BAR; PG8_SCHED;
            PG8_LDA(At, 0, 1); PG8_STAGE(PG8_SB(0, 0), b2, voffB); PG8_STAGE(PG8_SA(0, 0), a2, voffA);
            PG8_WAIT_V(6); PG8_WAIT_L(0); PG8_BAR; PG8_MMA(1, 0, At, B0); PG8_BAR; PG8_SCHED;
            PG8_LDB(B0, 1, 0); PG8_SCHED; PG8_LDA(At, 1, 0); PG8_STAGE(PG8_SA(0, 1), a2 + hstep, voffA);
            PG8_WAIT_V(6); PG8_WAIT_L(0); PG8_BAR; PG8_MMA(0, 0, At, B0); PG8_BAR; PG8_SCHED;
            PG8_LDA(At, 1, 1); PG8_STAGE(PG8_SB(1, 0), b3, voffB); PG8_STAGE(PG8_SA(1, 0), a3, voffA);
            PG8_WAIT_V(6); PG8_WAIT_L(0); PG8_BAR; PG8_MMA(1, 0, At, B0); PG8_BAR; PG8_SCHED;
            } else if constexpr (SP2) {
            PG8_LDB(B0, 0, 0); PG8_LDB(B1, 0, 1); PG8_SCHED; PG8_LDA(At, 0, 0); PG8_STAGE(PG8_SA(1, 1), a1 + hstep, voffA);
            PG8_WAIT_V(8); PG8_WAIT_L(0); PG8_BAR; PG8_MMA(0, 0, At, B0); PG8_MMA(0, 1, At, B1); PG8_BAR; PG8_SCHED;
            PG8_LDA(At, 0, 1); PG8_STAGE(PG8_SB(0, 0), b2, voffB); PG8_STAGE(PG8_SB(0, 1), b2 + hstep, voffB); PG8_STAGE(PG8_SA(0, 0), a2, voffA);
            PG8_WAIT_V(8); PG8_WAIT_L(0); PG8_BAR; PG8_MMA(1, 0, At, B0); PG8_MMA(1, 1, At, B1); PG8_BAR; PG8_SCHED;
            PG8_LDB(B0, 1, 0); PG8_LDB(B1, 1, 1); PG8_SCHED; PG8_LDA(At, 1, 0); PG8_STAGE(PG8_SA(0, 1), a2 + hstep, voffA);
            PG8_WAIT_V(8); PG8_WAIT_L(0); PG8_BAR; PG8_MMA(0, 0, At, B0); PG8_MMA(0, 1, At, B1); PG8_BAR; PG8_SCHED;
            PG8_LDA(At, 1, 1); PG8_STAGE(PG8_SB(1, 0), b3, voffB); PG8_STAGE(PG8_SB(1, 1), b3 + hstep, voffB); PG8_STAGE(PG8_SA(1, 0), a3, voffA);
            PG8_WAIT_V(8); PG8_WAIT_L(0); PG8_BAR; PG8_MMA(1, 0, At, B0); PG8_MMA(1, 1, At, B1); PG8_BAR; PG8_SCHED;
            } else {
            PG8_LDB(B0, 0, 0); PG8_SCHED; PG8_LDA(At, 0, 0); PG8_STAGE(PG8_SA(1, 1), a1 + hstep, voffA);
            PG8_WAIT_L(8); PG8_BAR; PG8_WAIT_L(0); PG8_MMA(0, 0, At, B0); PG8_BAR; PG8_SCHED;
            PG8_LDB(B1, 0, 1); PG8_STAGE(PG8_SB(0, 0), b2, voffB);
            PG8_BAR; PG8_WAIT_L(0); PG8_MMA(0, 1, At, B1); PG8_BAR;
            PG8_LDA(At, 0, 1); PG8_STAGE(PG8_SA(0, 0), a2, voffA);
            PG8_BAR; PG8_WAIT_L(0); PG8_MMA(1, 0, At, B0); PG8_BAR; PG8_SCHED;
            PG8_STAGE(PG8_SB(0, 1), b2 + hstep, voffB);
            PG8_WAIT_V(6); PG8_BAR; PG8_MMA(1, 1, At, B1); PG8_BAR;
            PG8_LDB(B0, 1, 0); PG8_SCHED; PG8_LDA(At, 1, 0); PG8_STAGE(PG8_SA(0, 1), a2 + hstep, voffA);
            PG8_WAIT_L(8); PG8_BAR; PG8_WAIT_L(0); PG8_MMA(0, 0, At, B0); PG8_BAR; PG8_SCHED;
            PG8_LDB(B1, 1, 1); PG8_STAGE(PG8_SB(1, 0), b3, voffB);
            PG8_BAR; PG8_WAIT_L(0); PG8_MMA(0, 1, At, B1); PG8_BAR;
            PG8_LDA(At, 1, 1); PG8_STAGE(PG8_SA(1, 0), a3, voffA);
            PG8_BAR; PG8_WAIT_L(0); PG8_MMA(1, 0, At, B0); PG8_BAR; PG8_SCHED;
            PG8_STAGE(PG8_SB(1, 1), b3 + hstep, voffB);
            PG8_WAIT_V(6); PG8_BAR; PG8_MMA(1, 1, At, B1); PG8_BAR;
            }
        }
        if constexpr (ALIGN_EPI) { if (wr == 0) PG8_BAR; }
        if constexpr (!Epi::AFTER_DRAIN) { E(acc, cur, wr, wc, fr, fq); S.done(cur); }
        if (!has_next) break;
#pragma unroll
        for (int a = 0; a < 2; ++a)
#pragma unroll
            for (int b = 0; b < 2; ++b)
#pragma unroll
                for (int m = 0; m < 4; ++m)
#pragma unroll
                    for (int n = 0; n < 2; ++n) acc[a][b][m][n] = (f32x4){0.f, 0.f, 0.f, 0.f};
        cur = nxt; cA = nA; cB = nB; ++ui;
        if constexpr (ALIGN_EPI) { if (wr == 1) PG8_BAR; }
    }
    PG8_WAIT_V(0);
    if constexpr (!ALIGN_EPI) { if (wr == 0) PG8_BAR; }
    PG8_BAR;
#undef PG8_SA
#undef PG8_SB
#undef PG8_STAGE
#undef PG8_LDA
#undef PG8_LDB
#undef PG8_MMA
#undef PG8_WAIT_V
#undef PG8_WAIT_L
#undef PG8_BAR
#undef PG8_SCHED
}

__device__ __forceinline__ float xrow16_sum(float x) {
    auto s = __builtin_amdgcn_permlane16_swap(__float_as_uint(x), __float_as_uint(x), false, false); x = __uint_as_float(s[0]) + __uint_as_float(s[1]);
    auto t = __builtin_amdgcn_permlane32_swap(__float_as_uint(x), __float_as_uint(x), false, false); return __uint_as_float(t[0]) + __uint_as_float(t[1]);
}
struct EpiStore {
    static constexpr bool PERM = true, AFTER_DRAIN = false;
    bf16_t* O; int ldc; const float* rscale; int split_cols; size_t split_stride; float inv_n; bool slots; bool halfn = false;
    __device__ __forceinline__ void operator()(const f32x4 (&acc)[2][2][4][2], const Unit& u, int wr, int wc, int fr, int fq) const {
        const int row0 = u.pm * BM + wr * 64 + fr; int colt = u.pn * (halfn ? HALF : BM); bf16_t* base = O;
        if (split_cols) { const int t = colt / split_cols; base += (size_t)t * split_stride; colt -= t * split_cols; }
        const int col0 = colt + wc * 32 + 8 * fq;
#pragma unroll
        for (int ai = 0; ai < 2; ++ai)
#pragma unroll
            for (int m = 0; m < 4; ++m) { const int row = row0 + ai * HALF + m * 16; float sc = 1.f; if (slots) { const f32x4 s0 = *(const f32x4*)(rscale + (size_t)row * 32 + fq * 8), s1 = *(const f32x4*)(rscale + (size_t)row * 32 + fq * 8 + 4); sc = 1.0f / sqrtf(xrow16_sum((s0.x + s0.y) + (s0.z + s0.w) + (s1.x + s1.y) + (s1.z + s1.w)) * inv_n + EPS); } else if (inv_n > 0.f) sc = 1.0f / sqrtf(rscale[row] * inv_n + EPS); else if (rscale) sc = rscale[row]; bf16_t* rowp = base + (size_t)row * ldc + col0;
#pragma unroll
                for (int bj = 0; bj < 2; ++bj) if (bj == 0 || !halfn) *(u32x4*)(rowp + bj * HALF) = pack8(acc[ai][bj][m][0] * sc, acc[ai][bj][m][1] * sc); }
    }
};
struct EpiWin {
    static constexpr bool PERM = true, AFTER_DRAIN = false;
    bf16_t *CQ, *CKV, *Z, *XBC; float* TAIL; const float* rscale;
    __device__ __forceinline__ void operator()(const f32x4 (&acc)[2][2][4][2], const Unit& u, int wr, int wc, int fr, int fq) const {
        const int row0 = u.pm * BM + wr * 64 + fr, pn = u.pn;
        bf16_t* base; int ldc, colt;
        if (pn < 2) { base = CQ; ldc = 512; colt = pn * 256; } else if (pn < 4) { base = CKV; ldc = 512; colt = (pn - 2) * 256; }
        else if (pn < 8) { base = Z; ldc = 1024; colt = (pn - 4) * 256; } else { base = XBC; ldc = 2048; colt = (pn - 8) * 256; }
        const int cl = wc * 32 + 8 * fq;
#pragma unroll
        for (int ai = 0; ai < 2; ++ai)
#pragma unroll
            for (int m = 0; m < 4; ++m) { const int row = row0 + ai * HALF + m * 16; const float sc = 1.0f / sqrtf(rscale[row] * (1.f / 2048.f) + EPS);
                if (pn < 16) { bf16_t* rowp = base + (size_t)row * ldc + colt + cl;
#pragma unroll
                    for (int bj = 0; bj < 2; ++bj) *(u32x4*)(rowp + bj * HALF) = pack8(acc[ai][bj][m][0] * sc, acc[ai][bj][m][1] * sc); }
                else if (cl < 80) { float* rowp = TAIL + (size_t)row * 80 + cl; *(f32x4*)rowp = acc[ai][0][m][0] * sc; *(f32x4*)(rowp + 4) = acc[ai][0][m][1] * sc; } }
    }
};
struct EpiResid {
    static constexpr bool PERM = true, AFTER_DRAIN = false;
    bf16_t* X; float* SSQ; float fac;
    __device__ __forceinline__ void operator()(const f32x4 (&acc)[2][2][4][2], const Unit& u, int wr, int wc, int fr, int fq) const {
        const int row0 = u.pm * BM + wr * 64 + fr, col0 = u.pn * BM + wc * 32 + 8 * fq;
#pragma unroll
        for (int ai = 0; ai < 2; ++ai)
#pragma unroll
            for (int m = 0; m < 4; ++m) { const int row = row0 + ai * HALF + m * 16; const size_t off = (size_t)row * DM + col0; float ss = 0.f;
#pragma unroll
                for (int bj = 0; bj < 2; ++bj) { float f[8]; unpack8(*(const u32x4*)(X + off + bj * HALF), f);
                    const f32x4 v0 = (f32x4){f[0], f[1], f[2], f[3]} + acc[ai][bj][m][0] * fac, v1 = (f32x4){f[4], f[5], f[6], f[7]} + acc[ai][bj][m][1] * fac;
                    *(u32x4*)(X + off + bj * HALF) = pack8(v0, v1);
                    ss += ((v0.x * v0.x + v0.y * v0.y) + (v0.z * v0.z + v0.w * v0.w)) + ((v1.x * v1.x + v1.y * v1.y) + (v1.z * v1.z + v1.w * v1.w)); }
                ss = xrow16_sum(ss);
                if (SSQ && fq == 0) SSQ[(size_t)row * 32 + u.pn * 4 + wc] = ss; }
    }
};
struct EpiTail {
    static constexpr bool PERM = true, AFTER_DRAIN = false;
    EpiWin in;
    __device__ __forceinline__ void operator()(const f32x4 (&acc)[2][2][4][2], const Unit& u, int wr, int wc, int fr, int fq) const { const Unit t{u.pm, 16}; in(acc, t, wr, wc, fr, fq); }
};
}

#define XB_TMO      128
#define XB_XCNT(j)  (256  + 64 * (j))
#define XB_XSUB(j)  (1280 + 64 * (j))
#define XB_XGEN(j)  (2304 + 64 * (j))
#define XB_TOP      3328
#define XB_TOPGEN   3392
#define XCD_BAR_WORDS 3456
#define XB_SPIN_CAP (1u << 25)
__device__ __forceinline__ unsigned xb_ld(unsigned* p)              { return __hip_atomic_load(p, __ATOMIC_RELAXED, __HIP_MEMORY_SCOPE_AGENT); }
__device__ __forceinline__ unsigned xb_add(unsigned* p, unsigned v) { return __hip_atomic_fetch_add(p, v, __ATOMIC_RELAXED, __HIP_MEMORY_SCOPE_AGENT); }
__device__ __forceinline__ unsigned xb_xcc_id() { return (unsigned)__builtin_amdgcn_s_getreg((3 << 11) | 20) & 0xFu; }
#define XB_SPIN(cond, bar) do { unsigned _sp = 0; while (cond) { __builtin_amdgcn_s_sleep(1); \
    if ((++_sp & 255u) == 0u) { if (xb_ld(&(bar)[XB_TMO])) break; if (_sp > XB_SPIN_CAP) { atomicAdd(&(bar)[XB_TMO], 1u); break; } } } } while (0)
struct XcdBarrier { unsigned* bar; unsigned x; volatile LAS unsigned* st; };
__device__ __forceinline__ XcdBarrier xcd_barrier_post(unsigned* bar, volatile LAS unsigned* st) {
    XcdBarrier b; b.bar = bar; b.x = xb_xcc_id(); b.st = st;
    if (threadIdx.x == 0) (void)xb_add(&bar[XB_XCNT(b.x)], 1u);
    return b;
}
__device__ __forceinline__ void xcd_barrier_complete(unsigned* bar, unsigned x, unsigned& nloc, unsigned& nx) {
    const unsigned G = gridDim.x * gridDim.y * gridDim.z;
    unsigned sum, cnt, mine, sp = 0u;
    for (;;) {
        sum = 0u; cnt = 0u; mine = 0u;
#pragma unroll
        for (unsigned j = 0; j < 16; ++j) { const unsigned c = xb_ld(&bar[XB_XCNT(j)]); sum += c; cnt += (c > 0u) ? 1u : 0u; mine = (j == x) ? c : mine; }
        if (sum == G) break;
        __builtin_amdgcn_s_sleep(1);
        if ((++sp & 255u) == 0u) { if (xb_ld(&bar[XB_TMO])) break; if (sp > XB_SPIN_CAP) { atomicAdd(&bar[XB_TMO], 1u); break; } }
    }
    nloc = mine > 0u ? mine : 1u; nx = cnt > 0u ? cnt : 1u;
}
__device__ __forceinline__ void xcd_barrier(const XcdBarrier& b, bool is_t0) {
    asm volatile("s_waitcnt vmcnt(0)" ::: "memory");
    __syncthreads();
    if (is_t0) {
        unsigned* bar = b.bar;
        __builtin_amdgcn_s_waitcnt(0);
        unsigned nloc = b.st[0], nx = b.st[1];
        if (nloc == 0u) { xcd_barrier_complete(bar, b.x, nloc, nx); b.st[0] = nloc; b.st[1] = nx; }
        const unsigned old = xb_add(&bar[XB_XSUB(b.x)], 1u);
        const unsigned gen = old / nloc;
        if (old + 1u == (gen + 1u) * nloc) {
            __builtin_amdgcn_fence(__ATOMIC_RELEASE, "agent");
            asm volatile("s_waitcnt vmcnt(0)" ::: "memory");
            const unsigned og = xb_add(&bar[XB_TOP], 1u);
            const unsigned tg = og / nx;
            if (og + 1u == (tg + 1u) * nx) xb_add(&bar[XB_TOPGEN], 1u);
            else XB_SPIN(xb_ld(&bar[XB_TOPGEN]) == tg, bar);
            __builtin_amdgcn_fence(__ATOMIC_ACQUIRE, "agent");
            xb_add(&bar[XB_XGEN(b.x)], 1u);
            asm volatile("s_waitcnt vmcnt(0)" ::: "memory");
        } else {
            XB_SPIN(xb_ld(&bar[XB_XGEN(b.x)]) == gen, bar);
            __builtin_amdgcn_fence(__ATOMIC_ACQUIRE, "agent");
            asm volatile("s_waitcnt vmcnt(0)" ::: "memory");
        }
    }
    __syncthreads();
}

struct Args {
    const float* in[39]; const int* pos; float* out; unsigned char* ws; int ph_lo, ph_hi;
};
struct Frame {
    LAS unsigned char* lds; int tid, lane, wave, G, bid, gw, NGW;
    GAS unsigned char* ws;
};
#define WSP(T, off) ((T*)(F.ws + (off)))

__device__ __forceinline__ void transpose_item(const float* W, int K, int N, bf16_t* WT, int ldt, int dst_row0, const float* gain, LAS float* scr, int k0, int n0, int lane) {
    const int n4 = (lane & 7) * 4; const bool ok = n0 + n4 < N;
    f32x4 v[8];
#pragma unroll
    for (int i = 0; i < 8; ++i) { const int kk = (lane >> 3) + 8 * i; v[i] = ok ? *(const f32x4*)(W + (size_t)(k0 + kk) * N + n0 + n4) : (f32x4){0.f, 0.f, 0.f, 0.f}; }
#pragma unroll
    for (int i = 0; i < 8; ++i) { const int kk = (lane >> 3) + 8 * i; const float gg = gain ? gain[k0 + kk] : 1.f; LAS float* s = scr + kk * 33 + n4; s[0] = v[i].x * gg; s[1] = v[i].y * gg; s[2] = v[i].z * gg; s[3] = v[i].w * gg; }
    asm volatile("s_waitcnt lgkmcnt(0)" ::: "memory");
    const int c = lane & 7;
#pragma unroll
    for (int j = 0; j < 4; ++j) { const int n = (lane >> 3) + 8 * j; const LAS float* s = scr + (8 * c) * 33 + n;
        u32x4 o; o.x = cvt_pk_bf16(s[0 * 33], s[1 * 33]); o.y = cvt_pk_bf16(s[2 * 33], s[3 * 33]); o.z = cvt_pk_bf16(s[4 * 33], s[5 * 33]); o.w = cvt_pk_bf16(s[6 * 33], s[7 * 33]);
        *(u32x4*)(WT + (size_t)(dst_row0 + n) * ldt + k0 + 8 * c) = o; }
    asm volatile("s_waitcnt lgkmcnt(0)" ::: "memory");
}
__device__ __forceinline__ void transpose_matrix(Frame& F, const float* W, int K, int N, bf16_t* WT, int row_off, const float* gain, LAS float* scr) {
    const int nblk = (N + 31) / 32, items = (K / 64) * nblk;
    for (int it = F.gw; it < items; it += F.NGW) { const int kb = it / nblk, nb = it % nblk; transpose_item(W, K, N, WT, K, row_off + nb * 32, gain, scr, kb * 64, nb * 32, F.lane); }
}
__device__ __forceinline__ int win_dst_row(int n0) {
    if (n0 < 1024) return n0; if (n0 < 1088) return 4096 + (n0 - 1024); if (n0 < 2112) return 1024 + (n0 - 1088); if (n0 < 4160) return 2048 + (n0 - 2112); return 4160;
}
__device__ __forceinline__ void rowstat_row(const float* xrow, bf16_t* orow, float* rstd_out, int lane) {
    f32x4 v[8]; float s = 0.f;
#pragma unroll
    for (int j = 0; j < 8; ++j) v[j] = *(const f32x4*)(xrow + j * 256 + lane * 4);
#pragma unroll
    for (int j = 0; j < 8; ++j) s += (v[j].x * v[j].x + v[j].y * v[j].y) + (v[j].z * v[j].z + v[j].w * v[j].w);
    s = wave_sum(s, lane);
#pragma unroll
    for (int j = 0; j < 8; ++j) { u32x2 o; o.x = cvt_pk_bf16(v[j].x, v[j].y); o.y = cvt_pk_bf16(v[j].z, v[j].w); *(u32x2*)(orow + j * 256 + lane * 4) = o; }
    if (lane == 0) *rstd_out = s;
}
__device__ __forceinline__ void rowstat_phase(Frame& F, const float* X, bf16_t* XB, float* RSTD, int nrows) {
    for (int m = F.gw; m < nrows; m += F.NGW) rowstat_row(X + (size_t)m * DM, XB + (size_t)m * DM, RSTD + m, F.lane);
}

constexpr int PEER_V4_MASK = 3;
constexpr int PEER_U4_MASK = 3;
constexpr int TCONV_G = 256, TCONV_FIRST = 64, TCONV_BLOCKS = 128;
__device__ __forceinline__ void convert_table_rows(Frame& F, const Args& a, int r0, int r1, int w0, int nw) {
    if (r0 + w0 >= r1) return;
    const int l = r0 / PEER_E;
    const bool u4 = (PEER_U4_MASK >> l) & 1, v4 = (PEER_V4_MASK >> l) & 1;
    f32x4 vg[8];
    { const float* gain = a.in[6] + l * 2048;
#pragma unroll
      for (int q = 0; q < 8; ++q) vg[q] = *(const f32x4*)(gain + q * 256 + F.lane * 4); }
    f32x4 nu[8], nv[8];
#define CV_LOAD(row) do { _Pragma("unroll") for (int q = 0; q < 8; ++q) { const size_t o_ = (size_t)(row) * 2048 + q * 256 + F.lane * 4; nu[q] = *(const f32x4*)(a.in[14] + o_); nv[q] = *(const f32x4*)(a.in[15] + o_); } } while (0)
    unsigned pu[8], pv[8]; float su = 0.f, sv = 0.f; int rp = r0 + w0;
#define CV_STORE() do { const int er_ = rp % PEER_E; unsigned char* du_ = WSP(unsigned char, WS_U8) + (size_t)l * PEER_E * 2048 + (size_t)er_ * 128; unsigned char* dv_ = WSP(unsigned char, WS_V8) + (size_t)l * PEER_E * 2048 + (size_t)er_ * 128; \
        _Pragma("unroll") for (int q = 0; q < 8; ++q) { const size_t so_ = (size_t)(q * 2 + (F.lane >> 5)) * PEER_E * 128 + (F.lane & 31) * 4, s4_ = (size_t)q * PEER_E * 128 + (F.lane >> 1) * 4; \
            if (!u4) *(unsigned*)(du_ + so_) = pu[q]; else if ((F.lane & 1) == 0) *(unsigned*)(du_ + s4_) = pu[q]; \
            if (!v4) *(unsigned*)(dv_ + so_) = pv[q]; else if ((F.lane & 1) == 0) *(unsigned*)(dv_ + s4_) = pv[q]; } \
        if (F.lane == 0) { WSP(float, WS_TSC)[rp] = su; WSP(float, WS_TSC)[(size_t)2 * PEER_E + rp] = sv; } } while (0)
#define S8(x, s) (((unsigned)(int)__builtin_rintf((x) * (s))) & 0xffu)
#define T4(x, s) ((unsigned)(((int)__builtin_rintf((x) * (s)) + o8) & 0xF))
#define CV_PACK(row) do { float mu = 0.f, mv = 0.f; \
        _Pragma("unroll") for (int i = 0; i < 8; ++i) { vu[i] = vu[i] * vg[i]; \
            mu = fmaxf(fmaxf(mu, fmaxf(fabsf(vu[i].x), fabsf(vu[i].y))), fmaxf(fabsf(vu[i].z), fabsf(vu[i].w))); \
            mv = fmaxf(fmaxf(mv, fmaxf(fabsf(vv[i].x), fabsf(vv[i].y))), fmaxf(fabsf(vv[i].z), fabsf(vv[i].w))); } \
        mu = wave_max(mu); mv = wave_max(mv); \
        const float iu = mu > 0.f ? (u4 ? 7.f : 127.f) / mu : 0.f, iv = mv > 0.f ? (v4 ? 7.f : 127.f) / mv : 0.f; const int o8 = (F.lane & 1) ? 0 : 8; \
        _Pragma("unroll") for (int q = 0; q < 8; ++q) { const f32x4 x = vu[q], y = vv[q]; \
            if (!u4) pu[q] = S8(x.x, iu) | (S8(x.y, iu) << 8) | (S8(x.z, iu) << 16) | (S8(x.w, iu) << 24); \
            else { const unsigned nb = T4(x.x, iu) | (T4(x.y, iu) << 8) | (T4(x.z, iu) << 16) | (T4(x.w, iu) << 24); pu[q] = nb | ((unsigned)dppi<0xB1>((int)nb) << 4); }        \
            if (!v4) pv[q] = S8(y.x, iv) | (S8(y.y, iv) << 8) | (S8(y.z, iv) << 16) | (S8(y.w, iv) << 24); \
            else { const unsigned nb = T4(y.x, iv) | (T4(y.y, iv) << 8) | (T4(y.z, iv) << 16) | (T4(y.w, iv) << 24); pv[q] = nb | ((unsigned)dppi<0xB1>((int)nb) << 4); } } \
        su = mu * (u4 ? 1.f / 7.f : 1.f / 127.f); sv = mv * (v4 ? 1.f / 7.f : 1.f / 127.f); rp = (row); } while (0)
    CV_LOAD(r0 + w0);
    { f32x4 vu[8], vv[8];
#pragma unroll
      for (int q = 0; q < 8; ++q) { vu[q] = nu[q]; vv[q] = nv[q]; }
      { const int rn = r0 + w0 + nw < r1 ? r0 + w0 + nw : r0 + w0; CV_LOAD(rn); }
      CV_PACK(r0 + w0); }
#pragma unroll 1
    for (int r = r0 + w0 + nw; r < r1; r += nw) {
        f32x4 vu[8], vv[8];
#pragma unroll
        for (int q = 0; q < 8; ++q) { vu[q] = nu[q]; vv[q] = nv[q]; }
        CV_STORE();
        { const int rn = r + nw < r1 ? r + nw : r; CV_LOAD(rn); }
        CV_PACK(r);
    }
    CV_STORE();
#undef CV_LOAD
#undef CV_STORE
#undef CV_PACK
#undef S8
#undef T4
}
__device__ __forceinline__ void transpose_matrix_w(int w0, int nw, int lane, const float* W, int K, int N, bf16_t* WT, const float* gain, LAS float* scr) {
    const int nblk = (N + 31) / 32, items = (K / 64) * nblk;
    for (int it = w0; it < items; it += nw) { const int kb = it / nblk, nb = it % nblk; transpose_item(W, K, N, WT, K, nb * 32, gain, scr, kb * 64, nb * 32, lane); }
}
__device__ __forceinline__ void p_layer1_weights(Frame& F, const Args& a, int w0, int nw) {
    LAS float* scr = (LAS float*)(F.lds + F.wave * 16384);
    transpose_matrix_w(w0, nw, F.lane, a.in[30], 2048, 6144, WSP(bf16_t, WS_WQKV), a.in[3] + 2048, scr);
    transpose_matrix_w(w0, nw, F.lane, a.in[38], 2048, 2048, WSP(bf16_t, WS_WO), nullptr, scr);
    transpose_matrix_w(w0, nw, F.lane, a.in[7] + (size_t)2048 * 512, 2048, 512, WSP(bf16_t, WS_WMEMQ) + (size_t)512 * 2048, a.in[4] + 2048, scr);
    transpose_matrix_w(w0, nw, F.lane, a.in[11] + (size_t)512 * 2048, 512, 2048, WSP(bf16_t, WS_WMEMO) + (size_t)2048 * 512, nullptr, scr);
    transpose_matrix_w(w0, nw, F.lane, a.in[12] + (size_t)2048 * 2048, 2048, 2048, WSP(bf16_t, WS_WPEERQ) + (size_t)2048 * 2048, a.in[6] + 2048, scr);
}
__device__ __forceinline__ void p_layer0_late_weights(Frame& F, const Args& a, int w0, int nw) {
    LAS float* scr = (LAS float*)(F.lds + F.wave * 16384);
    transpose_matrix_w(w0, nw, F.lane, a.in[29], 2048, 2048, WSP(bf16_t, WS_WOUT), nullptr, scr);
    transpose_matrix_w(w0, nw, F.lane, a.in[7], 2048, 512, WSP(bf16_t, WS_WMEMQ), a.in[4], scr);
    transpose_matrix_w(w0, nw, F.lane, a.in[11], 512, 2048, WSP(bf16_t, WS_WMEMO), nullptr, scr);
    transpose_matrix_w(w0, nw, F.lane, a.in[12], 2048, 2048, WSP(bf16_t, WS_WPEERQ), a.in[6], scr);
}
__device__ __forceinline__ void p_prologue(Frame& F, const Args& a) {
    LAS float* scr = (LAS float*)(F.lds + F.wave * 16384);
    {
        const float* W = a.in[16]; const float* gain = a.in[3]; bf16_t* WT = WSP(bf16_t, WS_WIN);
        const int nblk = 131, items = 32 * nblk;
        for (int it = F.gw; it < items; it += F.NGW) { const int kb = it / nblk, nb = it % nblk; transpose_item(W, 2048, EVEN_IN, WT, 2048, win_dst_row(nb * 32), gain, scr, kb * 64, nb * 32, F.lane); }
        for (int i = F.gw * 64 + F.lane; i < (4352 - 4192) * 2048 / 8; i += F.NGW * 64) *(u32x4*)(WT + (size_t)4192 * 2048 + (size_t)i * 8) = (u32x4){0u, 0u, 0u, 0u};
    }
    transpose_matrix(F, a.in[19], 512, 1536, WSP(bf16_t, WS_WUQ), 0, a.in[17], scr);
    transpose_matrix(F, a.in[20], 512, 2048, WSP(bf16_t, WS_WUKV), 0, a.in[18], scr);
    if (F.G != TCONV_G) p_layer0_late_weights(F, a, F.gw, F.NGW);
    for (int l = 0; l < 2; ++l) transpose_matrix(F, a.in[8] + (size_t)l * 2048 * 1024, 2048, 1024, WSP(bf16_t, WS_WMEMKV) + (size_t)l * 1024 * 2048, 0, a.in[5] + l * 2048, scr);
    if (F.G != TCONV_G) p_layer1_weights(F, a, F.gw, F.NGW);
    { const float* src = a.in[13]; bf16_t* dst = WSP(bf16_t, WS_KEYS); const int n8 = 2 * 8 * 2 * 128 * 128 / 8;
      for (int i = F.gw * 64 + F.lane; i < n8; i += F.NGW * 64) *(u32x4*)(dst + (size_t)i * 8) = pack8(*(const f32x4*)(src + (size_t)i * 8), *(const f32x4*)(src + (size_t)i * 8 + 4)); }
    if (F.G != TCONV_G) { convert_table_rows(F, a, 0, PEER_E, F.gw, F.NGW); convert_table_rows(F, a, PEER_E, 2 * PEER_E, F.gw, F.NGW); }
    { f32x2* r32 = WSP(f32x2, WS_ROPE32); f32x2* r64 = WSP(f32x2, WS_ROPE64);
      for (int i = F.gw * 64 + F.lane; i < TOK * 96; i += F.NGW * 64) { const int t = i / 96, j = i % 96; const bool is32 = j < 32; const int jj = is32 ? j : j - 32; const float half = is32 ? 32.f : 64.f;
          const float inv = 1.0f / exp2f(((float)jj / half) * 13.287712379549449f);
          const float ang = (float)a.pos[t] * inv;
          double rv = (double)ang * 0.15915494309189535; rv -= __builtin_rint(rv);
          const float fr = (float)rv; const f32x2 cs = {__builtin_amdgcn_cosf(fr), __builtin_amdgcn_sinf(fr)};
          if (is32) r32[(size_t)t * 32 + jj] = cs; else r64[(size_t)t * 64 + jj] = cs; } }
    rowstat_phase(F, a.in[0], WSP(bf16_t, WS_XB), WSP(float, WS_RSTD), TOK);
    rowstat_phase(F, a.in[1], WSP(bf16_t, WS_MEMB), WSP(float, WS_RSTD_MEM), BATCH * NMEM);
}


namespace att {
__device__ __forceinline__ int crow(int r, int hi) { return (r & 3) + 8 * (r >> 2) + 4 * hi; }
template <int ND> __device__ __forceinline__ int v_st(int k, int c) { const int kk = (k & ~0xC) | ((k & 4) << 1) | ((k & 8) >> 1); return ((kk >> 3) * ND + (c >> 5)) * 512 + ((kk & 7) * 32 + (c & 31)) * 2; }
__device__ __forceinline__ int v_rd_base(int lane) { return ((lane & 3) << 3) | (((lane >> 2) & 3) << 6) | (((lane >> 4) & 1) << 5) | (((lane >> 5) & 1) << 8); }
#define ATT_TR(dst, off) asm volatile("ds_read_b64_tr_b16 %0, %1 offset:%2" : "=&v"(dst) : "v"(vb), "i"(off) : "memory")
#define ATT_PK(L, H) (bf16x8){L[0], L[1], L[2], L[3], H[0], H[1], H[2], H[3]}
template <int BASE> __device__ __forceinline__ bf16x8 att_pk4(const f32x16& P) {
    const unsigned a0 = cvt_pk_bf16(P[BASE + 0], P[BASE + 1]), a1 = cvt_pk_bf16(P[BASE + 2], P[BASE + 3]), b0 = cvt_pk_bf16(P[BASE + 4], P[BASE + 5]), b1 = cvt_pk_bf16(P[BASE + 6], P[BASE + 7]);
    auto r0 = __builtin_amdgcn_permlane32_swap(a0, b0, false, false); auto r1 = __builtin_amdgcn_permlane32_swap(a1, b1, false, false);
    const u32x4 w = {r0[0], r1[0], r0[1], r1[1]}; return __builtin_bit_cast(bf16x8, w);
}
template <int ND, int D0> __device__ __forceinline__ void sm_slice(f32x16& p1, float Cr, float mnC, float& ps1, bf16x8& pa2, bf16x8& pa3) {
    if constexpr (D0 + 1 < ND) { constexpr int R0 = D0 * 16 / (ND - 1), R1 = (D0 + 1) * 16 / (ND - 1);
#pragma unroll
        for (int r = R0; r < R1; ++r) p1[r] = __builtin_amdgcn_exp2f(fmaf(p1[r], Cr, mnC)); }
    else { ps1 = ((p1[0] + p1[1]) + (p1[2] + p1[3])) + ((p1[4] + p1[5]) + (p1[6] + p1[7])) + (((p1[8] + p1[9]) + (p1[10] + p1[11])) + ((p1[12] + p1[13]) + (p1[14] + p1[15])));
           pa2 = att_pk4<0>(p1); pa3 = att_pk4<8>(p1); }
}
template <int ND, int D0> struct PvB {
    static __device__ __forceinline__ void run(f32x16* o, int vb, bf16x8 pa2, bf16x8 pa3, s16x4& c0, s16x4& c1, s16x4& c2, s16x4& c3, s16x4& n0, s16x4& n1, s16x4& n2, s16x4& n3) {
        constexpr int KS = 2 * ND * 512, HF = ND * 512;
        if constexpr (D0 + 1 < ND) { constexpr int NB = (D0 + 1) * 512; ATT_TR(n0, NB + 2 * KS); ATT_TR(n1, NB + 2 * KS + HF); ATT_TR(n2, NB + 3 * KS); ATT_TR(n3, NB + 3 * KS + HF); asm volatile("s_waitcnt lgkmcnt(4)" ::: "memory"); }
        else asm volatile("s_waitcnt lgkmcnt(0)" ::: "memory");
        __builtin_amdgcn_sched_barrier(0);
        o[D0] = __builtin_amdgcn_mfma_f32_32x32x16_bf16(pa2, ATT_PK(c0, c1), o[D0], 0, 0, 0);
        o[D0] = __builtin_amdgcn_mfma_f32_32x32x16_bf16(pa3, ATT_PK(c2, c3), o[D0], 0, 0, 0);
        __builtin_amdgcn_sched_barrier(0);
        if constexpr (D0 + 1 < ND) PvB<ND, D0 + 1>::run(o, vb, pa2, pa3, n0, n1, n2, n3, c0, c1, c2, c3);
    }
};
template <int ND, int D0> struct PvA {
    static __device__ __forceinline__ void run(f32x16* o, int vb, bf16x8 pa0, bf16x8 pa1, bf16x8& pa2, bf16x8& pa3, f32x16& p1, float Cr, float mnC, float& ps1,
                                               s16x4& c0, s16x4& c1, s16x4& c2, s16x4& c3, s16x4& n0, s16x4& n1, s16x4& n2, s16x4& n3) {
        constexpr int KS = 2 * ND * 512, HF = ND * 512;
        if constexpr (D0 + 1 < ND) { constexpr int NB = (D0 + 1) * 512; ATT_TR(n0, NB); ATT_TR(n1, NB + HF); ATT_TR(n2, NB + KS); ATT_TR(n3, NB + KS + HF); }
        else { ATT_TR(n0, 2 * KS); ATT_TR(n1, 2 * KS + HF); ATT_TR(n2, 3 * KS); ATT_TR(n3, 3 * KS + HF); }
        asm volatile("s_waitcnt lgkmcnt(4)" ::: "memory"); __builtin_amdgcn_sched_barrier(0);
        o[D0] = __builtin_amdgcn_mfma_f32_32x32x16_bf16(pa0, ATT_PK(c0, c1), o[D0], 0, 0, 0);
        o[D0] = __builtin_amdgcn_mfma_f32_32x32x16_bf16(pa1, ATT_PK(c2, c3), o[D0], 0, 0, 0);
        __builtin_amdgcn_sched_barrier(0);
        sm_slice<ND, D0>(p1, Cr, mnC, ps1, pa2, pa3);
        __builtin_amdgcn_sched_barrier(0);
        if constexpr (D0 + 1 < ND) PvA<ND, D0 + 1>::run(o, vb, pa0, pa1, pa2, pa3, p1, Cr, mnC, ps1, n0, n1, n2, n3, c0, c1, c2, c3);
        else PvB<ND, 0>::run(o, vb, pa2, pa3, n0, n1, n2, n3, c0, c1, c2, c3);
    }
};
template <int ND> __device__ __forceinline__ void pv_all(f32x16* o, int vb, bf16x8 pa0, bf16x8 pa1, f32x16& p1, float Cr, float mnC, float& ps1) {
    constexpr int KS = 2 * ND * 512, HF = ND * 512;
    s16x4 a0, a1, a2, a3, b0, b1, b2, b3; bf16x8 pa2, pa3;
    ATT_TR(a0, 0); ATT_TR(a1, HF); ATT_TR(a2, KS); ATT_TR(a3, KS + HF);
    PvA<ND, 0>::run(o, vb, pa0, pa1, pa2, pa3, p1, Cr, mnC, ps1, a0, a1, a2, a3, b0, b1, b2, b3);
}
template <int DQK, int DV, bool CAUSAL, bool QNORM = false, int NRP = 0, bool DIFFC = false>
__device__ __forceinline__ void attn_unit(LAS unsigned char* lds, const bf16_t* __restrict__ Qb, int ldq, const bf16_t* __restrict__ Kh, int ldk, const bf16_t* __restrict__ Vh, int ldv,
                                          bf16_t* __restrict__ Ob, int ldo, int NT, int q0, float C, int tid_in, const float* __restrict__ qgain = nullptr, const f32x2* __restrict__ qrope = nullptr,
                                          const bf16_t* O1b = nullptr, bf16_t* Mb = nullptr, int ldm = 0, float dlam = 0.f, const float* __restrict__ cgain = nullptr, float cscale = 1.f) {
    constexpr int NQ = DQK / 16, ND = DV / 32, RBK = DQK * 2, SHM_K = 64 * RBK, SHM_V = 64 * DV * 2;
    constexpr int KCH = DQK / 8, VCH = DV / 8, NKS = 64 * KCH / 512, NVS = 64 * VCH / 512, OST = 128 + 8;
    int tid = tid_in; asm volatile("" : "+v"(tid));
    const int wid = tid >> 6, lane = tid & 63, r32 = lane & 31, hi = lane >> 5;
    LAS float* wsf = (LAS float*)lds + wid * 64; LAS float* li_l = wsf; LAS float* al_l = wsf + 32;
    LAS unsigned char* V_lds = lds + 2048; LAS unsigned char* K_lds = lds + 2048 + 2 * SHM_V;
    float m_reg = -1e30f, l_reg = 0.f; f32x16 o[ND]; bf16x8 qr[NQ];
#pragma unroll
    for (int d = 0; d < ND; ++d)
#pragma unroll
        for (int r = 0; r < 16; ++r) o[d][r] = 0.f;
    { const int qoff = (wid * 32 + r32) * ldq + hi * 8;
#pragma unroll
      for (int d0 = 0; d0 < NQ; ++d0) qr[d0] = *(const bf16x8*)(Qb + (qoff + d0 * 16)); }
    if constexpr (NRP > 0) {
        constexpr int D0R = (DQK - 2 * NRP) / 16, NRD = NRP / 16;
        f32x4 cs[NRD][4];
#pragma unroll
        for (int dd = 0; dd < NRD; ++dd)
#pragma unroll
            for (int e2 = 0; e2 < 4; ++e2) cs[dd][e2] = *(const f32x4*)(qrope + ((wid * 32 + r32) * NRP + dd * 16 + hi * 8 + e2 * 2));
        float ss = 0.f;
#pragma unroll
        for (int d0 = 0; d0 < NQ; ++d0) { float f[8]; unpack8(__builtin_bit_cast(u32x4, qr[d0]), f);
#pragma unroll
            for (int e = 0; e < 8; ++e) ss += f[e] * f[e]; }
        { auto rr = __builtin_amdgcn_permlane32_swap(__float_as_uint(ss), __float_as_uint(ss), false, false); ss = __uint_as_float(rr[0]) + __uint_as_float(rr[1]); }
        const float rs = 1.0f / sqrtf(ss * (1.f / DQK) + EPS);
#define ATT_QG(f, d0) do { const f32x4 g0_ = *(const f32x4*)(qgain + (d0) * 16 + hi * 8), g1_ = *(const f32x4*)(qgain + (d0) * 16 + hi * 8 + 4); \
            f[0] *= rs * g0_.x; f[1] *= rs * g0_.y; f[2] *= rs * g0_.z; f[3] *= rs * g0_.w; f[4] *= rs * g1_.x; f[5] *= rs * g1_.y; f[6] *= rs * g1_.z; f[7] *= rs * g1_.w; } while (0)
#define ATT_QP(f) __builtin_bit_cast(bf16x8, pack8((f32x4){f[0], f[1], f[2], f[3]}, (f32x4){f[4], f[5], f[6], f[7]}))
#pragma unroll
        for (int d0 = 0; d0 < D0R; ++d0) { float f[8]; unpack8(__builtin_bit_cast(u32x4, qr[d0]), f); ATT_QG(f, d0); qr[d0] = ATT_QP(f); }
#pragma unroll
        for (int dd = 0; dd < NRD; ++dd) { const int d0 = D0R + dd, d1 = d0 + NRD; float fa[8], fb[8]; unpack8(__builtin_bit_cast(u32x4, qr[d0]), fa); unpack8(__builtin_bit_cast(u32x4, qr[d1]), fb); ATT_QG(fa, d0); ATT_QG(fb, d1);
#pragma unroll
            for (int e2 = 0; e2 < 4; ++e2) { const f32x4 c = cs[dd][e2];
                const float a0 = fa[2 * e2], b0 = fb[2 * e2], a1 = fa[2 * e2 + 1], b1 = fb[2 * e2 + 1];
                fa[2 * e2] = a0 * c.x - b0 * c.y; fb[2 * e2] = b0 * c.x + a0 * c.y; fa[2 * e2 + 1] = a1 * c.z - b1 * c.w; fb[2 * e2 + 1] = b1 * c.z + a1 * c.w; }
            qr[d0] = ATT_QP(fa); qr[d1] = ATT_QP(fb); }
#undef ATT_QG
#undef ATT_QP
    }
    float Cr = C;
    if constexpr (QNORM) { float ss = 0.f;
#pragma unroll
        for (int d0 = 0; d0 < NQ; ++d0) { float f[8]; unpack8(__builtin_bit_cast(u32x4, qr[d0]), f);
#pragma unroll
            for (int e = 0; e < 8; ++e) ss += f[e] * f[e]; }
        { auto rr = __builtin_amdgcn_permlane32_swap(__float_as_uint(ss), __float_as_uint(ss), false, false); ss = __uint_as_float(rr[0]) + __uint_as_float(rr[1]); }
        Cr = C / sqrtf(ss * (1.f / DQK) + EPS); }
    const int widu = __builtin_amdgcn_readfirstlane(wid); int kgo[NKS], vgo[NVS];
#pragma unroll
    for (int i = 0; i < NKS; ++i) { const int s = (i * 8 + wid) * 64 + lane, row = s / KCH, pos = s % KCH, ch = pos ^ (row & 7); kgo[i] = row * ldk + ch * 8; }
#pragma unroll
    for (int i = 0; i < NVS; ++i) { const int s = (i * 8 + wid) * 64 + lane, sub = s >> 5, within = s & 31, kk = (sub / ND) * 8 + (within >> 2), k = (kk & ~0xC) | ((kk & 4) << 1) | ((kk & 8) >> 1), c = (sub % ND) * 32 + (within & 3) * 8; vgo[i] = k * ldv + c; }
#define ATT_DMA(b, k0) do { const bf16_t* kb_ = Kh + (size_t)(k0) * ldk; const bf16_t* vb_ = Vh + (size_t)(k0) * ldv; \
        _Pragma("unroll") for (int i = 0; i < NKS; ++i) __builtin_amdgcn_global_load_lds((const unsigned*)(kb_ + kgo[i]), (LAS unsigned*)(K_lds + (b) * SHM_K + (i * 8 + widu) * 1024), 16, 0, 0); \
        _Pragma("unroll") for (int i = 0; i < NVS; ++i) __builtin_amdgcn_global_load_lds((const unsigned*)(vb_ + vgo[i]), (LAS unsigned*)(V_lds + (b) * SHM_V + (i * 8 + widu) * 1024), 16, 0, 0); } while (0)
    const int vb0 = (int)(uintptr_t)V_lds + v_rd_base(lane);
    ATT_DMA(0, 0);
    if (widu >= 4) __builtin_amdgcn_s_setprio(1);
    for (int j = 0; j < NT; ++j) {
        asm volatile("s_waitcnt vmcnt(0)" ::: "memory");
        __syncthreads();
        if (j + 1 < NT) ATT_DMA((j + 1) & 1, (j + 1) * 64);
        if (CAUSAL && 64 * j > q0 + widu * 32 + 31) continue;
        __builtin_amdgcn_sched_barrier(0);
        f32x16 p0, p1;
#pragma unroll
        for (int r = 0; r < 16; ++r) { p0[r] = 0.f; p1[r] = 0.f; }
        { const LAS unsigned char* Ks = K_lds + (j & 1) * SHM_K;
          bf16x8 kb0 = *(const LAS bf16x8*)(Ks + r32 * RBK + ((hi * 16) ^ ((r32 & 7) << 4))), kb1 = *(const LAS bf16x8*)(Ks + (32 + r32) * RBK + ((hi * 16) ^ ((r32 & 7) << 4)));
          __builtin_amdgcn_sched_barrier(0);
#pragma unroll
          for (int d0 = 0; d0 < NQ; ++d0) { const int cb = ((d0 + 1) * 16 + hi * 8) * 2; bf16x8 nb0 = kb0, nb1 = kb1;
              if (d0 + 1 < NQ) { nb0 = *(const LAS bf16x8*)(Ks + r32 * RBK + (cb ^ ((r32 & 7) << 4))); nb1 = *(const LAS bf16x8*)(Ks + (32 + r32) * RBK + (cb ^ ((r32 & 7) << 4))); }
              p0 = __builtin_amdgcn_mfma_f32_32x32x16_bf16(kb0, qr[d0], p0, 0, 0, 0);
              p1 = __builtin_amdgcn_mfma_f32_32x32x16_bf16(kb1, qr[d0], p1, 0, 0, 0);
              __builtin_amdgcn_sched_group_barrier(0x100, 2, 0); __builtin_amdgcn_sched_group_barrier(0x008, 2, 0);
              kb0 = nb0; kb1 = nb1; } }
        if (CAUSAL) {
            if (64 * j + 63 > q0 + wid * 32) { const int lim = q0 + wid * 32 + r32 - 64 * j - 4 * hi;
#pragma unroll
                for (int r = 0; r < 16; ++r) { if ((r & 3) + 8 * (r >> 2) > lim) p0[r] = -1e30f; if ((r & 3) + 8 * (r >> 2) + 32 > lim) p1[r] = -1e30f; } } }
        __builtin_amdgcn_sched_barrier(0);
        float pmax = p0[0];
#pragma unroll
        for (int r = 1; r < 16; ++r) pmax = fmaxf(pmax, p0[r]);
#pragma unroll
        for (int r = 0; r < 16; ++r) pmax = fmaxf(pmax, p1[r]);
        { auto rr = __builtin_amdgcn_permlane32_swap(__float_as_uint(pmax), __float_as_uint(pmax), false, false); pmax = fmaxf(__uint_as_float(rr[0]), __uint_as_float(rr[1])); }
        float alpha = 1.f;
        if (!__all((pmax - m_reg) * Cr <= 11.541560327f)) { const float mn = fmaxf(m_reg, pmax); alpha = __builtin_amdgcn_exp2f((m_reg - mn) * Cr); m_reg = mn; }
        if (__any(alpha < 1.f)) { if (hi == 0) al_l[r32] = alpha; asm volatile("s_waitcnt lgkmcnt(0)" ::: "memory");
#pragma unroll
            for (int r = 0; r < 16; ++r) { const float af = al_l[crow(r, hi)];
#pragma unroll
                for (int d = 0; d < ND; ++d) o[d][r] *= af; } }
        const float mnC = -m_reg * Cr; float ps = 0.f, ps1 = 0.f;
#pragma unroll
        for (int r = 0; r < 16; ++r) { p0[r] = __builtin_amdgcn_exp2f(fmaf(p0[r], Cr, mnC)); ps += p0[r]; }
        const bf16x8 pa0 = att_pk4<0>(p0), pa1 = att_pk4<8>(p0);
        __builtin_amdgcn_sched_barrier(0);
        pv_all<ND>(o, vb0 + (j & 1) * SHM_V, pa0, pa1, p1, Cr, mnC, ps1);
        ps += ps1;
        { auto rr = __builtin_amdgcn_permlane32_swap(__float_as_uint(ps), __float_as_uint(ps), false, false); ps = __uint_as_float(rr[0]) + __uint_as_float(rr[1]); }
        l_reg = l_reg * alpha + ps;
    }
#undef ATT_DMA
    __builtin_amdgcn_s_setprio(0);
    __syncthreads();
    {
    const int lane = lane_id(), r32 = lane & 31, hi = lane >> 5, wid = widu; LAS float* li_l = (LAS float*)lds + widu * 64;
    if (hi == 0) li_l[r32] = l_reg;
    asm volatile("s_waitcnt lgkmcnt(0)" ::: "memory");
    LAS bf16_t* ost = (LAS bf16_t*)(lds + 2048) + wid * (32 * OST);
    if constexpr (DIFFC) { if (dlam != 0.f) {
        u32x4 vp[2][8]; float ss[8];
        __builtin_amdgcn_fence(__ATOMIC_ACQUIRE, "workgroup");
#pragma unroll
        for (int i = 0; i < 8; ++i) ss[i] = 0.f;
#pragma unroll
        for (int hb = 0; hb < 2; ++hb) {
#pragma unroll
            for (int r = 0; r < 16; ++r) { const int row = crow(r, hi); const float inv = __builtin_amdgcn_rcpf(li_l[row]);
#pragma unroll
                for (int d = 0; d < 4; ++d) ost[row * OST + d * 32 + r32] = f2bf(o[4 * hb + d][r] * inv); }
            asm volatile("s_waitcnt lgkmcnt(0)" ::: "memory");
            u32x4 w1[8];
#pragma unroll
            for (int i = 0; i < 8; ++i) { const int cc = lane + 64 * i, row = cc / 16, ch = cc % 16;
                w1[i] = *(const u32x4*)(O1b + ((wid * 32 + row) * ldo + hb * 128 + ch * 8)); }
#pragma unroll
            for (int i = 0; i < 8; ++i) { const int cc = lane + 64 * i, row = cc / 16, ch = cc % 16; float f1[8], f2[8];
                unpack8(w1[i], f1); unpack8(*(const LAS u32x4*)(ost + row * OST + ch * 8), f2);
#pragma unroll
                for (int e = 0; e < 8; ++e) { f1[e] -= dlam * f2[e]; ss[i] += f1[e] * f1[e]; }
                vp[hb][i] = pack8((f32x4){f1[0], f1[1], f1[2], f1[3]}, (f32x4){f1[4], f1[5], f1[6], f1[7]}); }
            asm volatile("s_waitcnt lgkmcnt(0)" ::: "memory");
        }
#pragma unroll
        for (int i = 0; i < 8; ++i) { float t = row16_sum(ss[i]); ss[i] = cscale / sqrtf(t * (1.f / 256.f) + EPS); }
#pragma unroll
        for (int hb = 0; hb < 2; ++hb)
#pragma unroll
            for (int i = 0; i < 8; ++i) { const int cc = lane + 64 * i, row = cc / 16, ch = cc % 16; float f[8]; unpack8(vp[hb][i], f);
                const f32x4 g0 = *(const f32x4*)(cgain + hb * 128 + ch * 8), g1 = *(const f32x4*)(cgain + hb * 128 + ch * 8 + 4); const float rs = ss[i];
                *(u32x4*)(Mb + ((wid * 32 + row) * ldm + hb * 128 + ch * 8)) = pack8((f32x4){f[0], f[1], f[2], f[3]} * rs * g0, (f32x4){f[4], f[5], f[6], f[7]} * rs * g1); }
        __syncthreads();
        return; } }
#pragma unroll
    for (int hb = 0; hb < ND / 4; ++hb) {
#pragma unroll
        for (int r = 0; r < 16; ++r) { const int row = crow(r, hi); const float inv = __builtin_amdgcn_rcpf(li_l[row]);
#pragma unroll
            for (int d = 0; d < 4; ++d) ost[row * OST + d * 32 + r32] = f2bf(o[4 * hb + d][r] * inv); }
        asm volatile("s_waitcnt lgkmcnt(0)" ::: "memory");
#pragma unroll
        for (int i = 0; i < 32 * 16 / 64; ++i) { const int cc = lane + 64 * i, row = cc / 16, ch = cc % 16;
            const u32x4 w = *(const LAS u32x4*)(ost + row * OST + ch * 8); const int ooff = (wid * 32 + row) * ldo + hb * 128 + ch * 8; *(u32x4*)(Ob + ooff) = w; }
        asm volatile("s_waitcnt lgkmcnt(0)" ::: "memory");
    }
    }
    __syncthreads();
}
}

__device__ __forceinline__ void p_prepA(Frame& F, const Args& a, int u0, int nu) {
    const bf16_t* XBC = WSP(bf16_t, WS_XBC); bf16_t* XC = WSP(bf16_t, WS_XBCC);
    const bf16_t* CQ = WSP(bf16_t, WS_CQ); const bf16_t* CKV = WSP(bf16_t, WS_CKV);
    float* RCQ = WSP(float, WS_RSTD_CQ); float* RCKV = WSP(float, WS_RSTD_CKV); const float* TAIL = WSP(float, WS_TAIL); float* DT = WSP(float, WS_DT);
    const float* cw = a.in[23]; const float* cb = a.in[24]; const float* dtb = a.in[25];
    const int cg = F.tid & 255, half = F.tid >> 8, c0 = cg * 8;
    float w[4][8], bs[8];
#pragma unroll
    for (int e = 0; e < 8; ++e) { bs[e] = cb[c0 + e];
#pragma unroll
        for (int j = 0; j < 4; ++j) w[j][e] = cw[j * 2048 + c0 + e]; }
    for (int u = u0; u < TOK / 64; u += nu) {
        const int t0 = u * 64 + half * 32;
        float x0[8], x1[8], x2[8], x3[8];
        if ((t0 & (SEQ - 1)) == 0) {
#pragma unroll
            for (int e = 0; e < 8; ++e) { x0[e] = 0.f; x1[e] = 0.f; x2[e] = 0.f; }
        } else {
            unpack8(*(const u32x4*)(XBC + (size_t)(t0 - 3) * 2048 + c0), x0); unpack8(*(const u32x4*)(XBC + (size_t)(t0 - 2) * 2048 + c0), x1); unpack8(*(const u32x4*)(XBC + (size_t)(t0 - 1) * 2048 + c0), x2);
        }
#pragma unroll 1
        for (int i8 = 0; i8 < 32; i8 += 16) {
            u32x4 rr[16];
#pragma unroll
            for (int q = 0; q < 16; ++q) rr[q] = *(const u32x4*)(XBC + (size_t)(t0 + i8 + q) * 2048 + c0);
#pragma unroll
            for (int q = 0; q < 16; ++q) { unpack8(rr[q], x3); float o[8];
#pragma unroll
                for (int e = 0; e < 8; ++e) { o[e] = silu_f(bs[e] + w[0][e] * x0[e] + w[1][e] * x1[e] + w[2][e] * x2[e] + w[3][e] * x3[e]); x0[e] = x1[e]; x1[e] = x2[e]; x2[e] = x3[e]; }
                u32x4 pk; pk.x = cvt_pk_bf16(o[0], o[1]); pk.y = cvt_pk_bf16(o[2], o[3]); pk.z = cvt_pk_bf16(o[4], o[5]); pk.w = cvt_pk_bf16(o[6], o[7]);
                *(u32x4*)(XC + (size_t)(t0 + i8 + q) * 2048 + c0) = pk; }
        }
        { u32x4 rq[8], rk[8];
#pragma unroll
          for (int k = 0; k < 8; ++k) { const size_t t = (size_t)u * 64 + F.wave * 8 + k; rq[k] = *(const u32x4*)(CQ + t * 512 + F.lane * 8); rk[k] = *(const u32x4*)(CKV + t * 512 + F.lane * 8); }
#pragma unroll
          for (int k = 0; k < 8; ++k) { const int t = u * 64 + F.wave * 8 + k; float f[8], g[8]; unpack8(rq[k], f); unpack8(rk[k], g); float sq = 0.f, sk = 0.f;
#pragma unroll
              for (int e = 0; e < 8; ++e) { sq += f[e] * f[e]; sk += g[e] * g[e]; }
              sq = wave_sum(sq, F.lane); sk = wave_sum(sk, F.lane);
              if (F.lane == 0) { RCQ[t] = 1.0f / sqrtf(sq * (1.f / 512.f) + EPS); RCKV[t] = 1.0f / sqrtf(sk * (1.f / 512.f) + EPS); } } }
    }
}
__device__ __forceinline__ void p_prep_late(Frame& F, const Args& a) {
    const float* TAIL = WSP(float, WS_TAIL); float* DT = WSP(float, WS_DT); const float* dtb = a.in[25];
    for (int i = F.gw * 64 + F.lane; i < TOK * 16; i += F.NGW * 64) { const int t = i >> 4, h = i & 15; const float v = TAIL[(size_t)t * 80 + 64 + h] + dtb[h];
        DT[i] = fmaxf(v, 0.f) + log1pf(expf(-fabsf(v))); }
    for (int r = F.gw; r < 2 * BATCH * NMEM; r += F.NGW) { const int l = r / (BATCH * NMEM); bf16_t* p = WSP(bf16_t, WS_MEMKV) + (size_t)r * 1024 + F.lane * 8; const float* kg = a.in[10] + l * 128 + (F.lane & 15) * 8; const float* qg = a.in[9] + l * 128 + (F.lane & 15) * 8;
        float f[8]; unpack8(*(const u32x4*)p, f); float s = 0.f;
#pragma unroll
        for (int e = 0; e < 8; ++e) s += f[e] * f[e];
        s = row16_sum(s);
        const float rs = 1.0f / sqrtf(s * (1.f / 128.f) + EPS);
        u32x4 pk; pk.x = cvt_pk_bf16(f[0] * rs * kg[0] * qg[0], f[1] * rs * kg[1] * qg[1]); pk.y = cvt_pk_bf16(f[2] * rs * kg[2] * qg[2], f[3] * rs * kg[3] * qg[3]); pk.z = cvt_pk_bf16(f[4] * rs * kg[4] * qg[4], f[5] * rs * kg[5] * qg[5]); pk.w = cvt_pk_bf16(f[6] * rs * kg[6] * qg[6], f[7] * rs * kg[7] * qg[7]);
        *(u32x4*)p = pk; }
}
__device__ __forceinline__ void p_prepB(Frame& F, const Args& a) {
    const bf16_t* KV = WSP(bf16_t, WS_KV); bf16_t* KM = WSP(bf16_t, WS_KM); const float* TAIL = WSP(float, WS_TAIL); const f32x2* R32 = WSP(f32x2, WS_ROPE32);
    const float* kg = a.in[22];
    const int g = F.lane >> 3, i = F.lane & 7;
    for (int t = F.gw; t < TOK; t += F.NGW) {
        f32x2 cs[8];
        const bf16_t* ksrc = KV + (size_t)t * 2048 + g * 256;
        const u32x4 rk0 = *(const u32x4*)(ksrc + 8 * i), rk1 = *(const u32x4*)(ksrc + 64 + 8 * i);
        const f32x4 r0 = *(const f32x4*)(TAIL + (size_t)t * 80 + 8 * i), r1 = *(const f32x4*)(TAIL + (size_t)t * 80 + 8 * i + 4);
#pragma unroll
        for (int e = 0; e < 8; ++e) cs[e] = R32[(size_t)t * 32 + 8 * (i & 3) + e];
        float v0[8], v1[8], v2[8];
        unpack8(rk0, v0); unpack8(rk1, v1);
        v2[0] = r0.x; v2[1] = r0.y; v2[2] = r0.z; v2[3] = r0.w; v2[4] = r1.x; v2[5] = r1.y; v2[6] = r1.z; v2[7] = r1.w;
        float s = 0.f;
#pragma unroll
        for (int e = 0; e < 8; ++e) s += v0[e] * v0[e] + v1[e] * v1[e] + v2[e] * v2[e];
        s = row8_sum(s);
        const float rs = 1.0f / sqrtf(s * (1.f / 192.f) + EPS);
        float o2[8];
#pragma unroll
        for (int e = 0; e < 8; ++e) { v0[e] *= rs * kg[8 * i + e]; v1[e] *= rs * kg[64 + 8 * i + e]; v2[e] *= rs * kg[128 + 8 * i + e]; }
#pragma unroll
        for (int e = 0; e < 8; ++e) { const float pv = shx(v2[e], 4, F.lane); o2[e] = (i < 4) ? v2[e] * cs[e].x - pv * cs[e].y : v2[e] * cs[e].x + pv * cs[e].y; }
        bf16_t* dst = KM + (size_t)t * 1536 + g * 192;
        u32x4 pk; pk.x = cvt_pk_bf16(v0[0], v0[1]); pk.y = cvt_pk_bf16(v0[2], v0[3]); pk.z = cvt_pk_bf16(v0[4], v0[5]); pk.w = cvt_pk_bf16(v0[6], v0[7]); *(u32x4*)(dst + 8 * i) = pk;
        pk.x = cvt_pk_bf16(v1[0], v1[1]); pk.y = cvt_pk_bf16(v1[2], v1[3]); pk.z = cvt_pk_bf16(v1[4], v1[5]); pk.w = cvt_pk_bf16(v1[6], v1[7]); *(u32x4*)(dst + 64 + 8 * i) = pk;
        pk.x = cvt_pk_bf16(o2[0], o2[1]); pk.y = cvt_pk_bf16(o2[2], o2[3]); pk.z = cvt_pk_bf16(o2[4], o2[5]); pk.w = cvt_pk_bf16(o2[6], o2[7]); *(u32x4*)(dst + 128 + 8 * i) = pk;
    }
}
__device__ __forceinline__ bf16x8 tr_frag(int a0, int a1) {
    s16x4 lo, hi2; asm volatile("ds_read_b64_tr_b16 %0, %2\n\tds_read_b64_tr_b16 %1, %3\n\ts_waitcnt lgkmcnt(0)" : "=&v"(lo), "=&v"(hi2) : "v"(a0), "v"(a1) : "memory");
    return (bf16x8){lo[0], lo[1], lo[2], lo[3], hi2[0], hi2[1], hi2[2], hi2[3]};
}
__device__ __forceinline__ void ssd_item(Frame& F, const Args& a, int it) {
    const bf16_t* XC = WSP(bf16_t, WS_XBCC); const float* DT = WSP(float, WS_DT); const bf16_t* Z = WSP(bf16_t, WS_Z); bf16_t* YG = WSP(bf16_t, WS_YG);
    constexpr int SBN = 272, SXD = 144;
    constexpr int O_BN = 0, O_CN = 17408, O_XD = 34816, O_HB = 44032, O_ACS = 61440, O_YO = 61952, O_XR = 78336, O_ZR = 78336 + 2 * 9216, NCH = SEQ / 64;
    int tid = F.tid; asm volatile("" : "+v"(tid));
    const int lane = tid & 63, wave = tid >> 6, r32 = lane & 31, hi = lane >> 5, gq = lane >> 4, li = lane & 15;
    const int h = it & 15, b = it >> 4, g = h >> 2;
    const float a_h = -expf(a.in[26][h]), dskip = a.in[27][h];
    LAS unsigned char* L = F.lds; const int Lb = (int)(uintptr_t)L;
    const int sl = tid >> 4, sc = tid & 15, xl = tid >> 3, xc = tid & 7;
    for (int i = tid; i < 64 * SBN / 4; i += NTHREADS) *(LAS unsigned*)(L + O_HB + i * 4) = 0u;
    f32x16 HT;
#pragma unroll
    for (int r = 0; r < 16; ++r) HT[r] = 0.f;
    u32x4 rb0, rb1, rc0, rc1, rx, rz; float rdt, rdtx;
#define SSD_LOAD(c) do { const size_t t0_ = (size_t)b * SEQ + (size_t)(c) * 64; \
        rb0 = *(const u32x4*)(XC + (t0_ + sl) * 2048 + 1024 + g * 128 + sc * 8); rb1 = *(const u32x4*)(XC + (t0_ + 32 + sl) * 2048 + 1024 + g * 128 + sc * 8); \
        rc0 = *(const u32x4*)(XC + (t0_ + sl) * 2048 + 1536 + g * 128 + sc * 8); rc1 = *(const u32x4*)(XC + (t0_ + 32 + sl) * 2048 + 1536 + g * 128 + sc * 8); \
        rx = *(const u32x4*)(XC + (t0_ + xl) * 2048 + h * 64 + xc * 8); rz = *(const u32x4*)(Z + (t0_ + xl) * 1024 + h * 64 + xc * 8); rdtx = DT[(t0_ + xl) * 16 + h]; rdt = DT[(t0_ + lane) * 16 + h]; } while (0)
    SSD_LOAD(0);
    f32x16 yd; float dAtot = 1.f; f32x16 ST;
#pragma unroll
    for (int r = 0; r < 16; ++r) { yd[r] = 0.f; ST[r] = 0.f; }
    const int trB = (li >> 2) * SBN + (16 * (gq & 1) + 4 * (li & 3)) * 2, trX = (li >> 2) * SXD + (16 * (gq & 1) + 4 * (li & 3)) * 2;
    for (int c = 0; c <= NCH; ++c) {
        if (c > 0) {
            if (wave < 4) { const int lb = wave & 1, pb = wave >> 1; const size_t t0_ = (size_t)b * SEQ + (size_t)(c - 1) * 64;
#pragma unroll
                for (int r = 0; r < 16; ++r) { const int l = 32 * lb + att::crow(r, hi), p = 32 * pb + r32; const size_t tr = t0_ + l;
                    const float yv = yd[r] + *(const LAS float*)(L + O_YO + (l * 64 + p) * 4);
                    const bf16_t xv = *(const LAS bf16_t*)(L + O_XR + ((c - 1) & 1) * 9216 + l * SXD + p * 2), zv = *(const LAS bf16_t*)(L + O_ZR + ((c - 1) & 1) * 9216 + l * SXD + p * 2);
                    YG[tr * 1024 + h * 64 + p] = f2bf((yv + dskip * bf2f(xv)) * silu_f(bf2f(zv))); } }
            const int nb = wave & 3, ph = wave >> 2;
#pragma unroll
            for (int r = 0; r < 16; ++r) HT[r] = HT[r] * dAtot + ST[r];
#pragma unroll
            for (int q = 0; q < 4; ++q) { u32x2 w; w.x = cvt_pk_bf16(HT[4 * q], HT[4 * q + 1]); w.y = cvt_pk_bf16(HT[4 * q + 2], HT[4 * q + 3]);
                *(LAS u32x2*)(L + O_HB + (32 * ph + r32) * SBN + (32 * nb + 8 * q + 4 * hi) * 2) = w; }
        }
        if (c == NCH) break;
        { *(LAS u32x4*)(L + O_BN + sl * SBN + sc * 16) = rb0; *(LAS u32x4*)(L + O_BN + (32 + sl) * SBN + sc * 16) = rb1;
          *(LAS u32x4*)(L + O_CN + sl * SBN + sc * 16) = rc0; *(LAS u32x4*)(L + O_CN + (32 + sl) * SBN + sc * 16) = rc1;
          float fx[8]; unpack8(rx, fx); u32x4 xw; xw.x = cvt_pk_bf16(fx[0] * rdtx, fx[1] * rdtx); xw.y = cvt_pk_bf16(fx[2] * rdtx, fx[3] * rdtx); xw.z = cvt_pk_bf16(fx[4] * rdtx, fx[5] * rdtx); xw.w = cvt_pk_bf16(fx[6] * rdtx, fx[7] * rdtx);
          *(LAS u32x4*)(L + O_XD + xl * SXD + xc * 16) = xw;
          *(LAS u32x4*)(L + O_XR + (c & 1) * 9216 + xl * SXD + xc * 16) = rx; *(LAS u32x4*)(L + O_ZR + (c & 1) * 9216 + xl * SXD + xc * 16) = rz;
          if (wave == 0) { float v = rdt * a_h;
              v += __int_as_float(__builtin_amdgcn_update_dpp(0, __float_as_int(v), 0x111, 0xf, 0xf, false)); v += __int_as_float(__builtin_amdgcn_update_dpp(0, __float_as_int(v), 0x112, 0xf, 0xf, false));
              v += __int_as_float(__builtin_amdgcn_update_dpp(0, __float_as_int(v), 0x114, 0xf, 0xf, false)); v += __int_as_float(__builtin_amdgcn_update_dpp(0, __float_as_int(v), 0x118, 0xf, 0xf, false));
              v += __int_as_float(__builtin_amdgcn_update_dpp(0, __float_as_int(v), 0x142, 0xa, 0xf, false)); v += __int_as_float(__builtin_amdgcn_update_dpp(0, __float_as_int(v), 0x143, 0xc, 0xf, false));
              *(LAS float*)(L + O_ACS + lane * 4) = v; } }
        __syncthreads();
        if (c + 1 < NCH) SSD_LOAD(c + 1);
        dAtot = fast_exp(*(const LAS float*)(L + O_ACS + 63 * 4));
        if (wave < 4) {
            const int lb = wave & 1, pb = wave >> 1;
#pragma unroll
            for (int r = 0; r < 16; ++r) yd[r] = 0.f;
            const float acl = *(const LAS float*)(L + O_ACS + (32 * lb + r32) * 4);
#pragma unroll
            for (int sb = 0; sb < 2; ++sb) { if (sb <= lb) {
                f32x16 X;
#pragma unroll
                for (int r = 0; r < 16; ++r) X[r] = 0.f;
#pragma unroll
                for (int ks = 0; ks < 8; ++ks) { const bf16x8 af = *(const LAS bf16x8*)(L + O_BN + (32 * sb + r32) * SBN + (16 * ks + 8 * hi) * 2), bfr = *(const LAS bf16x8*)(L + O_CN + (32 * lb + r32) * SBN + (16 * ks + 8 * hi) * 2);
                    X = __builtin_amdgcn_mfma_f32_32x32x16_bf16(af, bfr, X, 0, 0, 0); }
#pragma unroll
                for (int q = 0; q < 4; ++q) { const f32x4 as = *(const LAS f32x4*)(L + O_ACS + (32 * sb + 8 * q + 4 * hi) * 4);
#pragma unroll
                    for (int e = 0; e < 4; ++e) { const int r = 4 * q + e; float gv = X[r] * fast_exp(acl - as[e]); if (sb == lb && (8 * q + 4 * hi + e) > r32) gv = 0.f; X[r] = gv; } }
#pragma unroll
                for (int k2 = 0; k2 < 2; ++k2) { u32x4 aw; aw.x = cvt_pk_bf16(X[8 * k2], X[8 * k2 + 1]); aw.y = cvt_pk_bf16(X[8 * k2 + 2], X[8 * k2 + 3]); aw.z = cvt_pk_bf16(X[8 * k2 + 4], X[8 * k2 + 5]); aw.w = cvt_pk_bf16(X[8 * k2 + 6], X[8 * k2 + 7]);
                    const int xa = Lb + O_XD + (32 * sb + 16 * k2 + 4 * hi) * SXD + (32 * pb) * 2 + trX;
                    const bf16x8 bw = tr_frag(xa, xa + 8 * SXD);
                    yd = __builtin_amdgcn_mfma_f32_32x32x16_bf16(__builtin_bit_cast(bf16x8, aw), bw, yd, 0, 0, 0); } } }
        } else {
            const int lb = wave & 1, pb = (wave >> 1) & 1; f32x16 Y;
#pragma unroll
            for (int r = 0; r < 16; ++r) Y[r] = 0.f;
#pragma unroll
            for (int ks = 0; ks < 8; ++ks) { const bf16x8 af = *(const LAS bf16x8*)(L + O_CN + (32 * lb + r32) * SBN + (16 * ks + 8 * hi) * 2), bfr = *(const LAS bf16x8*)(L + O_HB + (32 * pb + r32) * SBN + (16 * ks + 8 * hi) * 2);
                Y = __builtin_amdgcn_mfma_f32_32x32x16_bf16(af, bfr, Y, 0, 0, 0); }
#pragma unroll
            for (int q = 0; q < 4; ++q) { const f32x4 al = *(const LAS f32x4*)(L + O_ACS + (32 * lb + 8 * q + 4 * hi) * 4);
#pragma unroll
                for (int e = 0; e < 4; ++e) *(LAS float*)(L + O_YO + ((32 * lb + 8 * q + 4 * hi + e) * 64 + 32 * pb + r32) * 4) = Y[4 * q + e] * fast_exp(al[e]); }
        }
        { const int nb = wave & 3, ph = wave >> 2; const float ac63 = *(const LAS float*)(L + O_ACS + 63 * 4);
#pragma unroll
          for (int r = 0; r < 16; ++r) ST[r] = 0.f;
#pragma unroll
          for (int ks = 0; ks < 4; ++ks) { const int l0 = 16 * ks + 8 * hi;
              const int ba = Lb + O_BN + l0 * SBN + (32 * nb) * 2 + trB; const bf16x8 af = tr_frag(ba, ba + 4 * SBN);
              const int xa = Lb + O_XD + l0 * SXD + (32 * ph) * 2 + trX; const bf16x8 xf = tr_frag(xa, xa + 4 * SXD);
              float fx[8]; unpack8(__builtin_bit_cast(u32x4, xf), fx);
              const f32x4 a0 = *(const LAS f32x4*)(L + O_ACS + l0 * 4), a1 = *(const LAS f32x4*)(L + O_ACS + (l0 + 4) * 4);
              u32x4 bw; bw.x = cvt_pk_bf16(fx[0] * fast_exp(ac63 - a0.x), fx[1] * fast_exp(ac63 - a0.y)); bw.y = cvt_pk_bf16(fx[2] * fast_exp(ac63 - a0.z), fx[3] * fast_exp(ac63 - a0.w));
              bw.z = cvt_pk_bf16(fx[4] * fast_exp(ac63 - a1.x), fx[5] * fast_exp(ac63 - a1.y)); bw.w = cvt_pk_bf16(fx[6] * fast_exp(ac63 - a1.z), fx[7] * fast_exp(ac63 - a1.w));
              ST = __builtin_amdgcn_mfma_f32_32x32x16_bf16(af, __builtin_bit_cast(bf16x8, bw), ST, 0, 0, 0); } }
        __syncthreads();
    }
    __syncthreads();
#undef SSD_LOAD
}
__device__ __forceinline__ void p_mla_ssd(Frame& F, const Args& a, unsigned* qctr, volatile LAS int* slot) {
    for (int it = F.bid; it < 64; it += F.G) ssd_item(F, a, it);
    if (F.G == TCONV_G && F.bid >= TCONV_FIRST && F.bid < TCONV_FIRST + TCONV_BLOCKS) { constexpr int RPB = (PEER_E + TCONV_BLOCKS - 1) / TCONV_BLOCKS; const int cb = F.bid - TCONV_FIRST;
        __syncthreads();
        p_layer0_late_weights(F, a, cb * 8 + F.wave, TCONV_BLOCKS * 8);
        p_layer1_weights(F, a, cb * 8 + F.wave, TCONV_BLOCKS * 8);
#pragma unroll 1
        for (int l = 0; l < 2; ++l) { const int rb = l * PEER_E + cb * RPB, re = rb + RPB < (l + 1) * PEER_E ? rb + RPB : (l + 1) * PEER_E; convert_table_rows(F, a, rb, re, F.wave, 8); }
        __syncthreads(); }
    const bf16_t* QM = WSP(bf16_t, WS_QM); const bf16_t* KM = WSP(bf16_t, WS_KM); const bf16_t* KV = WSP(bf16_t, WS_KV); bf16_t* MIX = WSP(bf16_t, WS_MIX);
    const float scale = 0.07216878364870322f;
#pragma unroll 1
    for (;;) {
        __syncthreads();
        if (F.tid == 0) *slot = (int)__hip_atomic_fetch_add(qctr, 1u, __ATOMIC_RELAXED, __HIP_MEMORY_SCOPE_AGENT);
        __syncthreads();
        const int idx = *slot;
        if (idx >= 512) break;
        const int qb = 15 - (idx >> 5), bh = idx & 31, b = bh >> 3, h = bh & 7, q0 = qb * 256; const size_t row0 = (size_t)b * SEQ + q0, kr0 = (size_t)b * SEQ;
        att::attn_unit<192, 128, true, false, 32>(F.lds, QM + row0 * 1536 + h * 192, 1536, KM + kr0 * 1536 + h * 192, 1536, KV + kr0 * 2048 + h * 256 + 128, 2048, MIX + row0 * 2048 + h * 128, 2048,
                                       4 * (qb + 1), q0, scale * 1.4426950408889634f, F.tid, a.in[21], WSP(f32x2, WS_ROPE32) + row0 * 32);
    }
}
__device__ __forceinline__ void p_ssd_norm(Frame& F, const Args& a) {
    const bf16_t* YG = WSP(bf16_t, WS_YG); bf16_t* MIX = WSP(bf16_t, WS_MIX); const float* gn = a.in[28] + F.lane * 8;
    for (int t = F.gw; t < TOK; t += F.NGW) { const bf16_t* p = YG + (size_t)t * 1024 + F.lane * 8;
        const u32x4 w0 = *(const u32x4*)p, w1 = *(const u32x4*)(p + 512); float f0[8], f1[8]; unpack8(w0, f0); unpack8(w1, f1); float s0 = 0.f, s1 = 0.f;
#pragma unroll
        for (int e = 0; e < 8; ++e) { s0 += f0[e] * f0[e]; s1 += f1[e] * f1[e]; }
        s0 = half_sum(s0); s1 = half_sum(s1);
        const float r0 = 1.0f / sqrtf(s0 * (1.f / 256.f) + EPS), r1 = 1.0f / sqrtf(s1 * (1.f / 256.f) + EPS);
        const f32x4 g00 = *(const f32x4*)gn, g01 = *(const f32x4*)(gn + 4), g10 = *(const f32x4*)(gn + 512), g11 = *(const f32x4*)(gn + 516);
        bf16_t* d = MIX + (size_t)t * 2048 + 1024 + F.lane * 8;
        *(u32x4*)d = pack8((f32x4){f0[0], f0[1], f0[2], f0[3]} * r0 * g00, (f32x4){f0[4], f0[5], f0[6], f0[7]} * r0 * g01);
        *(u32x4*)(d + 512) = pack8((f32x4){f1[0], f1[1], f1[2], f1[3]} * r1 * g10, (f32x4){f1[4], f1[5], f1[6], f1[7]} * r1 * g11); }
}
__device__ __forceinline__ void p_attn_mem(Frame& F, int layer, const pg8::StaticOrder& S) {
    const bf16_t* MQ = WSP(bf16_t, WS_MEMQ); const bf16_t* MKV = WSP(bf16_t, WS_MEMKV) + (size_t)layer * 1024 * 1024; bf16_t* MO = WSP(bf16_t, WS_MEMO);
    const float scale = 0.08838834764831845f;
    asm volatile("s_waitcnt vmcnt(0)" ::: "memory"); __builtin_amdgcn_fence(__ATOMIC_RELEASE, "workgroup"); __syncthreads(); __builtin_amdgcn_fence(__ATOMIC_ACQUIRE, "workgroup");
    pg8::Unit u;
#pragma unroll 1
    for (int i = 0; S.next(i, u); ++i) { const int h = u.pn, qb = u.pm & 15, b = u.pm >> 4; const size_t row0 = (size_t)b * SEQ + qb * 256;
        att::attn_unit<128, 128, false, true>(F.lds, MQ + row0 * 512 + h * 128, 512, MKV + (size_t)b * 256 * 1024 + h * 128, 1024, MKV + (size_t)b * 256 * 1024 + 512 + h * 128, 1024, MO + row0 * 512 + h * 128, 512,
                                              4, 0, scale * 1.4426950408889634f, (F.wave << 6) | lane_id()); }
}
__device__ __forceinline__ unsigned ordf(float x) { const unsigned u = __float_as_uint(x); return u ^ ((unsigned)((int)u >> 31) | 0x80000000u); }
__device__ __forceinline__ float unordf(unsigned k) { return __uint_as_float((k & 0x80000000u) ? (k ^ 0x80000000u) : ~k); }
#define TK_CS(a, b) do { const unsigned hi_ = (a) > (b) ? (a) : (b); const unsigned lo_ = (a) > (b) ? (b) : (a); (a) = hi_; (b) = lo_; } while (0)
__device__ __forceinline__ void tk_sort16(unsigned (&a)[16]) {
#pragma unroll
    for (int k = 2; k <= 16; k <<= 1)
#pragma unroll
        for (int j = k >> 1; j > 0; j >>= 1)
#pragma unroll
            for (int i = 0; i < 16; ++i) { const int l = i ^ j; if (l > i) { if ((i & k) == 0) TK_CS(a[i], a[l]); else TK_CS(a[l], a[i]); } }
}
__device__ __forceinline__ void tk_merge16(unsigned (&L)[16], const unsigned (&B)[16]) {
#pragma unroll
    for (int i = 0; i < 16; ++i) L[i] = L[i] > B[15 - i] ? L[i] : B[15 - i];
#pragma unroll
    for (int j = 8; j > 0; j >>= 1)
#pragma unroll
        for (int i = 0; i < 16; ++i) { const int l = i ^ j; if (l > i) TK_CS(L[i], L[l]); }
}
__device__ __forceinline__ void p_peer_topk(Frame& F, int layer) {
    const bf16_t* PQ = WSP(bf16_t, WS_PQ); const bf16_t* KEYS = WSP(bf16_t, WS_KEYS) + (size_t)layer * 8 * 2 * 128 * 128; int* EXPo = WSP(int, WS_EXP); float* GATEo = WSP(float, WS_GATE);
    LAS float* sc = (LAS float*)(F.lds + F.wave * 16384);
    const bool u4 = (PEER_U4_MASK >> layer) & 1;
#pragma unroll 1
    for (int pass = 0; pass < 2; ++pass) {
    if ((pass ^ (F.bid & 1)) == 0) {
    for (int t = F.gw; t < TOK; t += F.NGW) { const int lane = F.lane; const bf16_t* xrow = WSP(bf16_t, WS_XB) + (size_t)t * 2048; float f[32]; float mx = 0.f; int xsum = 0;
#pragma unroll
        for (int c = 0; c < 2; ++c) { float g8[8]; unpack8(*(const u32x4*)(xrow + (c * 1024 + lane * 16)), g8);
#pragma unroll
            for (int j = 0; j < 8; ++j) f[c * 16 + j] = g8[j];
            unpack8(*(const u32x4*)(xrow + (c * 1024 + lane * 16 + 8)), g8);
#pragma unroll
            for (int j = 0; j < 8; ++j) f[c * 16 + 8 + j] = g8[j]; }
#pragma unroll
        for (int j = 0; j < 32; ++j) mx = fmaxf(mx, fabsf(f[j]));
        mx = wave_max(mx);
        const float inv = mx > 0.f ? 127.f / mx : 0.f;
#pragma unroll
        for (int c = 0; c < 2; ++c) { u32x4 w; unsigned* wp = (unsigned*)&w;
#pragma unroll
            for (int q = 0; q < 4; ++q) { unsigned v = 0u;
#pragma unroll
                for (int e = 0; e < 4; ++e) v |= (((unsigned)(int)__builtin_rintf(f[c * 16 + q * 4 + e] * inv)) & 0xffu) << (8 * e);
                wp[q] = v; }
            if (!u4) *(u32x4*)(WSP(unsigned char, WS_XQ) + ((size_t)(c * 8 + (lane >> 3)) * TOK + t) * 128 + (lane & 7) * 16) = w;
            else *(u32x4*)(WSP(unsigned char, WS_XQ) + ((size_t)(c * 4 + (lane >> 4)) * TOK + t) * 256 + (lane & 15) * 16) = w;
#pragma unroll
            for (int q = 0; q < 4; q += 2) xsum = __builtin_amdgcn_sdot4((int)wp[q], 0x01010101, xsum, false); }
        if (u4) {
            xsum = wave_sum_i(xsum);
            if (lane == 0) WSP(int, WS_SX)[t] = xsum; }
        const float ssq = wave_sum(lane < 32 ? WSP(float, WS_SSQ2)[(size_t)t * 32 + lane] : 0.f, lane);
        if (lane == 0) WSP(float, WS_XS)[t] = mx * (1.f / 127.f) / sqrtf(ssq * (1.f / 2048.f) + EPS); }
    } else {
    for (int it = F.gw; it < (TOK / 32) * 8; it += F.NGW) {
        int lane = lane_id(); asm volatile("" : "+v"(lane));
        const int r32 = lane & 31, hi = lane >> 5, h = it & 7, t0 = (it >> 3) * 32;
        unsigned KF[2][16];
#pragma unroll 1
        for (int p = 0; p < 2; ++p) {
            const bf16_t* qp = PQ + (size_t)(t0) * 2048 + h * 256 + p * 128; const int qo = r32 * 2048 + hi * 8; bf16x8 qf[8], af[8], an[8];
#pragma unroll
            for (int k = 0; k < 8; ++k) qf[k] = *(const bf16x8*)(qp + (qo + k * 16));
            const bf16_t* kp = KEYS + (size_t)(h * 2 + p) * 128 * 128; const int ko = r32 * 128 + hi * 8;
#pragma unroll
            for (int k = 0; k < 8; ++k) af[k] = *(const bf16x8*)(kp + (ko + k * 16));
            unsigned L[16];
#pragma unroll
            for (int i = 0; i < 16; ++i) L[i] = 0u;
#pragma unroll 1
            for (int nb = 0; nb < 4; ++nb) { f32x16 acc;
#pragma unroll
                for (int r = 0; r < 16; ++r) acc[r] = 0.f;
#pragma unroll
                for (int k = 0; k < 8; ++k) acc = __builtin_amdgcn_mfma_f32_32x32x16_bf16(af[k], qf[k], acc, 0, 0, 0);
                if (nb < 3) {
#pragma unroll
                    for (int k = 0; k < 8; ++k) an[k] = *(const bf16x8*)(kp + ((nb + 1) * 32 * 128 + ko + k * 16)); }
                const int nbase = 127 - (nb * 32 + 4 * hi); unsigned Bk[16];
#pragma unroll
                for (int r = 0; r < 16; ++r) Bk[r] = (ordf(acc[r]) & 0xFFFFFF80u) | (unsigned)(nbase - ((r & 3) + 8 * (r >> 2)));
                tk_sort16(Bk); tk_merge16(L, Bk);
#pragma unroll
                for (int k = 0; k < 8; ++k) af[k] = an[k];
            }
            unsigned P[16];
#pragma unroll
            for (int i = 0; i < 16; ++i) { auto sw_ = __builtin_amdgcn_permlane32_swap(L[i], L[i], false, false); P[i] = hi ? sw_[0] : sw_[1]; }
            tk_merge16(L, P);
            if (p == 0) {
#pragma unroll
                for (int i = 0; i < 16; ++i) KF[0][i] = L[i];
            } else {
#pragma unroll
                for (int i = 0; i < 16; ++i) KF[1][i] = L[i]; }
        }
        float s0[16], s1[16];
#pragma unroll
        for (int i = 0; i < 16; ++i) { s0[i] = unordf(KF[0][i] & 0xFFFFFF80u); s1[i] = unordf(KF[1][i] & 0xFFFFFF80u);
            sc[i * 64 + lane] = __int_as_float(127 - (int)(KF[0][i] & 127u)); sc[(16 + i) * 64 + lane] = __int_as_float(127 - (int)(KF[1][i] & 127u)); }
        unsigned Cn[16], Cb[16];
#define TK_CAND(i, j) ((ordf(s0[i] + s1[j]) & 0xFFFFFF00u) | (unsigned)(255 - ((i) * 16 + (j))))
        { int c = 0;
#pragma unroll
          for (int i = 0; i < 16; ++i)
#pragma unroll
              for (int j = 0; j < 16; ++j) if ((i + 1) * (j + 1) <= 16) { if (c < 16) Cn[c] = TK_CAND(i, j); ++c; } }
        tk_sort16(Cn);
#pragma unroll
        for (int grp = 1; grp < 4; ++grp) { int c = 0;
#pragma unroll
            for (int q = 0; q < 16; ++q) Cb[q] = 0u;
#pragma unroll
            for (int i = 0; i < 16; ++i)
#pragma unroll
                for (int j = 0; j < 16; ++j) if ((i + 1) * (j + 1) <= 16) { if (c >= grp * 16 && c < grp * 16 + 16) Cb[c - grp * 16] = TK_CAND(i, j); ++c; }
            tk_sort16(Cb); tk_merge16(Cn, Cb); }
#undef TK_CAND
        float bs[16]; int ex[16]; float mx = unordf(Cn[0] & 0xFFFFFF00u), sum = 0.f;
#pragma unroll
        for (int k = 0; k < 16; ++k) { const int c = 255 - (int)(Cn[k] & 255u); const int n0 = __float_as_int(sc[(c >> 4) * 64 + lane]), n1 = __float_as_int(sc[(16 + (c & 15)) * 64 + lane]);
            ex[k] = n0 * 128 + n1; bs[k] = fast_exp(unordf(Cn[k] & 0xFFFFFF00u) - mx); sum += bs[k]; }
        const float inv = 1.0f / sum;
        if (hi == 0) { int* ep = EXPo + (size_t)(t0 + r32) * 128 + h * 16; float* gp = GATEo + (size_t)(t0 + r32) * 128 + h * 16;
#pragma unroll
            for (int k = 0; k < 16; k += 4) { *(int4*)(ep + k) = make_int4(ex[k], ex[k + 1], ex[k + 2], ex[k + 3]); *(f32x4*)(gp + k) = (f32x4){bs[k] * inv, bs[k + 1] * inv, bs[k + 2] * inv, bs[k + 3] * inv}; } }
    }
    } }
}
#define UB0(x) ((float)((x) & 0xffu))
#define UB1(x) ((float)(((x) >> 8) & 0xffu))
#define UB2(x) ((float)(((x) >> 16) & 0xffu))
#define UB3(x) ((float)((x) >> 24))
template <bool U4> __device__ __forceinline__ void p_peer_u(Frame& F, int layer, unsigned* qbase) {
    const unsigned char* U8 = WSP(unsigned char, WS_U8) + (size_t)layer * PEER_E * 2048; const unsigned char* XQ = WSP(unsigned char, WS_XQ); const int* EXPi = WSP(int, WS_EXP); short* PD = WSP(short, WS_PD);
    const int xcc = (int)xb_xcc_id();
#pragma unroll 1
    for (int ri = 0; ri < (U4 ? 8 : 16); ++ri) {
        const int sl = U4 ? ((xcc + ri) & 7) : ((xcc + 8 * (ri & 1) + (ri >> 1)) & 15);
        const unsigned char* Us = U8 + (size_t)sl * PEER_E * 128; const unsigned char* Xs = XQ + (size_t)sl * TOK * (U4 ? 256 : 128); short* PDs = PD + (size_t)sl * TOK * 128;
#pragma unroll 1
        for (;;) {
            int lane = lane_id(); asm volatile("" : "+v"(lane));
            int chunk = 0; if (lane == 0) chunk = (int)__hip_atomic_fetch_add(qbase + sl * 64, 1u, __ATOMIC_RELAXED, __HIP_MEMORY_SCOPE_AGENT);
            chunk = __builtin_amdgcn_readfirstlane(chunk);
            if (chunk >= TOK / 32) break;
            const int r = lane >> 3, c = lane & 7; const bool c4 = c & 4, c2 = c & 2, c1 = c & 1;
            u32x4 en[4]; u32x4 xn, xn2 = {0u, 0u, 0u, 0u};
#define U_EXP(dst, tok) do { const int* ep_ = EXPi + (tok) * 128 + 8 * r; dst[0] = *(const u32x4*)ep_; dst[1] = *(const u32x4*)(ep_ + 4); dst[2] = *(const u32x4*)(ep_ + 64); dst[3] = *(const u32x4*)(ep_ + 68); } while (0)
            { const size_t t_ = (size_t)chunk * 32; U_EXP(en, t_); if constexpr (U4) { xn = *(const u32x4*)(Xs + (t_ * 256 + c * 32)); xn2 = *(const u32x4*)(Xs + (t_ * 256 + c * 32 + 16)); } else xn = *(const u32x4*)(Xs + (t_ * 128 + c * 16)); }
#pragma unroll 1
            for (int ti = 0; ti < 32; ++ti) {
                const size_t t = (size_t)chunk * 32 + ti; const u32x4 e0 = en[0], e1 = en[1], e2 = en[2], e3 = en[3]; const u32x4 xv = xn, xv2 = xn2; (void)xv2;
                if (ti + 1 < 32) { U_EXP(en, t + 1); if constexpr (U4) { xn = *(const u32x4*)(Xs + ((t + 1) * 256 + c * 32)); xn2 = *(const u32x4*)(Xs + ((t + 1) * 256 + c * 32 + 16)); } else xn = *(const u32x4*)(Xs + ((t + 1) * 128 + c * 16)); }
                u32x4 R[16];
#pragma unroll
                for (int g = 0; g < 16; ++g) { const u32x4 ev = g < 4 ? e0 : (g < 8 ? e1 : (g < 12 ? e2 : e3)); const int ek = (int)ev[g & 3]; R[g] = *(const u32x4*)(Us + (ek * 128 + c * 16)); }
                int part[16];
#pragma unroll
                for (int g = 0; g < 16; ++g) {
                    if constexpr (U4) { int d = 0, dh = 0;
#define U4_DW(w, xa, xb) d = __builtin_amdgcn_sdot4((int)((w) & 0x0F0F0F0Fu), (int)(xa), d, false); dh = __builtin_amdgcn_sdot4((int)((w) & 0xF0F0F0F0u), (int)(xb), dh, false)
                        U4_DW(R[g].x, xv.x, xv.y); U4_DW(R[g].y, xv.z, xv.w); U4_DW(R[g].z, xv2.x, xv2.y); U4_DW(R[g].w, xv2.z, xv2.w);
#undef U4_DW
                        part[g] = d + (dh >> 4); }
                    else { int d = __builtin_amdgcn_sdot4((int)R[g].x, (int)xv.x, 0, false); d = __builtin_amdgcn_sdot4((int)R[g].y, (int)xv.y, d, false);
                        d = __builtin_amdgcn_sdot4((int)R[g].z, (int)xv.z, d, false); part[g] = __builtin_amdgcn_sdot4((int)R[g].w, (int)xv.w, d, false); } }
#pragma unroll
                for (int hh = 0; hh < 2; ++hh) { int q4[4], q2[2];
#pragma unroll
                    for (int i = 0; i < 4; ++i) q4[i] = (c4 ? part[8 * hh + 4 + i] : part[8 * hh + i]) + __builtin_amdgcn_update_dpp(0, c4 ? part[8 * hh + i] : part[8 * hh + 4 + i], 0x141, 0xf, 0xf, false);
#pragma unroll
                    for (int i = 0; i < 2; ++i) q2[i] = (c2 ? q4[2 + i] : q4[i]) + __builtin_amdgcn_update_dpp(0, c2 ? q4[i] : q4[2 + i], 0x4E, 0xf, 0xf, false);
                    const int q1 = (c1 ? q2[1] : q2[0]) + __builtin_amdgcn_update_dpp(0, c1 ? q2[0] : q2[1], 0xB1, 0xf, 0xf, false);
                    const int qs = (q1 + 2) >> 2; PDs[t * 128 + 64 * hh + lane] = (short)(qs > 32767 ? 32767 : (qs < -32767 ? -32767 : qs)); }
            }
        }
    }
}
#undef U_EXP
__device__ __forceinline__ void p_peer_fin(Frame& F, int layer) {
    const float* USC = WSP(float, WS_TSC) + (size_t)layer * PEER_E; const float* VSC = WSP(float, WS_TSC) + (size_t)(2 + layer) * PEER_E;
    const short* PD = WSP(short, WS_PD); const float* XS = WSP(float, WS_XS); const int* EXPi = WSP(int, WS_EXP); const float* GATEi = WSP(float, WS_GATE);
    const bool u4 = (PEER_U4_MASK >> layer) & 1;
    for (int t = F.gw; t < TOK; t += F.NGW) { const int lane = F.lane; int s0 = 0, s1 = 0;
        if (!u4) {
#pragma unroll
            for (int s = 0; s < 16; ++s) { s0 += PD[((size_t)s * TOK + t) * 128 + lane]; s1 += PD[((size_t)s * TOK + t) * 128 + 64 + lane]; } }
        else { const int off = 2 * WSP(int, WS_SX)[t];
#pragma unroll
            for (int s = 0; s < 8; ++s) { s0 += PD[((size_t)s * TOK + t) * 128 + lane]; s1 += PD[((size_t)s * TOK + t) * 128 + 64 + lane]; }
            s0 -= off; s1 -= off; }
        const int e0 = EXPi[(size_t)t * 128 + lane], e1 = EXPi[(size_t)t * 128 + 64 + lane]; const float xs = XS[t];
        const float w0 = gelu_f((float)s0 * 4.f * USC[e0] * xs) * GATEi[(size_t)t * 128 + lane] * VSC[e0], w1 = gelu_f((float)s1 * 4.f * USC[e1] * xs) * GATEi[(size_t)t * 128 + 64 + lane] * VSC[e1];
        float mx = fmaxf(fabsf(w0), fabsf(w1));
        mx = wave_max(mx);
        const float inv = mx > 0.f ? 127.f / mx : 0.f;
        const int q0 = (int)__builtin_rintf(w0 * inv), q1 = (int)__builtin_rintf(w1 * inv);
        if ((PEER_V4_MASK >> layer) & 1) { int sw = q0 + q1;
            sw = wave_sum_i(sw);
            if (lane == 0) WSP(int, WS_SW)[t] = sw; }
        int* pw = WSP(int, WS_PW) + (size_t)t * 128; pw[lane] = (e0 << 8) | (q0 & 0xff); pw[64 + lane] = (e1 << 8) | (q1 & 0xff);
        if (lane == 0) WSP(float, WS_PWS)[t] = mx * (1.f / 127.f); }
}
#define V_PW(dst, tok) do { const int* pp_ = PWq + (tok) * 128 + 16 * r; dst[0] = *(const u32x4*)pp_; dst[1] = *(const u32x4*)(pp_ + 4); dst[2] = *(const u32x4*)(pp_ + 8); dst[3] = *(const u32x4*)(pp_ + 12); } while (0)
__device__ __forceinline__ void p_peer_v(Frame& F, const Args& a, int layer, bool next_stats, unsigned* qbase, float fac) {
    const unsigned char* V8 = WSP(unsigned char, WS_V8) + (size_t)layer * PEER_E * 2048; const int* PWq = WSP(int, WS_PW); const float* PWS = WSP(float, WS_PWS); float* out = a.out;
    const int xcc = (int)xb_xcc_id();
#pragma unroll 1
    for (int ri = 0; ri < 16; ++ri) {
        const int sl = (xcc + 8 * (ri & 1) + (ri >> 1)) & 15;
        const unsigned char* Vs = V8 + (size_t)sl * PEER_E * 128;
#pragma unroll 1
        for (;;) {
            int lane = lane_id(); asm volatile("" : "+v"(lane));
            int chunk = 0; if (lane == 0) chunk = (int)__hip_atomic_fetch_add(qbase + sl * 64, 1u, __ATOMIC_RELAXED, __HIP_MEMORY_SCOPE_AGENT);
            chunk = __builtin_amdgcn_readfirstlane(chunk);
            if (chunk >= TOK / 32) break;
            const int r = lane >> 3, c = lane & 7; const bool b5 = lane & 32, b4 = lane & 16, b3 = lane & 8;
            u32x4 wn[4]; float wsn;
            { const size_t t_ = (size_t)chunk * 32; V_PW(wn, t_); wsn = PWS[t_]; }
#pragma unroll 1
            for (int ti = 0; ti < 32; ++ti) {
                const size_t t = (size_t)chunk * 32 + ti; const u32x4 w0 = wn[0], w1 = wn[1], w2 = wn[2], w3 = wn[3]; const float ws = wsn;
                if (ti + 1 < 32) { V_PW(wn, t + 1); wsn = PWS[t + 1]; }
                unsigned* xp = (unsigned*)(WSP(bf16_t, WS_XB) + t * 2048 + (sl * 128 + c * 16 + r * 2)); const unsigned xw = *xp; const f32x2 o0 = {bf_lo(xw), bf_hi(xw)};
                u32x4 R[16]; int wk[16];
#pragma unroll
                for (int g = 0; g < 16; ++g) { const u32x4 wv = g < 4 ? w0 : (g < 8 ? w1 : (g < 12 ? w2 : w3)); wk[g] = (int)wv[g & 3];
                    R[g] = *(const u32x4*)(Vs + ((wk[g] >> 8) * 128 + c * 16)); }
                int acc[16];
#pragma unroll
                for (int i = 0; i < 16; ++i) acc[i] = 0;
#pragma unroll
                for (int j = 0; j < 4; ++j) {
                    const unsigned W = ((unsigned)wk[4 * j] & 0xffu) | (((unsigned)wk[4 * j + 1] & 0xffu) << 8) | (((unsigned)wk[4 * j + 2] & 0xffu) << 16) | ((unsigned)wk[4 * j + 3] << 24);
#pragma unroll
                    for (int d = 0; d < 4; ++d) { const unsigned ra = ((const unsigned*)&R[4 * j])[d], rb = ((const unsigned*)&R[4 * j + 1])[d], rc = ((const unsigned*)&R[4 * j + 2])[d], rd = ((const unsigned*)&R[4 * j + 3])[d];
                        const unsigned ablo = __builtin_amdgcn_perm(rb, ra, 0x05010400u), abhi = __builtin_amdgcn_perm(rb, ra, 0x07030602u), cdlo = __builtin_amdgcn_perm(rd, rc, 0x05010400u), cdhi = __builtin_amdgcn_perm(rd, rc, 0x07030602u);
                        const unsigned t0 = __builtin_amdgcn_perm(cdlo, ablo, 0x05040100u), t1 = __builtin_amdgcn_perm(cdlo, ablo, 0x07060302u), t2 = __builtin_amdgcn_perm(cdhi, abhi, 0x05040100u), t3 = __builtin_amdgcn_perm(cdhi, abhi, 0x07060302u);
                        acc[4 * d] = __builtin_amdgcn_sdot4((int)t0, (int)W, acc[4 * d], false); acc[4 * d + 1] = __builtin_amdgcn_sdot4((int)t1, (int)W, acc[4 * d + 1], false);
                        acc[4 * d + 2] = __builtin_amdgcn_sdot4((int)t2, (int)W, acc[4 * d + 2], false); acc[4 * d + 3] = __builtin_amdgcn_sdot4((int)t3, (int)W, acc[4 * d + 3], false); }
                }
                int a8[8], a4[4], a2[2];
#pragma unroll
                for (int i = 0; i < 8; ++i) a8[i] = rs_bit5(acc[i], acc[8 + i]);
#pragma unroll
                for (int i = 0; i < 4; ++i) a4[i] = rs_bit4(a8[i], a8[4 + i]);
#pragma unroll
                for (int i = 0; i < 2; ++i) a2[i] = rs_bit3(a4[i], a4[2 + i], b3);
                const int s0 = a2[0], s1 = a2[1];
                const float sc = ws * fac; const f32x2 nv = {o0.x + (float)s0 * sc, o0.y + (float)s1 * sc};
                if (!next_stats) { if (fac != 0.f) *(f32x2*)(out + t * 2048 + (sl * 128 + c * 16 + r * 2)) = nv; }
                else { *xp = cvt_pk_bf16(nv.x, nv.y);
                    const float ssq = wave_sum(nv.x * nv.x + nv.y * nv.y, lane); if (lane < 2) WSP(float, WS_SSQ1)[t * 32 + 2 * sl + lane] = lane == 0 ? ssq : 0.f; }
            }
        }
    }
}
__device__ __forceinline__ void p_peer_v4(Frame& F, const Args& a, int layer, bool next_stats, unsigned* qbase, float fac) {
    const unsigned char* V8 = WSP(unsigned char, WS_V8) + (size_t)layer * PEER_E * 2048; const int* PWq = WSP(int, WS_PW); const float* PWS = WSP(float, WS_PWS); const int* SW = WSP(int, WS_SW); float* out = a.out;
    const int xcc = (int)xb_xcc_id();
#pragma unroll 1
    for (int ri = 0; ri < 8; ++ri) {
        const int sl = (xcc + ri) & 7;
        const unsigned char* Vs = V8 + (size_t)sl * PEER_E * 128;
#pragma unroll 1
        for (;;) {
            int lane = lane_id(); asm volatile("" : "+v"(lane));
            int chunk = 0; if (lane == 0) chunk = (int)__hip_atomic_fetch_add(qbase + sl * 64, 1u, __ATOMIC_RELAXED, __HIP_MEMORY_SCOPE_AGENT);
            chunk = __builtin_amdgcn_readfirstlane(chunk);
            if (chunk >= TOK / 32) break;
            const int r = lane >> 3, c = lane & 7; const bool b5 = lane & 32, b4 = lane & 16, b3 = lane & 8;
            u32x4 wn[4]; float wsn; int swn;
            { const size_t t_ = (size_t)chunk * 32; V_PW(wn, t_); wsn = PWS[t_]; swn = SW[t_]; }
#pragma unroll 1
            for (int ti = 0; ti < 32; ++ti) {
                const size_t t = (size_t)chunk * 32 + ti; const u32x4 w0 = wn[0], w1 = wn[1], w2 = wn[2], w3 = wn[3]; const float ws = wsn; const int sw8 = 8 * swn;
                if (ti + 1 < 32) { V_PW(wn, t + 1); wsn = PWS[t + 1]; swn = SW[t + 1]; }
                unsigned* xp = (unsigned*)(WSP(bf16_t, WS_XB) + t * 2048 + (sl * 256 + c * 32 + 8 * (r >> 1) + 2 * (r & 1))); u32x2 xw; xw.x = xp[0]; xw.y = xp[2];
                u32x4 R[16]; int wk[16];
#pragma unroll
                for (int g = 0; g < 16; ++g) { const u32x4 wv = g < 4 ? w0 : (g < 8 ? w1 : (g < 12 ? w2 : w3)); wk[g] = (int)wv[g & 3];
                    R[g] = *(const u32x4*)(Vs + ((wk[g] >> 8) * 128 + c * 16)); }
                int acc[32];
#pragma unroll
                for (int i = 0; i < 32; ++i) acc[i] = 0;
#pragma unroll
                for (int j = 0; j < 4; ++j) {
                    const unsigned W = ((unsigned)wk[4 * j] & 0xffu) | (((unsigned)wk[4 * j + 1] & 0xffu) << 8) | (((unsigned)wk[4 * j + 2] & 0xffu) << 16) | ((unsigned)wk[4 * j + 3] << 24);
#pragma unroll
                    for (int d = 0; d < 4; ++d) { const unsigned ra = ((const unsigned*)&R[4 * j])[d], rb = ((const unsigned*)&R[4 * j + 1])[d], rc = ((const unsigned*)&R[4 * j + 2])[d], rd = ((const unsigned*)&R[4 * j + 3])[d];
                        const unsigned ablo = __builtin_amdgcn_perm(rb, ra, 0x05010400u), abhi = __builtin_amdgcn_perm(rb, ra, 0x07030602u), cdlo = __builtin_amdgcn_perm(rd, rc, 0x05010400u), cdhi = __builtin_amdgcn_perm(rd, rc, 0x07030602u);
                        const unsigned t0 = __builtin_amdgcn_perm(cdlo, ablo, 0x05040100u), t1 = __builtin_amdgcn_perm(cdlo, ablo, 0x07060302u), t2 = __builtin_amdgcn_perm(cdhi, abhi, 0x05040100u), t3 = __builtin_amdgcn_perm(cdhi, abhi, 0x07060302u);
                        const int b = 8 * d;
#define V4_COL(tt, i) acc[b + 2 * (i)] = __builtin_amdgcn_sdot4((int)(tt), (int)W, acc[b + 2 * (i)], false); acc[b + 2 * (i) + 1] = __builtin_amdgcn_sdot4((int)((tt) & 0xF0F0F0F0u), (int)W, acc[b + 2 * (i) + 1], false)
                        V4_COL(t0, 0); V4_COL(t1, 1); V4_COL(t2, 2); V4_COL(t3, 3);
#undef V4_COL
                    }
                }
                int a16[16], a8[8], a4[4];
#pragma unroll
                for (int i = 0; i < 16; ++i) a16[i] = rs_bit5(acc[i], acc[16 + i]);
#pragma unroll
                for (int i = 0; i < 8; ++i) a8[i] = rs_bit4(a16[i], a16[8 + i]);
#pragma unroll
                for (int i = 0; i < 4; ++i) a4[i] = rs_bit3(a8[i], a8[4 + i], b3);

                const float sc = ws * fac; f32x4 nv;
                const int lo0 = a4[0] - a4[1] - sw8, hi0 = a4[1] >> 4, lo1 = a4[2] - a4[3] - sw8, hi1 = a4[3] >> 4;
                nv.x = bf_lo(xw.x) + (float)lo0 * sc; nv.y = bf_hi(xw.x) + (float)lo1 * sc; nv.z = bf_lo(xw.y) + (float)hi0 * sc; nv.w = bf_hi(xw.y) + (float)hi1 * sc;
                if (!next_stats) { if (fac != 0.f) { float* op = out + t * 2048 + (sl * 256 + c * 32 + 8 * (r >> 1) + 2 * (r & 1)); *(f32x2*)op = (f32x2){nv.x, nv.y}; *(f32x2*)(op + 4) = (f32x2){nv.z, nv.w}; } }
                else { xp[0] = cvt_pk_bf16(nv.x, nv.y); xp[2] = cvt_pk_bf16(nv.z, nv.w);
                    const float ssq = wave_sum((nv.x * nv.x + nv.y * nv.y) + (nv.z * nv.z + nv.w * nv.w), lane); if (lane < 4) WSP(float, WS_SSQ1)[t * 32 + 4 * sl + lane] = lane == 0 ? ssq : 0.f; }
            }
        }
    }
}
__device__ __forceinline__ void p_diff_prep(Frame& F, const Args& a) {
    const f32x2* R64 = WSP(f32x2, WS_ROPE64); const int lane = F.lane, d0 = (lane & 15) * 8; const float* gn = a.in[32] + d0;
    for (int t = F.gw; t < TOK; t += F.NGW) {
        u32x4 raw[4]; f32x2 cs[8]; bf16_t* base = WSP(bf16_t, WS_KD) + (size_t)t * 2048;
#pragma unroll
        for (int i = 0; i < 4; ++i) raw[i] = *(const u32x4*)(base + (lane + 64 * i) * 8);
#pragma unroll
        for (int e = 0; e < 8; ++e) cs[e] = R64[(size_t)t * 64 + (lane & 7) * 8 + e];
#pragma unroll
        for (int i = 0; i < 4; ++i) { bf16_t* p = base + (lane + 64 * i) * 8; float f[8]; unpack8(raw[i], f); float s = 0.f;
#pragma unroll
            for (int e = 0; e < 8; ++e) s += f[e] * f[e];
            s = row16_sum(s);
            const float rs = 1.0f / sqrtf(s * (1.f / 128.f) + EPS); float o[8];
#pragma unroll
            for (int e = 0; e < 8; ++e) f[e] *= rs * gn[e];
#pragma unroll
            for (int e = 0; e < 8; ++e) { const float pv = dppf<0x128>(f[e]); o[e] = (lane & 8) ? f[e] * cs[e].x + pv * cs[e].y : f[e] * cs[e].x - pv * cs[e].y; }
            u32x4 pk; pk.x = cvt_pk_bf16(o[0], o[1]); pk.y = cvt_pk_bf16(o[2], o[3]); pk.z = cvt_pk_bf16(o[4], o[5]); pk.w = cvt_pk_bf16(o[6], o[7]); *(u32x4*)p = pk; }
    }
}
__device__ __forceinline__ void p_attn_diff(Frame& F, const Args& a) {
    const bf16_t* QD = WSP(bf16_t, WS_QD); const bf16_t* KD = WSP(bf16_t, WS_KD); const bf16_t* VD = WSP(bf16_t, WS_VD); bf16_t* OD = WSP(bf16_t, WS_OD); bf16_t* MIX = WSP(bf16_t, WS_MIX);
    const float scale = 0.08838834764831845f;
    const float lam_init = 0.8f - 0.6f * 0.7408182206817179f;
    for (int it = F.bid; it < 256; it += F.G) {
        const int x = it & 7, y = it >> 3, pairidx = y & 7, bh = x * 4 + (y >> 3), h = bh & 7, b = bh >> 3;
#pragma unroll 1
        for (int s = 0; s < 4; ++s) { const int qb = (s >> 1) ? pairidx : 15 - pairidx, m = s & 1, q0 = qb * 256; const size_t row0 = (size_t)b * SEQ + q0, kr0 = (size_t)b * SEQ;
            float lam = 0.f;
            if (m) { const int ln = lane_id(); const float d1 = wave_sum(a.in[33][ln] * a.in[34][ln] + a.in[33][64 + ln] * a.in[34][64 + ln], ln), d2 = wave_sum(a.in[35][ln] * a.in[36][ln] + a.in[35][64 + ln] * a.in[36][64 + ln], ln);
                     lam = expf(d1) - expf(d2) + lam_init; }
            att::attn_unit<128, 256, true, false, 64, true>(F.lds, QD + row0 * 2048 + h * 256 + m * 128, 2048, KD + kr0 * 2048 + h * 256 + m * 128, 2048, VD + kr0 * 2048 + h * 256, 2048,
                                           OD + row0 * 4096 + h * 512 + m * 256, 4096, 4 * (qb + 1), q0, scale * 1.4426950408889634f, (F.wave << 6) | lane_id(), a.in[31], WSP(f32x2, WS_ROPE64) + row0 * 64,
                                           OD + row0 * 4096 + h * 512, MIX + row0 * 2048 + h * 256, 2048, lam, a.in[37], 1.0f - lam_init); }
    }
}

constexpr int PH_LAST = 35;
__global__ void __launch_bounds__(NTHREADS, 2) mega_fwd(Args args) {
    extern __shared__ __attribute__((aligned(16))) unsigned char lds_raw[];
    Frame F;
    F.lds = (LAS unsigned char*)lds_raw; F.tid = threadIdx.x; F.lane = F.tid & 63; F.wave = __builtin_amdgcn_readfirstlane(F.tid >> 6);
    F.G = gridDim.x; F.bid = blockIdx.x; F.gw = F.bid * NWAVES + F.wave; F.NGW = F.G * NWAVES; F.ws = (GAS unsigned char*)args.ws;
    volatile LAS unsigned* MISC = (volatile LAS unsigned*)(F.lds + MISC_OFF);
    if (F.tid < 64) MISC[F.tid] = 0u;
    __syncthreads();
    const int lo = args.ph_lo, hi = args.ph_hi;
    XcdBarrier bar; bar.bar = (unsigned*)(F.ws + WS_CTL) + CW_BAR; bar.x = 0; bar.st = nullptr;
    if (hi - lo > 1) bar = xcd_barrier_post((unsigned*)(F.ws + WS_CTL) + CW_BAR, MISC + 8);
#ifdef ONLY
#define IN(k) ((k) == ONLY && lo <= (k) && (k) < hi)
#else
#define IN(k) (lo <= (k) && (k) < hi)
#endif
#define SEAM(k) do { if (IN((k) + 1)) { XcdBarrier bb_ = bar; unsigned* b_ = bar.bar; asm volatile("" : "+s"(b_)); bb_.bar = (unsigned*)(GAS unsigned*)b_; xcd_barrier(bb_, ((F.wave << 6) | lane_id()) == 0); } } while (0)
#define REFRESH() do { int t_ = (F.wave << 6) | lane_id(); asm volatile("" : "+v"(t_)); F.tid = t_; F.lane = t_ & 63; unsigned char* w_ = args.ws; asm volatile("" : "+s"(w_)); F.ws = (GAS unsigned char*)w_; } while (0)
#define GEMM_STORE(Ap, Bp, Mv, Nv, Kv, Op, ldcv, rs, scv, ssv, invn, slotsv) do { pg8::Gemm g_{Ap, Bp, Mv, Nv, Kv}; pg8::StaticOrder S_; S_.init(Mv, Nv, F.G, F.bid); pg8::EpiStore E_{Op, ldcv, rs, scv, ssv, invn, slotsv}; \
        pg8::gemm_phase<pg8::EpiStore, pg8::StaticOrder, true, true>(F.lds, g_, S_, E_, F.tid); } while (0)
#define GEMM_RESID(Ap, Bp, Kv, ssqp) do { pg8::Gemm g_{Ap, Bp, TOK, DM, Kv}; pg8::StaticOrder S_; S_.init(TOK, DM, F.G, F.bid); pg8::EpiResid E_{WSP(bf16_t, WS_XB), dry ? nullptr : (ssqp), fac}; \
        pg8::gemm_phase<pg8::EpiResid, pg8::StaticOrder, true, true>(F.lds, g_, S_, E_, F.tid); } while (0)
#ifndef REPEAT_MASK
#define REPEAT_MASK 0ull
#endif
#define PHASE(k, ...) if (IN(k)) { REFRESH(); { const float fac = 1.f; const bool dry = false; (void)fac; (void)dry; __VA_ARGS__ } \
        if ((REPEAT_MASK >> ((k) > 24 ? (k) - 16 : (k))) & 1ull) { const float fac = 0.f; const bool dry = true; (void)fac; (void)dry; __VA_ARGS__ } SEAM(k); }
    PHASE(0, p_prologue(F, args);)
    PHASE(1,
        { pg8::Gemm g{WSP(bf16_t, WS_XB), WSP(bf16_t, WS_WIN), TOK, 4096, 2048}; pg8::StaticOrder S; S.init(TOK, 4096, F.G, F.bid);
          pg8::EpiWin E{WSP(bf16_t, WS_CQ), WSP(bf16_t, WS_CKV), WSP(bf16_t, WS_Z), WSP(bf16_t, WS_XBC), WSP(float, WS_TAIL), WSP(float, WS_RSTD)};
          pg8::gemm_phase<pg8::EpiWin, pg8::StaticOrder, true, true>(F.lds, g, S, E, F.tid); })
    PHASE(2,
        { pg8::Gemm g{WSP(bf16_t, WS_XB), WSP(bf16_t, WS_WIN) + (size_t)4096 * 2048, TOK, 256, 2048}; pg8::StaticOrder S; S.init(TOK, 256, F.G, F.bid);
          pg8::EpiTail E{{WSP(bf16_t, WS_CQ), WSP(bf16_t, WS_CKV), WSP(bf16_t, WS_Z), WSP(bf16_t, WS_XBC), WSP(float, WS_TAIL), WSP(float, WS_RSTD)}};
          pg8::gemm_phase<pg8::EpiTail, pg8::StaticOrder, true, true>(F.lds, g, S, E, F.tid); }
        _Pragma("unroll 1")
        for (int l = 0; l < 2; ++l) { pg8::Gemm g{WSP(bf16_t, WS_MEMB), WSP(bf16_t, WS_WMEMKV) + (size_t)l * 1024 * 2048, 1024, 1024, 2048}; pg8::StaticOrder S; S.init(1024, 1024, F.G, (F.bid + 2 * F.G - 64 - 16 * l) % F.G);
          pg8::EpiStore E{WSP(bf16_t, WS_MEMKV) + (size_t)l * 1024 * 1024, 1024, WSP(float, WS_RSTD_MEM), 0, 0, 1.f / 2048.f, false};
          pg8::gemm_phase<pg8::EpiStore, pg8::StaticOrder, true, true>(F.lds, g, S, E, F.tid); }
        if (!dry) { const int first = F.G > 96 ? 96 : 0; if (F.bid >= first) p_prepA(F, args, F.bid - first, F.G - first); })
    PHASE(3,
        GEMM_STORE(WSP(bf16_t, WS_CQ), WSP(bf16_t, WS_WUQ), TOK, 1536, 512, WSP(bf16_t, WS_QM), 1536, WSP(float, WS_RSTD_CQ), 0, 0, 0.f, false);
        GEMM_STORE(WSP(bf16_t, WS_CKV), WSP(bf16_t, WS_WUKV), TOK, 2048, 512, WSP(bf16_t, WS_KV), 2048, WSP(float, WS_RSTD_CKV), 0, 0, 0.f, false);)
    PHASE(4, if (!dry) { p_prepB(F, args); p_prep_late(F, args); })
    PHASE(5, if (!dry) p_mla_ssd(F, args, (unsigned*)(F.ws + WS_CTL) + 64, (volatile LAS int*)(F.lds + MISC_OFF + 128));)
    PHASE(7, p_ssd_norm(F, args);)
    PHASE(8, GEMM_RESID(WSP(bf16_t, WS_MIX), WSP(bf16_t, WS_WOUT), 2048, WSP(float, WS_SSQ1));)
#pragma unroll 1
    for (int layer = 0; layer < 2; ++layer) {
        const int pb = layer ? 25 : 9;
        if (layer == 1) {
            PHASE(20, GEMM_STORE(WSP(bf16_t, WS_XB), WSP(bf16_t, WS_WQKV), TOK, 6144, 2048, WSP(bf16_t, WS_QD), 2048, WSP(float, WS_SSQ1), 2048, (size_t)TOK * 2048, 1.f / 2048.f, true);)
            PHASE(21, if (!dry) p_diff_prep(F, args);)
            PHASE(22, p_attn_diff(F, args);)
            PHASE(24, GEMM_RESID(WSP(bf16_t, WS_MIX), WSP(bf16_t, WS_WO), 2048, WSP(float, WS_SSQ1));)
        }
        PHASE(pb + 1,
                      { pg8::Gemm g_{WSP(bf16_t, WS_XB), WSP(bf16_t, WS_WMEMQ) + (size_t)layer * 512 * 2048, TOK, 512, 2048}; pg8::StaticOrder S_; S_.init(TOK, 2 * 512, F.G, F.bid);
                        pg8::EpiStore E_{WSP(bf16_t, WS_MEMQ), 512, WSP(float, WS_SSQ1), 0, 0, 1.f / 2048.f, true, true};
                        pg8::gemm_phase<pg8::EpiStore, pg8::StaticOrder, true, true, true>(F.lds, g_, S_, E_, F.tid);
                        p_attn_mem(F, layer, S_); })
        PHASE(pb + 4, GEMM_RESID(WSP(bf16_t, WS_MEMO), WSP(bf16_t, WS_WMEMO) + (size_t)layer * 2048 * 512, 512, WSP(float, WS_SSQ2));)
        PHASE(pb + 6, GEMM_STORE(WSP(bf16_t, WS_XB), WSP(bf16_t, WS_WPEERQ) + (size_t)layer * 2048 * 2048, TOK, 2048, 2048, WSP(bf16_t, WS_PQ), 2048, WSP(float, WS_SSQ2), 0, 0, 1.f / 2048.f, true);)
        PHASE(pb + 7, p_peer_topk(F, layer);)
        PHASE(pb + 8, if ((PEER_U4_MASK >> layer) & 1) p_peer_u<true>(F, layer, (unsigned*)(F.ws + WS_CTL) + 8192 + layer * 2048 + (dry ? 8192 : 0));
                      else p_peer_u<false>(F, layer, (unsigned*)(F.ws + WS_CTL) + 8192 + layer * 2048 + (dry ? 8192 : 0));)
        PHASE(pb + 9, p_peer_fin(F, layer);)
        PHASE(pb + 10, if ((PEER_V4_MASK >> layer) & 1) p_peer_v4(F, args, layer, layer == 0, (unsigned*)(F.ws + WS_CTL) + 8192 + layer * 2048 + 1024 + (dry ? 8192 : 0), fac);
                       else p_peer_v(F, args, layer, layer == 0, (unsigned*)(F.ws + WS_CTL) + 8192 + layer * 2048 + 1024 + (dry ? 8192 : 0), fac);)
    }
}

extern "C" void kernel_launch(void* const* d_in, const int* in_sizes, int n_in, void* d_out, int out_size, void* d_ws, size_t ws_size, hipStream_t stream) {
    static int grid = 0;
    if (grid == 0) {
        if (n_in != 39 || out_size != TOK * DM || ws_size < WS_END) { fprintf(stderr, "kernel_launch: unexpected shapes (n_in %d out %d ws %zu need %zu)\n", n_in, out_size, ws_size, (size_t)WS_END); grid = -1; return; }
        int dev = 0, cus = 0, per_cu = 0;
        if (hipGetDevice(&dev) != hipSuccess || hipDeviceGetAttribute(&cus, hipDeviceAttributeMultiprocessorCount, dev) != hipSuccess) { grid = -1; return; }
        if (hipFuncSetAttribute((const void*)mega_fwd, hipFuncAttributeMaxDynamicSharedMemorySize, LDS_BYTES) != hipSuccess) { fprintf(stderr, "kernel_launch: hipFuncSetAttribute failed\n"); grid = -1; return; }
        if (hipOccupancyMaxActiveBlocksPerMultiprocessor(&per_cu, (const void*)mega_fwd, NTHREADS, LDS_BYTES) != hipSuccess || per_cu < 1) { fprintf(stderr, "kernel_launch: occupancy query says %d\n", per_cu); grid = -1; return; }
        (void)hipGetLastError();
        grid = cus;
    }
    if (grid < 0) return;
    (void)hipMemsetAsync((char*)d_ws + WS_CTL, 0, CTL_ZERO_BYTES, stream);
    Args a{};
    for (int i = 0; i < 39; ++i) a.in[i] = (const float*)d_in[i];
    a.pos = (const int*)d_in[2]; a.out = (float*)d_out; a.ws = (unsigned char*)d_ws;
#if MK_ONE_LAUNCH
    a.ph_lo = 0; a.ph_hi = PH_LAST + 1;
    hipLaunchKernelGGL(mega_fwd, dim3(grid), dim3(NTHREADS), LDS_BYTES, stream, a);
#else
    for (int ph = 0; ph <= PH_LAST; ++ph) { a.ph_lo = ph; a.ph_hi = ph + 1; hipLaunchKernelGGL(mega_fwd, dim3(grid), dim3(NTHREADS), LDS_BYTES, stream, a); }
#endif
}
```

```cpp
#include <hip/hip_runtime.h>
#include <cstdio>
#include <cstdint>

#ifndef MK_ONE_LAUNCH
#define MK_ONE_LAUNCH 1
#endif

#define LAS __attribute__((address_space(3)))
#define GAS __attribute__((address_space(1)))
typedef unsigned short bf16_t;
typedef short bf16x8 __attribute__((ext_vector_type(8)));
typedef short s16x4 __attribute__((ext_vector_type(4)));
typedef float f32x4 __attribute__((ext_vector_type(4)));
typedef float f32x2 __attribute__((ext_vector_type(2)));
typedef float f32x16 __attribute__((ext_vector_type(16)));
typedef unsigned u32x4 __attribute__((ext_vector_type(4)));
typedef unsigned u32x2 __attribute__((ext_vector_type(2)));
typedef __bf16 bf16x2_t __attribute__((ext_vector_type(2)));

constexpr int BATCH = 4, SEQ = 4096, DM = 2048, TOK = BATCH * SEQ;
constexpr int NMEM = 256;
constexpr float EPS = 1e-6f;
constexpr int MLA_H = 8, MLA_QK = 192, MLA_NOPE = 128, MLA_ROPE = 64, MLA_V = 128, MLA_RANK = 512;
constexpr int SSD_H = 16, SSD_P = 64, SSD_INNER = 1024, SSD_G = 4, SSD_N = 128, SSD_CONVD = 2048;
constexpr int EVEN_IN = 4176, WIN_N = 4352;
constexpr int DIFF_H = 8, DIFF_HD = 128, DIFF_V = 256;
constexpr int MEM_H = 4, MEM_HD = 128, MEM_W = 512;
constexpr int PEER_H = 8, PEER_KEYS = 128, PEER_E = 16384, PEER_K = 16, PEER_HK = 128;

constexpr size_t MiB = 1u << 20;
constexpr size_t WS_CTL = 0, CTL_ZERO_BYTES = 1 * MiB;
constexpr size_t WS_WIN = 1 * MiB;
constexpr size_t WS_WUQ = 18 * MiB;
constexpr size_t WS_WUKV = 20 * MiB;
constexpr size_t WS_WOUT = 22 * MiB;
constexpr size_t WS_WMEMQ = 30 * MiB;
constexpr size_t WS_WMEMKV = 34 * MiB;
constexpr size_t WS_WMEMO = 42 * MiB;
constexpr size_t WS_WPEERQ = 46 * MiB;
constexpr size_t WS_WQKV = 62 * MiB;
constexpr size_t WS_WO = 86 * MiB;
constexpr size_t WS_KEYS = 94 * MiB;
constexpr size_t WS_U8 = 96 * MiB;
constexpr size_t WS_V8 = 160 * MiB;
constexpr size_t WS_TSC = 224 * MiB;
constexpr size_t WS_ROPE32 = 352 * MiB;
constexpr size_t WS_ROPE64 = 356 * MiB;
constexpr size_t WS_XB = 364 * MiB;
constexpr size_t WS_RSTD = 428 * MiB;
constexpr size_t WS_RSTD_CQ = WS_RSTD + 65536;
constexpr size_t WS_RSTD_CKV = WS_RSTD + 2 * 65536;
constexpr size_t WS_RSTD_MEM = WS_RSTD + 3 * 65536;
constexpr size_t WS_SSQ1 = 925 * MiB, WS_SSQ2 = 927 * MiB;
constexpr size_t WS_MEMB = 429 * MiB;
constexpr size_t WS_MEMKV = 433 * MiB;
constexpr size_t WS_MIX = 437 * MiB;
constexpr size_t WS_LR = 501 * MiB;
constexpr size_t WS_CQ = WS_LR;
constexpr size_t WS_CKV = WS_LR + 16 * MiB;
constexpr size_t WS_Z = WS_LR + 32 * MiB;
constexpr size_t WS_XBC = WS_LR + 64 * MiB;
constexpr size_t WS_XBCC = WS_LR + 128 * MiB;
constexpr size_t WS_TAIL = WS_LR + 192 * MiB;
constexpr size_t WS_DT = WS_LR + 198 * MiB;
constexpr size_t WS_QM = WS_LR + 200 * MiB;
constexpr size_t WS_KV = WS_LR + 248 * MiB;
constexpr size_t WS_KM = WS_LR + 312 * MiB;
constexpr size_t WS_YG = WS_LR + 360 * MiB;
constexpr size_t WS_QD = WS_LR;
constexpr size_t WS_KD = WS_LR + 64 * MiB;
constexpr size_t WS_VD = WS_LR + 128 * MiB;
constexpr size_t WS_OD = WS_LR + 192 * MiB;
constexpr size_t WS_MEMQ = WS_LR;
constexpr size_t WS_MEMO = WS_LR + 16 * MiB;
constexpr size_t WS_PQ = WS_LR + 32 * MiB;
constexpr size_t WS_EXP = WS_LR + 96 * MiB;
constexpr size_t WS_GATE = WS_LR + 104 * MiB;
constexpr size_t WS_PW = WS_LR + 112 * MiB;
constexpr size_t WS_PWS = WS_LR + 158 * MiB;
constexpr size_t WS_XQ = WS_LR + 120 * MiB;
constexpr size_t WS_SW = WS_LR + 152 * MiB + 131072;
constexpr size_t WS_SX = WS_LR + 152 * MiB + 65536;
constexpr size_t WS_XS = WS_LR + 152 * MiB;
constexpr size_t WS_PD = WS_LR + 160 * MiB;
constexpr size_t WS_END = WS_LR + 428 * MiB;
constexpr int CW_BAR = 4096;

constexpr int RING_BYTES = 131072;
constexpr int MISC_OFF = RING_BYTES;
constexpr int LDS_BYTES = 147456;
constexpr int NWAVES = 8, NTHREADS = 512;

__device__ __forceinline__ unsigned cvt_pk_bf16(float lo, float hi) { unsigned r; asm volatile("v_cvt_pk_bf16_f32 %0, %1, %2" : "=v"(r) : "v"(lo), "v"(hi)); return r; }
__device__ __forceinline__ float bf_lo(unsigned w) { return __uint_as_float(w << 16); }
__device__ __forceinline__ float bf_hi(unsigned w) { return __uint_as_float(w & 0xffff0000u); }
__device__ __forceinline__ float bf2f(bf16_t h) { return __uint_as_float(((unsigned)h) << 16); }
__device__ __forceinline__ bf16_t f2bf(float f) { return (bf16_t)(cvt_pk_bf16(f, 0.f) & 0xffffu); }
__device__ __forceinline__ int lane_id() { int l; asm volatile("v_mbcnt_lo_u32_b32 %0, -1, 0\n\tv_mbcnt_hi_u32_b32 %0, -1, %0" : "=v"(l)); return l; }
__device__ __forceinline__ float shx(float v, int m, int lane) { return __int_as_float(__builtin_amdgcn_ds_bpermute((lane ^ m) << 2, __float_as_int(v))); }
__device__ __forceinline__ unsigned shxu(unsigned v, int m, int lane) { return (unsigned)__builtin_amdgcn_ds_bpermute((lane ^ m) << 2, (int)v); }
__device__ __forceinline__ float shf(float v, int src) { return __int_as_float(__builtin_amdgcn_ds_bpermute(src << 2, __float_as_int(v))); }
__device__ __forceinline__ int rs_bit5(int lo, int hi) { auto r = __builtin_amdgcn_permlane32_swap((unsigned)lo, (unsigned)hi, false, false); return (int)r[0] + (int)r[1]; }
__device__ __forceinline__ int rs_bit4(int lo, int hi) { auto r = __builtin_amdgcn_permlane16_swap((unsigned)lo, (unsigned)hi, false, false); return (int)r[0] + (int)r[1]; }
__device__ __forceinline__ int rs_bit3(int lo, int hi, bool b3) { const int keep = b3 ? hi : lo, send = b3 ? lo : hi; return keep + __builtin_amdgcn_update_dpp(0, send, 0x128, 0xf, 0xf, false); }
template <int CTRL> __device__ __forceinline__ float dppf(float v) { return __int_as_float(__builtin_amdgcn_update_dpp(0, __float_as_int(v), CTRL, 0xf, 0xf, false)); }
template <int CTRL> __device__ __forceinline__ int dppi(int v) { return __builtin_amdgcn_update_dpp(0, v, CTRL, 0xf, 0xf, false); }
__device__ __forceinline__ float row8_sum(float v) { v += dppf<0xB1>(v); v += dppf<0x4E>(v); v += dppf<0x141>(v); return v; }
__device__ __forceinline__ float row16_sum(float v) { v = row8_sum(v); v += dppf<0x140>(v); return v; }
__device__ __forceinline__ float half_sum(float v) { v = row16_sum(v); auto s = __builtin_amdgcn_permlane16_swap(__float_as_uint(v), __float_as_uint(v), false, false); return __uint_as_float(s[0]) + __uint_as_float(s[1]); }
__device__ __forceinline__ float wave_sum(float v, int) { v = half_sum(v); auto t = __builtin_amdgcn_permlane32_swap(__float_as_uint(v), __float_as_uint(v), false, false); return __uint_as_float(t[0]) + __uint_as_float(t[1]); }
__device__ __forceinline__ float wave_max(float v) { v = fmaxf(v, dppf<0xB1>(v)); v = fmaxf(v, dppf<0x4E>(v)); v = fmaxf(v, dppf<0x141>(v)); v = fmaxf(v, dppf<0x140>(v));
    auto s = __builtin_amdgcn_permlane16_swap(__float_as_uint(v), __float_as_uint(v), false, false); v = fmaxf(__uint_as_float(s[0]), __uint_as_float(s[1]));
    auto t = __builtin_amdgcn_permlane32_swap(__float_as_uint(v), __float_as_uint(v), false, false); return fmaxf(__uint_as_float(t[0]), __uint_as_float(t[1])); }
__device__ __forceinline__ int wave_sum_i(int v) { v += dppi<0xB1>(v); v += dppi<0x4E>(v); v += dppi<0x141>(v); v += dppi<0x140>(v);
    auto s = __builtin_amdgcn_permlane16_swap((unsigned)v, (unsigned)v, false, false); v = (int)s[0] + (int)s[1];
    auto t = __builtin_amdgcn_permlane32_swap((unsigned)v, (unsigned)v, false, false); return (int)t[0] + (int)t[1]; }
__device__ __forceinline__ u32x4 pack8(f32x4 a, f32x4 b) { u32x4 w; w.x = cvt_pk_bf16(a.x, a.y); w.y = cvt_pk_bf16(a.z, a.w); w.z = cvt_pk_bf16(b.x, b.y); w.w = cvt_pk_bf16(b.z, b.w); return w; }
__device__ __forceinline__ void unpack8(u32x4 w, float (&f)[8]) { f[0] = bf_lo(w.x); f[1] = bf_hi(w.x); f[2] = bf_lo(w.y); f[3] = bf_hi(w.y); f[4] = bf_lo(w.z); f[5] = bf_hi(w.z); f[6] = bf_lo(w.w); f[7] = bf_hi(w.w); }
__device__ __forceinline__ float fast_exp(float x) { return __builtin_amdgcn_exp2f(x * 1.4426950408889634f); }
__device__ __forceinline__ float silu_f(float v) { return v * __builtin_amdgcn_rcpf(1.f + fast_exp(-v)); }
__device__ __forceinline__ float gelu_f(float v) {
    const float av = fabsf(v), t = __builtin_amdgcn_rcpf(av * 0.2316418882f + 1.0f);
    float q = t * 0.5307027145f + (-0.7265760135f); q = q * t + 0.7107068705f; q = q * t + (-0.142248368f); q = q * t + 0.127414796f; q = q * t;
    const float e = __builtin_amdgcn_exp2f((v * v) * (-0.72134752044f));
    const float m = v * (q * e);
    return v < 0.f ? m : v - m;
}

__device__ __forceinline__ float ld_ssq(const float* p) { return __hip_atomic_fetch_add(const_cast<float*>(p), 0.0f, __ATOMIC_RELAXED, __HIP_MEMORY_SCOPE_AGENT); }
namespace pg8 {
constexpr int BM = 256, BK = 64, HALF = 128, HTB = HALF * BK * 2, STAGE_BYTES = 8 * HTB, NXCD = 8, WGM = 8;
__host__ __device__ __forceinline__ int lds_byte(int r, int c) { const int st = (r >> 4) * 2 + (c >> 5), rr = r & 15, cc = c & 31, ob = rr * 64 + cc * 2; return st * 1024 + (ob ^ (((ob >> 9) & 1) << 5)); }
__host__ __device__ __forceinline__ void stage_rc(int b, int& R, int& C) { const int st = b / 1024, sb = b % 1024, swz = sb ^ (((sb >> 9) & 1) << 5); R = (st >> 1) * 16 + swz / 64; C = (st & 1) * 32 + (swz % 64) / 2; }
__host__ __device__ __forceinline__ int perm32(int rho) { const int n = rho >> 4, i = rho & 15; return 8 * (i >> 2) + 4 * n + (i & 3); }
struct Unit { int pm, pn; };
struct Gemm { const bf16_t* A; const bf16_t* Bt; int M, N, K; };
struct StaticOrder {
    int nM, nN, nwg, G, c;
    __host__ __device__ void init(int M, int N, int G_, int c_) { nM = M / BM; nN = N / BM; nwg = nM * nN; G = G_; c = c_; }
    __host__ __device__ __forceinline__ bool next(int i, Unit& u) const {
        const long L = (long)i * G + c; if (L >= nwg) return false;
        int wgid = (int)L; { const int q = nwg / NXCD, r = nwg % NXCD, xcd = wgid % NXCD, off = wgid / NXCD; wgid = (xcd < r ? xcd * (q + 1) : r * (q + 1) + (xcd - r) * q) + off; }
        const int nig = WGM * nN, gid = wgid / nig, fm = gid * WGM, gsz = (nM - fm) < WGM ? (nM - fm) : WGM;
        u.pm = fm + ((wgid % nig) % gsz); u.pn = (wgid % nig) / gsz; return true;
    }
    __device__ __forceinline__ void a_ready(const Unit&) const {}
    __device__ __forceinline__ void done(const Unit&) const {}
};
template <class Epi, class Sched, bool ALIGN_EPI = false, bool SP2 = false, bool HALFN = false>
__device__ __forceinline__ void gemm_phase(LAS unsigned char* lds, const Gemm g, const Sched& S, const Epi& E, int tid_in) {
    static_assert(!HALFN || SP2, "HALFN is written for the SP2 schedule");
    int tid = tid_in; asm volatile("" : "+v"(tid));
    const int wid = __builtin_amdgcn_readfirstlane(tid >> 6), lane = tid & 63, wr = wid >> 2, wc = wid & 3, fr = lane & 15, fq = lane >> 4;
    const int K = g.K, nt = K / BK;
    unsigned voffA[2], voffB[2];
#pragma unroll
    for (int i = 0; i < 2; ++i) { int R, C; stage_rc(tid * 16 + i * 8192, R, C); const int Rb = Epi::PERM ? ((R & ~31) + perm32(R & 31)) : R;
        voffA[i] = (unsigned)(R * K + C) * 2u; voffB[i] = (unsigned)(Rb * K + C) * 2u; }
    const size_t kstep = (size_t)(BK * 2);
    const size_t hstep = (size_t)HALF * K * 2;
    const size_t tstep = 2 * hstep;
    const unsigned ldsw = (unsigned)wid * 1024u;
    const int aoff = lds_byte(wr * 64 + fr, fq * 8), boff = lds_byte(wc * 32 + fr, fq * 8);
#define PG8_SA(b, h) (((b) * 2 + (h)) * HTB)
#define PG8_SB(b, h) ((4 + (b) * 2 + (h)) * HTB)
#define PG8_STAGE(bufoff, gbase, voff) do { _Pragma("unroll") for (int _i = 0; _i < 2; ++_i) \
        __builtin_amdgcn_global_load_lds((const unsigned*)((const char*)(gbase) + (voff)[_i]), (LAS unsigned*)(lds + (bufoff) + ldsw + _i * 8192), 16, 0, 0); } while (0)
#define PG8_LDA(dst, b, h) do { _Pragma("unroll") for (int m = 0; m < 4; ++m) _Pragma("unroll") for (int k = 0; k < 2; ++k) dst[m][k] = *(const LAS bf16x8*)(lds + PG8_SA(b, h) + aoff + m * 2048 + k * 1024); } while (0)
#define PG8_LDB(dst, b, h) do { _Pragma("unroll") for (int n = 0; n < 2; ++n) _Pragma("unroll") for (int k = 0; k < 2; ++k) dst[n][k] = *(const LAS bf16x8*)(lds + PG8_SB(b, h) + boff + n * 2048 + k * 1024); } while (0)
#define PG8_MMA(ai, bj, At, Bt) do { __builtin_amdgcn_s_setprio(1); _Pragma("unroll") for (int m = 0; m < 4; ++m) _Pragma("unroll") for (int n = 0; n < 2; ++n) _Pragma("unroll") for (int k = 0; k < 2; ++k) \
        acc[ai][bj][m][n] = __builtin_amdgcn_mfma_f32_16x16x32_bf16(Bt[n][k], At[m][k], acc[ai][bj][m][n], 0, 0, 0); __builtin_amdgcn_s_setprio(0); } while (0)
#define PG8_WAIT_V(n) asm volatile("s_waitcnt vmcnt(" #n ")" ::: "memory")
#define PG8_WAIT_L(n) asm volatile("s_waitcnt lgkmcnt(" #n ")" ::: "memory")
#define PG8_BAR __builtin_amdgcn_s_barrier()
#define PG8_SCHED __builtin_amdgcn_sched_barrier(0)
    Unit cur, nxt; int ui = 0;
    if (!S.next(0, cur)) return;
    f32x4 acc[2][2][4][2];
#pragma unroll
    for (int a = 0; a < 2; ++a)
#pragma unroll
        for (int b = 0; b < 2; ++b)
#pragma unroll
            for (int m = 0; m < 4; ++m)
#pragma unroll
                for (int n = 0; n < 2; ++n) acc[a][b][m][n] = (f32x4){0.f, 0.f, 0.f, 0.f};
    bf16x8 At[4][2], B0[2][2], B1[2][2];
    const size_t bstep = HALFN ? hstep : tstep;
    const char* cA = (const char*)g.A + (size_t)cur.pm * tstep; const char* cB = (const char*)g.Bt + (size_t)cur.pn * bstep;
    S.a_ready(cur);
    if constexpr (HALFN) {
        PG8_STAGE(PG8_SB(0, 0), cB, voffB); PG8_STAGE(PG8_SA(0, 0), cA, voffA); PG8_STAGE(PG8_SA(0, 1), cA + hstep, voffA);
        if (wr == 1) PG8_BAR;
        PG8_WAIT_V(2); PG8_BAR;
        PG8_STAGE(PG8_SB(1, 0), cB + kstep, voffB); PG8_STAGE(PG8_SA(1, 0), cA + kstep, voffA);
        PG8_WAIT_V(4); PG8_BAR;
    } else if constexpr (SP2) {
        PG8_STAGE(PG8_SB(0, 0), cB, voffB); PG8_STAGE(PG8_SB(0, 1), cB + hstep, voffB); PG8_STAGE(PG8_SA(0, 0), cA, voffA); PG8_STAGE(PG8_SA(0, 1), cA + hstep, voffA);
        if (wr == 1) PG8_BAR;
        PG8_WAIT_V(2); PG8_BAR;
        PG8_STAGE(PG8_SB(1, 0), cB + kstep, voffB); PG8_STAGE(PG8_SA(1, 0), cA + kstep, voffA); PG8_STAGE(PG8_SB(1, 1), cB + hstep + kstep, voffB);
        PG8_WAIT_V(6); PG8_BAR;
    } else {
        PG8_STAGE(PG8_SB(0, 0), cB, voffB); PG8_STAGE(PG8_SA(0, 0), cA, voffA); PG8_STAGE(PG8_SB(0, 1), cB + hstep, voffB); PG8_STAGE(PG8_SA(0, 1), cA + hstep, voffA);
        if (wr == 1) PG8_BAR;
        PG8_WAIT_V(4); PG8_BAR;
        PG8_STAGE(PG8_SB(1, 0), cB + kstep, voffB); PG8_STAGE(PG8_SA(1, 0), cA + kstep, voffA); PG8_STAGE(PG8_SB(1, 1), cB + hstep + kstep, voffB);
        PG8_WAIT_V(6); PG8_BAR;
    }
    for (;;) {
        const bool has_next = S.next(ui + 1, nxt);
        const char* nA = has_next ? (const char*)g.A + (size_t)nxt.pm * tstep : cA; const char* nB = has_next ? (const char*)g.Bt + (size_t)nxt.pn * bstep : cB;
        for (int t = 0; t < nt; t += 2) {
            const bool last = (t == nt - 2);
            const char* a1 = cA + (size_t)(t + 1) * kstep;
            const char* a2 = last ? nA : cA + (size_t)(t + 2) * kstep; const char* b2 = last ? nB : cB + (size_t)(t + 2) * kstep;
            const char* a3 = a2 + kstep; const char* b3 = b2 + kstep;
            if (last && has_next) S.a_ready(nxt);
            if constexpr (HALFN) {
            PG8_LDB(B0, 0, 0); PG8_SCHED; PG8_LDA(At, 0, 0); PG8_STAGE(PG8_SA(1, 1), a1 + hstep, voffA);
            PG8_WAIT_V(6); PG8_WAIT_L(0); PG8_BAR; PG8_MMA(0, 0, At, B0); PG8_BAR; PG8_SCHED;
            PG8_LDA(At, 0, 1); PG8_STAGE(PG8_SB(0, 0), b2, voffB); PG8_STAGE(PG8_SA(0, 0), a2, voffA);
            PG8_WAIT_V(6); PG8_WAIT_L(0); PG8_BAR; PG8_MMA(1, 0, At, B0); PG8_BAR; PG8_SCHED;
            PG8_LDB(B0, 1, 0); PG8_SCHED; PG8_LDA(At, 1, 0); PG8_STAGE(PG8_SA(0, 1), a2 + hstep, voffA);
            PG8_WAIT_V(6); PG8_WAIT_L(0); PG8_BAR; PG8_MMA(0, 0, At, B0); PG8_BAR; PG8_SCHED;
            PG8_LDA(At, 1, 1); PG8_STAGE(PG8_SB(1, 0), b3, voffB); PG8_STAGE(PG8_SA(1, 0), a3, voffA);
            PG8_WAIT_V(6); PG8_WAIT_L(0); PG8_BAR; PG8_MMA(1, 0, At, B0); PG8_BAR; PG8_SCHED;
            } else if constexpr (SP2) {
            PG8_LDB(B0, 0, 0); PG8_LDB(B1, 0, 1); PG8_SCHED; PG8_LDA(At, 0, 0); PG8_STAGE(PG8_SA(1, 1), a1 + hstep, voffA);
            PG8_WAIT_V(8); PG8_WAIT_L(0); PG8_BAR; PG8_MMA(0, 0, At, B0); PG8_MMA(0, 1, At, B1); PG8_BAR; PG8_SCHED;
            PG8_LDA(At, 0, 1); PG8_STAGE(PG8_SB(0, 0), b2, voffB); PG8_STAGE(PG8_SB(0, 1), b2 + hstep, voffB); PG8_STAGE(PG8_SA(0, 0), a2, voffA);
            PG8_WAIT_V(8); PG8_WAIT_L(0); PG8_BAR; PG8_MMA(1, 0, At, B0); PG8_MMA(1, 1, At, B1); PG8_BAR; PG8_SCHED;
            PG8_LDB(B0, 1, 0); PG8_LDB(B1, 1, 1); PG8_SCHED; PG8_LDA(At, 1, 0); PG8_STAGE(PG8_SA(0, 1), a2 + hstep, voffA);
            PG8_WAIT_V(8); PG8_WAIT_L(0); PG8_BAR; PG8_MMA(0, 0, At, B0); PG8_MMA(0, 1, At, B1); PG8_BAR; PG8_SCHED;
            PG8_LDA(At, 1, 1); PG8_STAGE(PG8_SB(1, 0), b3, voffB); PG8_STAGE(PG8_SB(1, 1), b3 + hstep, voffB); PG8_STAGE(PG8_SA(1, 0), a3, voffA);
            PG8_WAIT_V(8); PG8_WAIT_L(0); PG8_BAR; PG8_MMA(1, 0, At, B0); PG8_MMA(1, 1, At, B1); PG8_BAR; PG8_SCHED;
            } else {
            PG8_LDB(B0, 0, 0); PG8_SCHED; PG8_LDA(At, 0, 0); PG8_STAGE(PG8_SA(1, 1), a1 + hstep, voffA);
            PG8_WAIT_L(8); PG8_BAR; PG8_WAIT_L(0); PG8_MMA(0, 0, At, B0); PG8_BAR; PG8_SCHED;
            PG8_LDB(B1, 0, 1); PG8_STAGE(PG8_SB(0, 0), b2, voffB);
            PG8_BAR; PG8_WAIT_L(0); PG8_MMA(0, 1, At, B1); PG8_BAR;
            PG8_LDA(At, 0, 1); PG8_STAGE(PG8_SA(0, 0), a2, voffA);
            PG8_BAR; PG8_WAIT_L(0); PG8_MMA(1, 0, At, B0); PG8_BAR; PG8_SCHED;
            PG8_STAGE(PG8_SB(0, 1), b2 + hstep, voffB);
            PG8_WAIT_V(6); PG8_BAR; PG8_MMA(1, 1, At, B1); PG8_BAR;
            PG8_LDB(B0, 1, 0); PG8_SCHED; PG8_LDA(At, 1, 0); PG8_STAGE(PG8_SA(0, 1), a2 + hstep, voffA);
            PG8_WAIT_L(8); PG8_BAR; PG8_WAIT_L(0); PG8_MMA(0, 0, At, B0); PG8_BAR; PG8_SCHED;
            PG8_LDB(B1, 1, 1); PG8_STAGE(PG8_SB(1, 0), b3, voffB);
            PG8_BAR; PG8_WAIT_L(0); PG8_MMA(0, 1, At, B1); PG8_BAR;
            PG8_LDA(At, 1, 1); PG8_STAGE(PG8_SA(1, 0), a3, voffA);
            PG8_BAR; PG8_WAIT_L(0); PG8_MMA(1, 0, At, B0); PG8_BAR; PG8_SCHED;
            PG8_STAGE(PG8_SB(1, 1), b3 + hstep, voffB);
            PG8_WAIT_V(6); PG8_BAR; PG8_MMA(1, 1, At, B1); PG8_BAR;
            }
        }
        if constexpr (ALIGN_EPI) { if (wr == 0) PG8_BAR; }
        if constexpr (!Epi::AFTER_DRAIN) { E(acc, cur, wr, wc, fr, fq); S.done(cur); }
        if (!has_next) break;
#pragma unroll
        for (int a = 0; a < 2; ++a)
#pragma unroll
            for (int b = 0; b < 2; ++b)
#pragma unroll
                for (int m = 0; m < 4; ++m)
#pragma unroll
                    for (int n = 0; n < 2; ++n) acc[a][b][m][n] = (f32x4){0.f, 0.f, 0.f, 0.f};
        cur = nxt; cA = nA; cB = nB; ++ui;
        if constexpr (ALIGN_EPI) { if (wr == 1) PG8_BAR; }
    }
    PG8_WAIT_V(0);
    if constexpr (!ALIGN_EPI) { if (wr == 0) PG8_BAR; }
    PG8_BAR;
#undef PG8_SA
#undef PG8_SB
#undef PG8_STAGE
#undef PG8_LDA
#undef PG8_LDB
#undef PG8_MMA
#undef PG8_WAIT_V
#undef PG8_WAIT_L
#undef PG8_BAR
#undef PG8_SCHED
}

__device__ __forceinline__ float xrow16_sum(float x) {
    auto s = __builtin_amdgcn_permlane16_swap(__float_as_uint(x), __float_as_uint(x), false, false); x = __uint_as_float(s[0]) + __uint_as_float(s[1]);
    auto t = __builtin_amdgcn_permlane32_swap(__float_as_uint(x), __float_as_uint(x), false, false); return __uint_as_float(t[0]) + __uint_as_float(t[1]);
}
struct EpiStore {
    static constexpr bool PERM = true, AFTER_DRAIN = false;
    bf16_t* O; int ldc; const float* rscale; int split_cols; size_t split_stride; float inv_n; bool slots; bool halfn = false;
    __device__ __forceinline__ void operator()(const f32x4 (&acc)[2][2][4][2], const Unit& u, int wr, int wc, int fr, int fq) const {
        const int row0 = u.pm * BM + wr * 64 + fr; int colt = u.pn * (halfn ? HALF : BM); bf16_t* base = O;
        if (split_cols) { const int t = colt / split_cols; base += (size_t)t * split_stride; colt -= t * split_cols; }
        const int col0 = colt + wc * 32 + 8 * fq;
#pragma unroll
        for (int ai = 0; ai < 2; ++ai)
#pragma unroll
            for (int m = 0; m < 4; ++m) { const int row = row0 + ai * HALF + m * 16; float sc = 1.f; if (slots) { const f32x4 s0 = *(const f32x4*)(rscale + (size_t)row * 32 + fq * 8), s1 = *(const f32x4*)(rscale + (size_t)row * 32 + fq * 8 + 4); sc = 1.0f / sqrtf(xrow16_sum((s0.x + s0.y) + (s0.z + s0.w) + (s1.x + s1.y) + (s1.z + s1.w)) * inv_n + EPS); } else if (inv_n > 0.f) sc = 1.0f / sqrtf(rscale[row] * inv_n + EPS); else if (rscale) sc = rscale[row]; bf16_t* rowp = base + (size_t)row * ldc + col0;
#pragma unroll
                for (int bj = 0; bj < 2; ++bj) if (bj == 0 || !halfn) *(u32x4*)(rowp + bj * HALF) = pack8(acc[ai][bj][m][0] * sc, acc[ai][bj][m][1] * sc); }
    }
};
struct EpiWin {
    static constexpr bool PERM = true, AFTER_DRAIN = false;
    bf16_t *CQ, *CKV, *Z, *XBC; float* TAIL; const float* rscale;
    __device__ __forceinline__ void operator()(const f32x4 (&acc)[2][2][4][2], const Unit& u, int wr, int wc, int fr, int fq) const {
        const int row0 = u.pm * BM + wr * 64 + fr, pn = u.pn;
        bf16_t* base; int ldc, colt;
        if (pn < 2) { base = CQ; ldc = 512; colt = pn * 256; } else if (pn < 4) { base = CKV; ldc = 512; colt = (pn - 2) * 256; }
        else if (pn < 8) { base = Z; ldc = 1024; colt = (pn - 4) * 256; } else { base = XBC; ldc = 2048; colt = (pn - 8) * 256; }
        const int cl = wc * 32 + 8 * fq;
#pragma unroll
        for (int ai = 0; ai < 2; ++ai)
#pragma unroll
            for (int m = 0; m < 4; ++m) { const int row = row0 + ai * HALF + m * 16; const float sc = 1.0f / sqrtf(rscale[row] * (1.f / 2048.f) + EPS);
                if (pn < 16) { bf16_t* rowp = base + (size_t)row * ldc + colt + cl;
#pragma unroll
                    for (int bj = 0; bj < 2; ++bj) *(u32x4*)(rowp + bj * HALF) = pack8(acc[ai][bj][m][0] * sc, acc[ai][bj][m][1] * sc); }
                else if (cl < 80) { float* rowp = TAIL + (size_t)row * 80 + cl; *(f32x4*)rowp = acc[ai][0][m][0] * sc; *(f32x4*)(rowp + 4) = acc[ai][0][m][1] * sc; } }
    }
};
struct EpiResid {
    static constexpr bool PERM = true, AFTER_DRAIN = false;
    bf16_t* X; float* SSQ; float fac;
    __device__ __forceinline__ void operator()(const f32x4 (&acc)[2][2][4][2], const Unit& u, int wr, int wc, int fr, int fq) const {
        const int row0 = u.pm * BM + wr * 64 + fr, col0 = u.pn * BM + wc * 32 + 8 * fq;
#pragma unroll
        for (int ai = 0; ai < 2; ++ai)
#pragma unroll
            for (int m = 0; m < 4; ++m) { const int row = row0 + ai * HALF + m * 16; const size_t off = (size_t)row * DM + col0; float ss = 0.f;
#pragma unroll
                for (int bj = 0; bj < 2; ++bj) { float f[8]; unpack8(*(const u32x4*)(X + off + bj * HALF), f);
                    const f32x4 v0 = (f32x4){f[0], f[1], f[2], f[3]} + acc[ai][bj][m][0] * fac, v1 = (f32x4){f[4], f[5], f[6], f[7]} + acc[ai][bj][m][1] * fac;
                    *(u32x4*)(X + off + bj * HALF) = pack8(v0, v1);
                    ss += ((v0.x * v0.x + v0.y * v0.y) + (v0.z * v0.z + v0.w * v0.w)) + ((v1.x * v1.x + v1.y * v1.y) + (v1.z * v1.z + v1.w * v1.w)); }
                ss = xrow16_sum(ss);
                if (SSQ && fq == 0) SSQ[(size_t)row * 32 + u.pn * 4 + wc] = ss; }
    }
};
struct EpiTail {
    static constexpr bool PERM = true, AFTER_DRAIN = false;
    EpiWin in;
    __device__ __forceinline__ void operator()(const f32x4 (&acc)[2][2][4][2], const Unit& u, int wr, int wc, int fr, int fq) const { const Unit t{u.pm, 16}; in(acc, t, wr, wc, fr, fq); }
};
}

#define XB_TMO      128
#define XB_XCNT(j)  (256  + 64 * (j))
#define XB_XSUB(j)  (1280 + 64 * (j))
#define XB_XGEN(j)  (2304 + 64 * (j))
#define XB_TOP      3328
#define XB_TOPGEN   3392
#define XCD_BAR_WORDS 3456
#define XB_SPIN_CAP (1u << 25)
__device__ __forceinline__ unsigned xb_ld(unsigned* p)              { return __hip_atomic_load(p, __ATOMIC_RELAXED, __HIP_MEMORY_SCOPE_AGENT); }
__device__ __forceinline__ unsigned xb_add(unsigned* p, unsigned v) { return __hip_atomic_fetch_add(p, v, __ATOMIC_RELAXED, __HIP_MEMORY_SCOPE_AGENT); }
__device__ __forceinline__ unsigned xb_xcc_id() { return (unsigned)__builtin_amdgcn_s_getreg((3 << 11) | 20) & 0xFu; }
#define XB_SPIN(cond, bar) do { unsigned _sp = 0; while (cond) { __builtin_amdgcn_s_sleep(1); \
    if ((++_sp & 255u) == 0u) { if (xb_ld(&(bar)[XB_TMO])) break; if (_sp > XB_SPIN_CAP) { atomicAdd(&(bar)[XB_TMO], 1u); break; } } } } while (0)
struct XcdBarrier { unsigned* bar; unsigned x; volatile LAS unsigned* st; };
__device__ __forceinline__ XcdBarrier xcd_barrier_post(unsigned* bar, volatile LAS unsigned* st) {
    XcdBarrier b; b.bar = bar; b.x = xb_xcc_id(); b.st = st;
    if (threadIdx.x == 0) (void)xb_add(&bar[XB_XCNT(b.x)], 1u);
    return b;
}
__device__ __forceinline__ void xcd_barrier_complete(unsigned* bar, unsigned x, unsigned& nloc, unsigned& nx) {
    const unsigned G = gridDim.x * gridDim.y * gridDim.z;
    unsigned sum, cnt, mine, sp = 0u;
    for (;;) {
        sum = 0u; cnt = 0u; mine = 0u;
#pragma unroll
        for (unsigned j = 0; j < 16; ++j) { const unsigned c = xb_ld(&bar[XB_XCNT(j)]); sum += c; cnt += (c > 0u) ? 1u : 0u; mine = (j == x) ? c : mine; }
        if (sum == G) break;
        __builtin_amdgcn_s_sleep(1);
        if ((++sp & 255u) == 0u) { if (xb_ld(&bar[XB_TMO])) break; if (sp > XB_SPIN_CAP) { atomicAdd(&bar[XB_TMO], 1u); break; } }
    }
    nloc = mine > 0u ? mine : 1u; nx = cnt > 0u ? cnt : 1u;
}
__device__ __forceinline__ void xcd_barrier(const XcdBarrier& b, bool is_t0) {
    asm volatile("s_waitcnt vmcnt(0)" ::: "memory");
    __syncthreads();
    if (is_t0) {
        unsigned* bar = b.bar;
        __builtin_amdgcn_s_waitcnt(0);
        unsigned nloc = b.st[0], nx = b.st[1];
        if (nloc == 0u) { xcd_barrier_complete(bar, b.x, nloc, nx); b.st[0] = nloc; b.st[1] = nx; }
        const unsigned old = xb_add(&bar[XB_XSUB(b.x)], 1u);
        const unsigned gen = old / nloc;
        if (old + 1u == (gen + 1u) * nloc) {
            __builtin_amdgcn_fence(__ATOMIC_RELEASE, "agent");
            asm volatile("s_waitcnt vmcnt(0)" ::: "memory");
            const unsigned og = xb_add(&bar[XB_TOP], 1u);
            const unsigned tg = og / nx;
            if (og + 1u == (tg + 1u) * nx) xb_add(&bar[XB_TOPGEN], 1u);
            else XB_SPIN(xb_ld(&bar[XB_TOPGEN]) == tg, bar);
            __builtin_amdgcn_fence(__ATOMIC_ACQUIRE, "agent");
            xb_add(&bar[XB_XGEN(b.x)], 1u);
            asm volatile("s_waitcnt vmcnt(0)" ::: "memory");
        } else {
            XB_SPIN(xb_ld(&bar[XB_XGEN(b.x)]) == gen, bar);
            __builtin_amdgcn_fence(__ATOMIC_ACQUIRE, "agent");
            asm volatile("s_waitcnt vmcnt(0)" ::: "memory");
        }
    }
    __syncthreads();
}

struct Args {
    const float* in[39]; const int* pos; float* out; unsigned char* ws; int ph_lo, ph_hi;
};
struct Frame {
    LAS unsigned char* lds; int tid, lane, wave, G, bid, gw, NGW;
    GAS unsigned char* ws;
};
#define WSP(T, off) ((T*)(F.ws + (off)))

__device__ __forceinline__ void transpose_item(const float* W, int K, int N, bf16_t* WT, int ldt, int dst_row0, const float* gain, LAS float* scr, int k0, int n0, int lane) {
    const int n4 = (lane & 7) * 4; const bool ok = n0 + n4 < N;
    f32x4 v[8];
#pragma unroll
    for (int i = 0; i < 8; ++i) { const int kk = (lane >> 3) + 8 * i; v[i] = ok ? *(const f32x4*)(W + (size_t)(k0 + kk) * N + n0 + n4) : (f32x4){0.f, 0.f, 0.f, 0.f}; }
#pragma unroll
    for (int i = 0; i < 8; ++i) { const int kk = (lane >> 3) + 8 * i; const float gg = gain ? gain[k0 + kk] : 1.f; LAS float* s = scr + kk * 33 + n4; s[0] = v[i].x * gg; s[1] = v[i].y * gg; s[2] = v[i].z * gg; s[3] = v[i].w * gg; }
    asm volatile("s_waitcnt lgkmcnt(0)" ::: "memory");
    const int c = lane & 7;
#pragma unroll
    for (int j = 0; j < 4; ++j) { const int n = (lane >> 3) + 8 * j; const LAS float* s = scr + (8 * c) * 33 + n;
        u32x4 o; o.x = cvt_pk_bf16(s[0 * 33], s[1 * 33]); o.y = cvt_pk_bf16(s[2 * 33], s[3 * 33]); o.z = cvt_pk_bf16(s[4 * 33], s[5 * 33]); o.w = cvt_pk_bf16(s[6 * 33], s[7 * 33]);
        *(u32x4*)(WT + (size_t)(dst_row0 + n) * ldt + k0 + 8 * c) = o; }
    asm volatile("s_waitcnt lgkmcnt(0)" ::: "memory");
}
__device__ __forceinline__ void transpose_matrix(Frame& F, const float* W, int K, int N, bf16_t* WT, int row_off, const float* gain, LAS float* scr) {
    const int nblk = (N + 31) / 32, items = (K / 64) * nblk;
    for (int it = F.gw; it < items; it += F.NGW) { const int kb = it / nblk, nb = it % nblk; transpose_item(W, K, N, WT, K, row_off + nb * 32, gain, scr, kb * 64, nb * 32, F.lane); }
}
__device__ __forceinline__ int win_dst_row(int n0) {
    if (n0 < 1024) return n0; if (n0 < 1088) return 4096 + (n0 - 1024); if (n0 < 2112) return 1024 + (n0 - 1088); if (n0 < 4160) return 2048 + (n0 - 2112); return 4160;
}
__device__ __forceinline__ void rowstat_row(const float* xrow, bf16_t* orow, float* rstd_out, int lane) {
    f32x4 v[8]; float s = 0.f;
#pragma unroll
    for (int j = 0; j < 8; ++j) v[j] = *(const f32x4*)(xrow + j * 256 + lane * 4);
#pragma unroll
    for (int j = 0; j < 8; ++j) s += (v[j].x * v[j].x + v[j].y * v[j].y) + (v[j].z * v[j].z + v[j].w * v[j].w);
    s = wave_sum(s, lane);
#pragma unroll
    for (int j = 0; j < 8; ++j) { u32x2 o; o.x = cvt_pk_bf16(v[j].x, v[j].y); o.y = cvt_pk_bf16(v[j].z, v[j].w); *(u32x2*)(orow + j * 256 + lane * 4) = o; }
    if (lane == 0) *rstd_out = s;
}
__device__ __forceinline__ void rowstat_phase(Frame& F, const float* X, bf16_t* XB, float* RSTD, int nrows) {
    for (int m = F.gw; m < nrows; m += F.NGW) rowstat_row(X + (size_t)m * DM, XB + (size_t)m * DM, RSTD + m, F.lane);
}

constexpr int PEER_V4_MASK = 3;
constexpr int PEER_U4_MASK = 3;
constexpr int TCONV_G = 256, TCONV_FIRST = 64, TCONV_BLOCKS = 128;
__device__ __forceinline__ void convert_table_rows(Frame& F, const Args& a, int r0, int r1, int w0, int nw) {
    if (r0 + w0 >= r1) return;
    const int l = r0 / PEER_E;
    const bool u4 = (PEER_U4_MASK >> l) & 1, v4 = (PEER_V4_MASK >> l) & 1;
    f32x4 vg[8];
    { const float* gain = a.in[6] + l * 2048;
#pragma unroll
      for (int q = 0; q < 8; ++q) vg[q] = *(const f32x4*)(gain + q * 256 + F.lane * 4); }
    f32x4 nu[8], nv[8];
#define CV_LOAD(row) do { _Pragma("unroll") for (int q = 0; q < 8; ++q) { const size_t o_ = (size_t)(row) * 2048 + q * 256 + F.lane * 4; nu[q] = *(const f32x4*)(a.in[14] + o_); nv[q] = *(const f32x4*)(a.in[15] + o_); } } while (0)
    unsigned pu[8], pv[8]; float su = 0.f, sv = 0.f; int rp = r0 + w0;
#define CV_STORE() do { const int er_ = rp % PEER_E; unsigned char* du_ = WSP(unsigned char, WS_U8) + (size_t)l * PEER_E * 2048 + (size_t)er_ * 128; unsigned char* dv_ = WSP(unsigned char, WS_V8) + (size_t)l * PEER_E * 2048 + (size_t)er_ * 128; \
        _Pragma("unroll") for (int q = 0; q < 8; ++q) { const size_t so_ = (size_t)(q * 2 + (F.lane >> 5)) * PEER_E * 128 + (F.lane & 31) * 4, s4_ = (size_t)q * PEER_E * 128 + (F.lane >> 1) * 4; \
            if (!u4) *(unsigned*)(du_ + so_) = pu[q]; else if ((F.lane & 1) == 0) *(unsigned*)(du_ + s4_) = pu[q]; \
            if (!v4) *(unsigned*)(dv_ + so_) = pv[q]; else if ((F.lane & 1) == 0) *(unsigned*)(dv_ + s4_) = pv[q]; } \
        if (F.lane == 0) { WSP(float, WS_TSC)[rp] = su; WSP(float, WS_TSC)[(size_t)2 * PEER_E + rp] = sv; } } while (0)
#define S8(x, s) (((unsigned)(int)__builtin_rintf((x) * (s))) & 0xffu)
#define T4(x, s) ((unsigned)(((int)__builtin_rintf((x) * (s)) + o8) & 0xF))
#define T4U(x, s) ((unsigned)((int)__builtin_rintf((x) * (s)) & 0xF))
#define CV_PACK(row) do { float mu = 0.f, mv = 0.f; \
        _Pragma("unroll") for (int i = 0; i < 8; ++i) { vu[i] = vu[i] * vg[i]; \
            mu = fmaxf(fmaxf(mu, fmaxf(fabsf(vu[i].x), fabsf(vu[i].y))), fmaxf(fabsf(vu[i].z), fabsf(vu[i].w))); \
            mv = fmaxf(fmaxf(mv, fmaxf(fabsf(vv[i].x), fabsf(vv[i].y))), fmaxf(fabsf(vv[i].z), fabsf(vv[i].w))); } \
        mu = wave_max(mu); mv = wave_max(mv); \
        const float iu = mu > 0.f ? (u4 ? 7.f : 127.f) / mu : 0.f, iv = mv > 0.f ? (v4 ? 7.f : 127.f) / mv : 0.f; const int o8 = (F.lane & 1) ? 0 : 8; \
        _Pragma("unroll") for (int q = 0; q < 8; ++q) { const f32x4 x = vu[q], y = vv[q]; \
            if (!u4) pu[q] = S8(x.x, iu) | (S8(x.y, iu) << 8) | (S8(x.z, iu) << 16) | (S8(x.w, iu) << 24); \
            else { const unsigned nb = T4U(x.x, iu) | (T4U(x.y, iu) << 8) | (T4U(x.z, iu) << 16) | (T4U(x.w, iu) << 24); pu[q] = nb | ((unsigned)dppi<0xB1>((int)nb) << 4); }        \
            if (!v4) pv[q] = S8(y.x, iv) | (S8(y.y, iv) << 8) | (S8(y.z, iv) << 16) | (S8(y.w, iv) << 24); \
            else { const unsigned nb = T4(y.x, iv) | (T4(y.y, iv) << 8) | (T4(y.z, iv) << 16) | (T4(y.w, iv) << 24); pv[q] = nb | ((unsigned)dppi<0xB1>((int)nb) << 4); } } \
        su = mu * (u4 ? 1.f / 7.f : 1.f / 127.f); sv = mv * (v4 ? 1.f / 7.f : 1.f / 127.f); rp = (row); } while (0)
    CV_LOAD(r0 + w0);
    { f32x4 vu[8], vv[8];
#pragma unroll
      for (int q = 0; q < 8; ++q) { vu[q] = nu[q]; vv[q] = nv[q]; }
      { const int rn = r0 + w0 + nw < r1 ? r0 + w0 + nw : r0 + w0; CV_LOAD(rn); }
      CV_PACK(r0 + w0); }
#pragma unroll 1
    for (int r = r0 + w0 + nw; r < r1; r += nw) {
        f32x4 vu[8], vv[8];
#pragma unroll
        for (int q = 0; q < 8; ++q) { vu[q] = nu[q]; vv[q] = nv[q]; }
        CV_STORE();
        { const int rn = r + nw < r1 ? r + nw : r; CV_LOAD(rn); }
        CV_PACK(r);
    }
    CV_STORE();
#undef CV_LOAD
#undef CV_STORE
#undef CV_PACK
#undef S8
#undef T4
#undef T4U
}
__device__ __forceinline__ void transpose_matrix_w(int w0, int nw, int lane, const float* W, int K, int N, bf16_t* WT, const float* gain, LAS float* scr) {
    const int nblk = (N + 31) / 32, items = (K / 64) * nblk;
    for (int it = w0; it < items; it += nw) { const int kb = it / nblk, nb = it % nblk; transpose_item(W, K, N, WT, K, nb * 32, gain, scr, kb * 64, nb * 32, lane); }
}
__device__ __forceinline__ void p_layer1_weights(Frame& F, const Args& a, int w0, int nw) {
    LAS float* scr = (LAS float*)(F.lds + F.wave * 16384);
    transpose_matrix_w(w0, nw, F.lane, a.in[30], 2048, 6144, WSP(bf16_t, WS_WQKV), a.in[3] + 2048, scr);
    transpose_matrix_w(w0, nw, F.lane, a.in[38], 2048, 2048, WSP(bf16_t, WS_WO), nullptr, scr);
    transpose_matrix_w(w0, nw, F.lane, a.in[7] + (size_t)2048 * 512, 2048, 512, WSP(bf16_t, WS_WMEMQ) + (size_t)512 * 2048, a.in[4] + 2048, scr);
    transpose_matrix_w(w0, nw, F.lane, a.in[11] + (size_t)512 * 2048, 512, 2048, WSP(bf16_t, WS_WMEMO) + (size_t)2048 * 512, nullptr, scr);
    transpose_matrix_w(w0, nw, F.lane, a.in[12] + (size_t)2048 * 2048, 2048, 2048, WSP(bf16_t, WS_WPEERQ) + (size_t)2048 * 2048, a.in[6] + 2048, scr);
}
__device__ __forceinline__ void p_layer0_late_weights(Frame& F, const Args& a, int w0, int nw) {
    LAS float* scr = (LAS float*)(F.lds + F.wave * 16384);
    transpose_matrix_w(w0, nw, F.lane, a.in[29], 2048, 2048, WSP(bf16_t, WS_WOUT), nullptr, scr);
    transpose_matrix_w(w0, nw, F.lane, a.in[7], 2048, 512, WSP(bf16_t, WS_WMEMQ), a.in[4], scr);
    transpose_matrix_w(w0, nw, F.lane, a.in[11], 512, 2048, WSP(bf16_t, WS_WMEMO), nullptr, scr);
    transpose_matrix_w(w0, nw, F.lane, a.in[12], 2048, 2048, WSP(bf16_t, WS_WPEERQ), a.in[6], scr);
}
__device__ __forceinline__ void p_prologue(Frame& F, const Args& a) {
    LAS float* scr = (LAS float*)(F.lds + F.wave * 16384);
    {
        const float* W = a.in[16]; const float* gain = a.in[3]; bf16_t* WT = WSP(bf16_t, WS_WIN);
        const int nblk = 131, items = 32 * nblk;
        for (int it = F.gw; it < items; it += F.NGW) { const int kb = it / nblk, nb = it % nblk; transpose_item(W, 2048, EVEN_IN, WT, 2048, win_dst_row(nb * 32), gain, scr, kb * 64, nb * 32, F.lane); }
        for (int i = F.gw * 64 + F.lane; i < (4352 - 4192) * 2048 / 8; i += F.NGW * 64) *(u32x4*)(WT + (size_t)4192 * 2048 + (size_t)i * 8) = (u32x4){0u, 0u, 0u, 0u};
    }
    transpose_matrix(F, a.in[19], 512, 1536, WSP(bf16_t, WS_WUQ), 0, a.in[17], scr);
    transpose_matrix(F, a.in[20], 512, 2048, WSP(bf16_t, WS_WUKV), 0, a.in[18], scr);
    if (F.G != TCONV_G) p_layer0_late_weights(F, a, F.gw, F.NGW);
    for (int l = 0; l < 2; ++l) transpose_matrix(F, a.in[8] + (size_t)l * 2048 * 1024, 2048, 1024, WSP(bf16_t, WS_WMEMKV) + (size_t)l * 1024 * 2048, 0, a.in[5] + l * 2048, scr);
    if (F.G != TCONV_G) p_layer1_weights(F, a, F.gw, F.NGW);
    { const float* src = a.in[13]; bf16_t* dst = WSP(bf16_t, WS_KEYS); const int n8 = 2 * 8 * 2 * 128 * 128 / 8;
      for (int i = F.gw * 64 + F.lane; i < n8; i += F.NGW * 64) *(u32x4*)(dst + (size_t)i * 8) = pack8(*(const f32x4*)(src + (size_t)i * 8), *(const f32x4*)(src + (size_t)i * 8 + 4)); }
    if (F.G != TCONV_G) { convert_table_rows(F, a, 0, PEER_E, F.gw, F.NGW); convert_table_rows(F, a, PEER_E, 2 * PEER_E, F.gw, F.NGW); }
    { f32x2* r32 = WSP(f32x2, WS_ROPE32); f32x2* r64 = WSP(f32x2, WS_ROPE64);
      for (int i = F.gw * 64 + F.lane; i < TOK * 96; i += F.NGW * 64) { const int t = i / 96, j = i % 96; const bool is32 = j < 32; const int jj = is32 ? j : j - 32; const float half = is32 ? 32.f : 64.f;
          const float inv = 1.0f / exp2f(((float)jj / half) * 13.287712379549449f);
          const float ang = (float)a.pos[t] * inv;
          double rv = (double)ang * 0.15915494309189535; rv -= __builtin_rint(rv);
          const float fr = (float)rv; const f32x2 cs = {__builtin_amdgcn_cosf(fr), __builtin_amdgcn_sinf(fr)};
          if (is32) r32[(size_t)t * 32 + jj] = cs; else r64[(size_t)t * 64 + jj] = cs; } }
    rowstat_phase(F, a.in[0], WSP(bf16_t, WS_XB), WSP(float, WS_RSTD), TOK);
    rowstat_phase(F, a.in[1], WSP(bf16_t, WS_MEMB), WSP(float, WS_RSTD_MEM), BATCH * NMEM);
}


namespace att {
__device__ __forceinline__ int crow(int r, int hi) { return (r & 3) + 8 * (r >> 2) + 4 * hi; }
template <int ND> __device__ __forceinline__ int v_st(int k, int c) { const int kk = (k & ~0xC) | ((k & 4) << 1) | ((k & 8) >> 1); return ((kk >> 3) * ND + (c >> 5)) * 512 + ((kk & 7) * 32 + (c & 31)) * 2; }
__device__ __forceinline__ int v_rd_base(int lane) { return ((lane & 3) << 3) | (((lane >> 2) & 3) << 6) | (((lane >> 4) & 1) << 5) | (((lane >> 5) & 1) << 8); }
#define ATT_TR(dst, off) asm volatile("ds_read_b64_tr_b16 %0, %1 offset:%2" : "=&v"(dst) : "v"(vb), "i"(off) : "memory")
#define ATT_PK(L, H) (bf16x8){L[0], L[1], L[2], L[3], H[0], H[1], H[2], H[3]}
template <int BASE> __device__ __forceinline__ bf16x8 att_pk4(const f32x16& P) {
    const unsigned a0 = cvt_pk_bf16(P[BASE + 0], P[BASE + 1]), a1 = cvt_pk_bf16(P[BASE + 2], P[BASE + 3]), b0 = cvt_pk_bf16(P[BASE + 4], P[BASE + 5]), b1 = cvt_pk_bf16(P[BASE + 6], P[BASE + 7]);
    auto r0 = __builtin_amdgcn_permlane32_swap(a0, b0, false, false); auto r1 = __builtin_amdgcn_permlane32_swap(a1, b1, false, false);
    const u32x4 w = {r0[0], r1[0], r0[1], r1[1]}; return __builtin_bit_cast(bf16x8, w);
}
template <int ND, int D0> __device__ __forceinline__ void sm_slice(f32x16& p1, float Cr, float mnC, float& ps1, bf16x8& pa2, bf16x8& pa3) {
    if constexpr (D0 + 1 < ND) { constexpr int R0 = D0 * 16 / (ND - 1), R1 = (D0 + 1) * 16 / (ND - 1);
#pragma unroll
        for (int r = R0; r < R1; ++r) p1[r] = __builtin_amdgcn_exp2f(fmaf(p1[r], Cr, mnC)); }
    else { ps1 = ((p1[0] + p1[1]) + (p1[2] + p1[3])) + ((p1[4] + p1[5]) + (p1[6] + p1[7])) + (((p1[8] + p1[9]) + (p1[10] + p1[11])) + ((p1[12] + p1[13]) + (p1[14] + p1[15])));
           pa2 = att_pk4<0>(p1); pa3 = att_pk4<8>(p1); }
}
template <int ND, int D0> struct PvB {
    static __device__ __forceinline__ void run(f32x16* o, int vb, bf16x8 pa2, bf16x8 pa3, s16x4& c0, s16x4& c1, s16x4& c2, s16x4& c3, s16x4& n0, s16x4& n1, s16x4& n2, s16x4& n3) {
        constexpr int KS = 2 * ND * 512, HF = ND * 512;
        if constexpr (D0 + 1 < ND) { constexpr int NB = (D0 + 1) * 512; ATT_TR(n0, NB + 2 * KS); ATT_TR(n1, NB + 2 * KS + HF); ATT_TR(n2, NB + 3 * KS); ATT_TR(n3, NB + 3 * KS + HF); asm volatile("s_waitcnt lgkmcnt(4)" ::: "memory"); }
        else asm volatile("s_waitcnt lgkmcnt(0)" ::: "memory");
        __builtin_amdgcn_sched_barrier(0);
        o[D0] = __builtin_amdgcn_mfma_f32_32x32x16_bf16(pa2, ATT_PK(c0, c1), o[D0], 0, 0, 0);
        o[D0] = __builtin_amdgcn_mfma_f32_32x32x16_bf16(pa3, ATT_PK(c2, c3), o[D0], 0, 0, 0);
        __builtin_amdgcn_sched_barrier(0);
        if constexpr (D0 + 1 < ND) PvB<ND, D0 + 1>::run(o, vb, pa2, pa3, n0, n1, n2, n3, c0, c1, c2, c3);
    }
};
template <int ND, int D0> struct PvA {
    static __device__ __forceinline__ void run(f32x16* o, int vb, bf16x8 pa0, bf16x8 pa1, bf16x8& pa2, bf16x8& pa3, f32x16& p1, float Cr, float mnC, float& ps1,
                                               s16x4& c0, s16x4& c1, s16x4& c2, s16x4& c3, s16x4& n0, s16x4& n1, s16x4& n2, s16x4& n3) {
        constexpr int KS = 2 * ND * 512, HF = ND * 512;
        if constexpr (D0 + 1 < ND) { constexpr int NB = (D0 + 1) * 512; ATT_TR(n0, NB); ATT_TR(n1, NB + HF); ATT_TR(n2, NB + KS); ATT_TR(n3, NB + KS + HF); }
        else { ATT_TR(n0, 2 * KS); ATT_TR(n1, 2 * KS + HF); ATT_TR(n2, 3 * KS); ATT_TR(n3, 3 * KS + HF); }
        asm volatile("s_waitcnt lgkmcnt(4)" ::: "memory"); __builtin_amdgcn_sched_barrier(0);
        o[D0] = __builtin_amdgcn_mfma_f32_32x32x16_bf16(pa0, ATT_PK(c0, c1), o[D0], 0, 0, 0);
        o[D0] = __builtin_amdgcn_mfma_f32_32x32x16_bf16(pa1, ATT_PK(c2, c3), o[D0], 0, 0, 0);
        __builtin_amdgcn_sched_barrier(0);
        sm_slice<ND, D0>(p1, Cr, mnC, ps1, pa2, pa3);
        __builtin_amdgcn_sched_barrier(0);
        if constexpr (D0 + 1 < ND) PvA<ND, D0 + 1>::run(o, vb, pa0, pa1, pa2, pa3, p1, Cr, mnC, ps1, n0, n1, n2, n3, c0, c1, c2, c3);
        else PvB<ND, 0>::run(o, vb, pa2, pa3, n0, n1, n2, n3, c0, c1, c2, c3);
    }
};
template <int ND> __device__ __forceinline__ void pv_all(f32x16* o, int vb, bf16x8 pa0, bf16x8 pa1, f32x16& p1, float Cr, float mnC, float& ps1) {
    constexpr int KS = 2 * ND * 512, HF = ND * 512;
    s16x4 a0, a1, a2, a3, b0, b1, b2, b3; bf16x8 pa2, pa3;
    ATT_TR(a0, 0); ATT_TR(a1, HF); ATT_TR(a2, KS); ATT_TR(a3, KS + HF);
    PvA<ND, 0>::run(o, vb, pa0, pa1, pa2, pa3, p1, Cr, mnC, ps1, a0, a1, a2, a3, b0, b1, b2, b3);
}
template <int DQK, int DV, bool CAUSAL, bool QNORM = false, int NRP = 0, bool DIFFC = false>
__device__ __forceinline__ void attn_unit(LAS unsigned char* lds, const bf16_t* __restrict__ Qb, int ldq, const bf16_t* __restrict__ Kh, int ldk, const bf16_t* __restrict__ Vh, int ldv,
                                          bf16_t* __restrict__ Ob, int ldo, int NT, int q0, float C, int tid_in, const float* __restrict__ qgain = nullptr, const f32x2* __restrict__ qrope = nullptr,
                                          const bf16_t* O1b = nullptr, bf16_t* Mb = nullptr, int ldm = 0, float dlam = 0.f, const float* __restrict__ cgain = nullptr, float cscale = 1.f) {
    constexpr int NQ = DQK / 16, ND = DV / 32, RBK = DQK * 2, SHM_K = 64 * RBK, SHM_V = 64 * DV * 2;
    constexpr int KCH = DQK / 8, VCH = DV / 8, NKS = 64 * KCH / 512, NVS = 64 * VCH / 512, OST = 128 + 8;
    int tid = tid_in; asm volatile("" : "+v"(tid));
    const int wid = tid >> 6, lane = tid & 63, r32 = lane & 31, hi = lane >> 5;
    LAS float* wsf = (LAS float*)lds + wid * 64; LAS float* li_l = wsf; LAS float* al_l = wsf + 32;
    LAS unsigned char* V_lds = lds + 2048; LAS unsigned char* K_lds = lds + 2048 + 2 * SHM_V;
    float m_reg = -1e30f, l_reg = 0.f; f32x16 o[ND]; bf16x8 qr[NQ];
#pragma unroll
    for (int d = 0; d < ND; ++d)
#pragma unroll
        for (int r = 0; r < 16; ++r) o[d][r] = 0.f;
    { const int qoff = (wid * 32 + r32) * ldq + hi * 8;
#pragma unroll
      for (int d0 = 0; d0 < NQ; ++d0) qr[d0] = *(const bf16x8*)(Qb + (qoff + d0 * 16)); }
    if constexpr (NRP > 0) {
        constexpr int D0R = (DQK - 2 * NRP) / 16, NRD = NRP / 16;
        f32x4 cs[NRD][4];
#pragma unroll
        for (int dd = 0; dd < NRD; ++dd)
#pragma unroll
            for (int e2 = 0; e2 < 4; ++e2) cs[dd][e2] = *(const f32x4*)(qrope + ((wid * 32 + r32) * NRP + dd * 16 + hi * 8 + e2 * 2));
        float ss = 0.f;
#pragma unroll
        for (int d0 = 0; d0 < NQ; ++d0) { float f[8]; unpack8(__builtin_bit_cast(u32x4, qr[d0]), f);
#pragma unroll
            for (int e = 0; e < 8; ++e) ss += f[e] * f[e]; }
        { auto rr = __builtin_amdgcn_permlane32_swap(__float_as_uint(ss), __float_as_uint(ss), false, false); ss = __uint_as_float(rr[0]) + __uint_as_float(rr[1]); }
        const float rs = 1.0f / sqrtf(ss * (1.f / DQK) + EPS);
#define ATT_QG(f, d0) do { const f32x4 g0_ = *(const f32x4*)(qgain + (d0) * 16 + hi * 8), g1_ = *(const f32x4*)(qgain + (d0) * 16 + hi * 8 + 4); \
            f[0] *= rs * g0_.x; f[1] *= rs * g0_.y; f[2] *= rs * g0_.z; f[3] *= rs * g0_.w; f[4] *= rs * g1_.x; f[5] *= rs * g1_.y; f[6] *= rs * g1_.z; f[7] *= rs * g1_.w; } while (0)
#define ATT_QP(f) __builtin_bit_cast(bf16x8, pack8((f32x4){f[0], f[1], f[2], f[3]}, (f32x4){f[4], f[5], f[6], f[7]}))
#pragma unroll
        for (int d0 = 0; d0 < D0R; ++d0) { float f[8]; unpack8(__builtin_bit_cast(u32x4, qr[d0]), f); ATT_QG(f, d0); qr[d0] = ATT_QP(f); }
#pragma unroll
        for (int dd = 0; dd < NRD; ++dd) { const int d0 = D0R + dd, d1 = d0 + NRD; float fa[8], fb[8]; unpack8(__builtin_bit_cast(u32x4, qr[d0]), fa); unpack8(__builtin_bit_cast(u32x4, qr[d1]), fb); ATT_QG(fa, d0); ATT_QG(fb, d1);
#pragma unroll
            for (int e2 = 0; e2 < 4; ++e2) { const f32x4 c = cs[dd][e2];
                const float a0 = fa[2 * e2], b0 = fb[2 * e2], a1 = fa[2 * e2 + 1], b1 = fb[2 * e2 + 1];
                fa[2 * e2] = a0 * c.x - b0 * c.y; fb[2 * e2] = b0 * c.x + a0 * c.y; fa[2 * e2 + 1] = a1 * c.z - b1 * c.w; fb[2 * e2 + 1] = b1 * c.z + a1 * c.w; }
            qr[d0] = ATT_QP(fa); qr[d1] = ATT_QP(fb); }
#undef ATT_QG
#undef ATT_QP
    }
    float Cr = C;
    if constexpr (QNORM) { float ss = 0.f;
#pragma unroll
        for (int d0 = 0; d0 < NQ; ++d0) { float f[8]; unpack8(__builtin_bit_cast(u32x4, qr[d0]), f);
#pragma unroll
            for (int e = 0; e < 8; ++e) ss += f[e] * f[e]; }
        { auto rr = __builtin_amdgcn_permlane32_swap(__float_as_uint(ss), __float_as_uint(ss), false, false); ss = __uint_as_float(rr[0]) + __uint_as_float(rr[1]); }
        Cr = C / sqrtf(ss * (1.f / DQK) + EPS); }
    const int widu = __builtin_amdgcn_readfirstlane(wid); int kgo[NKS], vgo[NVS];
#pragma unroll
    for (int i = 0; i < NKS; ++i) { const int s = (i * 8 + wid) * 64 + lane, row = s / KCH, pos = s % KCH, ch = pos ^ (row & 7); kgo[i] = row * ldk + ch * 8; }
#pragma unroll
    for (int i = 0; i < NVS; ++i) { const int s = (i * 8 + wid) * 64 + lane, sub = s >> 5, within = s & 31, kk = (sub / ND) * 8 + (within >> 2), k = (kk & ~0xC) | ((kk & 4) << 1) | ((kk & 8) >> 1), c = (sub % ND) * 32 + (within & 3) * 8; vgo[i] = k * ldv + c; }
#define ATT_DMA(b, k0) do { const bf16_t* kb_ = Kh + (size_t)(k0) * ldk; const bf16_t* vb_ = Vh + (size_t)(k0) * ldv; \
        _Pragma("unroll") for (int i = 0; i < NKS; ++i) __builtin_amdgcn_global_load_lds((const unsigned*)(kb_ + kgo[i]), (LAS unsigned*)(K_lds + (b) * SHM_K + (i * 8 + widu) * 1024), 16, 0, 0); \
        _Pragma("unroll") for (int i = 0; i < NVS; ++i) __builtin_amdgcn_global_load_lds((const unsigned*)(vb_ + vgo[i]), (LAS unsigned*)(V_lds + (b) * SHM_V + (i * 8 + widu) * 1024), 16, 0, 0); } while (0)
    const int vb0 = (int)(uintptr_t)V_lds + v_rd_base(lane);
    ATT_DMA(0, 0);
    if (widu >= 4) __builtin_amdgcn_s_setprio(1);
    for (int j = 0; j < NT; ++j) {
        asm volatile("s_waitcnt vmcnt(0)" ::: "memory");
        __syncthreads();
        if (j + 1 < NT) ATT_DMA((j + 1) & 1, (j + 1) * 64);
        if (CAUSAL && 64 * j > q0 + widu * 32 + 31) continue;
        __builtin_amdgcn_sched_barrier(0);
        f32x16 p0, p1;
#pragma unroll
        for (int r = 0; r < 16; ++r) { p0[r] = 0.f; p1[r] = 0.f; }
        { const LAS unsigned char* Ks = K_lds + (j & 1) * SHM_K;
          bf16x8 kb0 = *(const LAS bf16x8*)(Ks + r32 * RBK + ((hi * 16) ^ ((r32 & 7) << 4))), kb1 = *(const LAS bf16x8*)(Ks + (32 + r32) * RBK + ((hi * 16) ^ ((r32 & 7) << 4)));
          __builtin_amdgcn_sched_barrier(0);
#pragma unroll
          for (int d0 = 0; d0 < NQ; ++d0) { const int cb = ((d0 + 1) * 16 + hi * 8) * 2; bf16x8 nb0 = kb0, nb1 = kb1;
              if (d0 + 1 < NQ) { nb0 = *(const LAS bf16x8*)(Ks + r32 * RBK + (cb ^ ((r32 & 7) << 4))); nb1 = *(const LAS bf16x8*)(Ks + (32 + r32) * RBK + (cb ^ ((r32 & 7) << 4))); }
              p0 = __builtin_amdgcn_mfma_f32_32x32x16_bf16(kb0, qr[d0], p0, 0, 0, 0);
              p1 = __builtin_amdgcn_mfma_f32_32x32x16_bf16(kb1, qr[d0], p1, 0, 0, 0);
              __builtin_amdgcn_sched_group_barrier(0x100, 2, 0); __builtin_amdgcn_sched_group_barrier(0x008, 2, 0);
              kb0 = nb0; kb1 = nb1; } }
        if (CAUSAL) {
            if (64 * j + 63 > q0 + wid * 32) { const int lim = q0 + wid * 32 + r32 - 64 * j - 4 * hi;
#pragma unroll
                for (int r = 0; r < 16; ++r) { if ((r & 3) + 8 * (r >> 2) > lim) p0[r] = -1e30f; if ((r & 3) + 8 * (r >> 2) + 32 > lim) p1[r] = -1e30f; } } }
        __builtin_amdgcn_sched_barrier(0);
        float pmax = p0[0];
#pragma unroll
        for (int r = 1; r < 16; ++r) pmax = fmaxf(pmax, p0[r]);
#pragma unroll
        for (int r = 0; r < 16; ++r) pmax = fmaxf(pmax, p1[r]);
        { auto rr = __builtin_amdgcn_permlane32_swap(__float_as_uint(pmax), __float_as_uint(pmax), false, false); pmax = fmaxf(__uint_as_float(rr[0]), __uint_as_float(rr[1])); }
        float alpha = 1.f;
        if (!__all((pmax - m_reg) * Cr <= 11.541560327f)) { const float mn = fmaxf(m_reg, pmax); alpha = __builtin_amdgcn_exp2f((m_reg - mn) * Cr); m_reg = mn; }
        if (__any(alpha < 1.f)) { if (hi == 0) al_l[r32] = alpha; asm volatile("s_waitcnt lgkmcnt(0)" ::: "memory");
#pragma unroll
            for (int r = 0; r < 16; ++r) { const float af = al_l[crow(r, hi)];
#pragma unroll
                for (int d = 0; d < ND; ++d) o[d][r] *= af; } }
        const float mnC = -m_reg * Cr; float ps = 0.f, ps1 = 0.f;
#pragma unroll
        for (int r = 0; r < 16; ++r) { p0[r] = __builtin_amdgcn_exp2f(fmaf(p0[r], Cr, mnC)); ps += p0[r]; }
        const bf16x8 pa0 = att_pk4<0>(p0), pa1 = att_pk4<8>(p0);
        __builtin_amdgcn_sched_barrier(0);
        pv_all<ND>(o, vb0 + (j & 1) * SHM_V, pa0, pa1, p1, Cr, mnC, ps1);
        ps += ps1;
        { auto rr = __builtin_amdgcn_permlane32_swap(__float_as_uint(ps), __float_as_uint(ps), false, false); ps = __uint_as_float(rr[0]) + __uint_as_float(rr[1]); }
        l_reg = l_reg * alpha + ps;
    }
#undef ATT_DMA
    __builtin_amdgcn_s_setprio(0);
    __syncthreads();
    {
    const int lane = lane_id(), r32 = lane & 31, hi = lane >> 5, wid = widu; LAS float* li_l = (LAS float*)lds + widu * 64;
    if (hi == 0) li_l[r32] = l_reg;
    asm volatile("s_waitcnt lgkmcnt(0)" ::: "memory");
    LAS bf16_t* ost = (LAS bf16_t*)(lds + 2048) + wid * (32 * OST);
    if constexpr (DIFFC) { if (dlam != 0.f) {
        u32x4 vp[2][8]; float ss[8];
        __builtin_amdgcn_fence(__ATOMIC_ACQUIRE, "workgroup");
#pragma unroll
        for (int i = 0; i < 8; ++i) ss[i] = 0.f;
#pragma unroll
        for (int hb = 0; hb < 2; ++hb) {
#pragma unroll
            for (int r = 0; r < 16; ++r) { const int row = crow(r, hi); const float inv = __builtin_amdgcn_rcpf(li_l[row]);
#pragma unroll
                for (int d = 0; d < 4; ++d) ost[row * OST + d * 32 + r32] = f2bf(o[4 * hb + d][r] * inv); }
            asm volatile("s_waitcnt lgkmcnt(0)" ::: "memory");
            u32x4 w1[8];
#pragma unroll
            for (int i = 0; i < 8; ++i) { const int cc = lane + 64 * i, row = cc / 16, ch = cc % 16;
                w1[i] = *(const u32x4*)(O1b + ((wid * 32 + row) * ldo + hb * 128 + ch * 8)); }
#pragma unroll
            for (int i = 0; i < 8; ++i) { const int cc = lane + 64 * i, row = cc / 16, ch = cc % 16; float f1[8], f2[8];
                unpack8(w1[i], f1); unpack8(*(const LAS u32x4*)(ost + row * OST + ch * 8), f2);
#pragma unroll
                for (int e = 0; e < 8; ++e) { f1[e] -= dlam * f2[e]; ss[i] += f1[e] * f1[e]; }
                vp[hb][i] = pack8((f32x4){f1[0], f1[1], f1[2], f1[3]}, (f32x4){f1[4], f1[5], f1[6], f1[7]}); }
            asm volatile("s_waitcnt lgkmcnt(0)" ::: "memory");
        }
#pragma unroll
        for (int i = 0; i < 8; ++i) { float t = row16_sum(ss[i]); ss[i] = cscale / sqrtf(t * (1.f / 256.f) + EPS); }
#pragma unroll
        for (int hb = 0; hb < 2; ++hb)
#pragma unroll
            for (int i = 0; i < 8; ++i) { const int cc = lane + 64 * i, row = cc / 16, ch = cc % 16; float f[8]; unpack8(vp[hb][i], f);
                const f32x4 g0 = *(const f32x4*)(cgain + hb * 128 + ch * 8), g1 = *(const f32x4*)(cgain + hb * 128 + ch * 8 + 4); const float rs = ss[i];
                *(u32x4*)(Mb + ((wid * 32 + row) * ldm + hb * 128 + ch * 8)) = pack8((f32x4){f[0], f[1], f[2], f[3]} * rs * g0, (f32x4){f[4], f[5], f[6], f[7]} * rs * g1); }
        __syncthreads();
        return; } }
#pragma unroll
    for (int hb = 0; hb < ND / 4; ++hb) {
#pragma unroll
        for (int r = 0; r < 16; ++r) { const int row = crow(r, hi); const float inv = __builtin_amdgcn_rcpf(li_l[row]);
#pragma unroll
            for (int d = 0; d < 4; ++d) ost[row * OST + d * 32 + r32] = f2bf(o[4 * hb + d][r] * inv); }
        asm volatile("s_waitcnt lgkmcnt(0)" ::: "memory");
#pragma unroll
        for (int i = 0; i < 32 * 16 / 64; ++i) { const int cc = lane + 64 * i, row = cc / 16, ch = cc % 16;
            const u32x4 w = *(const LAS u32x4*)(ost + row * OST + ch * 8); const int ooff = (wid * 32 + row) * ldo + hb * 128 + ch * 8; *(u32x4*)(Ob + ooff) = w; }
        asm volatile("s_waitcnt lgkmcnt(0)" ::: "memory");
    }
    }
    __syncthreads();
}
}

__device__ __forceinline__ void p_prepA(Frame& F, const Args& a, int u0, int nu) {
    const bf16_t* XBC = WSP(bf16_t, WS_XBC); bf16_t* XC = WSP(bf16_t, WS_XBCC);
    const bf16_t* CQ = WSP(bf16_t, WS_CQ); const bf16_t* CKV = WSP(bf16_t, WS_CKV);
    float* RCQ = WSP(float, WS_RSTD_CQ); float* RCKV = WSP(float, WS_RSTD_CKV); const float* TAIL = WSP(float, WS_TAIL); float* DT = WSP(float, WS_DT);
    const float* cw = a.in[23]; const float* cb = a.in[24]; const float* dtb = a.in[25];
    const int cg = F.tid & 255, half = F.tid >> 8, c0 = cg * 8;
    float w[4][8], bs[8];
#pragma unroll
    for (int e = 0; e < 8; ++e) { bs[e] = cb[c0 + e];
#pragma unroll
        for (int j = 0; j < 4; ++j) w[j][e] = cw[j * 2048 + c0 + e]; }
    for (int u = u0; u < TOK / 64; u += nu) {
        const int t0 = u * 64 + half * 32;
        float x0[8], x1[8], x2[8], x3[8];
        if ((t0 & (SEQ - 1)) == 0) {
#pragma unroll
            for (int e = 0; e < 8; ++e) { x0[e] = 0.f; x1[e] = 0.f; x2[e] = 0.f; }
        } else {
            unpack8(*(const u32x4*)(XBC + (size_t)(t0 - 3) * 2048 + c0), x0); unpack8(*(const u32x4*)(XBC + (size_t)(t0 - 2) * 2048 + c0), x1); unpack8(*(const u32x4*)(XBC + (size_t)(t0 - 1) * 2048 + c0), x2);
        }
#pragma unroll 1
        for (int i8 = 0; i8 < 32; i8 += 16) {
            u32x4 rr[16];
#pragma unroll
            for (int q = 0; q < 16; ++q) rr[q] = *(const u32x4*)(XBC + (size_t)(t0 + i8 + q) * 2048 + c0);
#pragma unroll
            for (int q = 0; q < 16; ++q) { unpack8(rr[q], x3); float o[8];
#pragma unroll
                for (int e = 0; e < 8; ++e) { o[e] = silu_f(bs[e] + w[0][e] * x0[e] + w[1][e] * x1[e] + w[2][e] * x2[e] + w[3][e] * x3[e]); x0[e] = x1[e]; x1[e] = x2[e]; x2[e] = x3[e]; }
                u32x4 pk; pk.x = cvt_pk_bf16(o[0], o[1]); pk.y = cvt_pk_bf16(o[2], o[3]); pk.z = cvt_pk_bf16(o[4], o[5]); pk.w = cvt_pk_bf16(o[6], o[7]);
                *(u32x4*)(XC + (size_t)(t0 + i8 + q) * 2048 + c0) = pk; }
        }
        { u32x4 rq[8], rk[8];
#pragma unroll
          for (int k = 0; k < 8; ++k) { const size_t t = (size_t)u * 64 + F.wave * 8 + k; rq[k] = *(const u32x4*)(CQ + t * 512 + F.lane * 8); rk[k] = *(const u32x4*)(CKV + t * 512 + F.lane * 8); }
#pragma unroll
          for (int k = 0; k < 8; ++k) { const int t = u * 64 + F.wave * 8 + k; float f[8], g[8]; unpack8(rq[k], f); unpack8(rk[k], g); float sq = 0.f, sk = 0.f;
#pragma unroll
              for (int e = 0; e < 8; ++e) { sq += f[e] * f[e]; sk += g[e] * g[e]; }
              sq = wave_sum(sq, F.lane); sk = wave_sum(sk, F.lane);
              if (F.lane == 0) { RCQ[t] = 1.0f / sqrtf(sq * (1.f / 512.f) + EPS); RCKV[t] = 1.0f / sqrtf(sk * (1.f / 512.f) + EPS); } } }
    }
}
__device__ __forceinline__ void p_prep_late(Frame& F, const Args& a) {
    const float* TAIL = WSP(float, WS_TAIL); float* DT = WSP(float, WS_DT); const float* dtb = a.in[25];
    for (int i = F.gw * 64 + F.lane; i < TOK * 16; i += F.NGW * 64) { const int t = i >> 4, h = i & 15; const float v = TAIL[(size_t)t * 80 + 64 + h] + dtb[h];
        DT[i] = fmaxf(v, 0.f) + log1pf(expf(-fabsf(v))); }
    for (int r = F.gw; r < 2 * BATCH * NMEM; r += F.NGW) { const int l = r / (BATCH * NMEM); bf16_t* p = WSP(bf16_t, WS_MEMKV) + (size_t)r * 1024 + F.lane * 8; const float* kg = a.in[10] + l * 128 + (F.lane & 15) * 8; const float* qg = a.in[9] + l * 128 + (F.lane & 15) * 8;
        float f[8]; unpack8(*(const u32x4*)p, f); float s = 0.f;
#pragma unroll
        for (int e = 0; e < 8; ++e) s += f[e] * f[e];
        s = row16_sum(s);
        const float rs = 1.0f / sqrtf(s * (1.f / 128.f) + EPS);
        u32x4 pk; pk.x = cvt_pk_bf16(f[0] * rs * kg[0] * qg[0], f[1] * rs * kg[1] * qg[1]); pk.y = cvt_pk_bf16(f[2] * rs * kg[2] * qg[2], f[3] * rs * kg[3] * qg[3]); pk.z = cvt_pk_bf16(f[4] * rs * kg[4] * qg[4], f[5] * rs * kg[5] * qg[5]); pk.w = cvt_pk_bf16(f[6] * rs * kg[6] * qg[6], f[7] * rs * kg[7] * qg[7]);
        *(u32x4*)p = pk; }
}
__device__ __forceinline__ void p_prepB_tile(Frame& F, const Args& a, int pm, int g) {
    const bf16_t* KV = WSP(bf16_t, WS_KV); bf16_t* KM = WSP(bf16_t, WS_KM); const float* TAIL = WSP(float, WS_TAIL); const f32x2* R32 = WSP(f32x2, WS_ROPE32);
    const float* kg = a.in[22];
    const int i = F.lane & 7, tb = pm * 256 + F.wave * 32 + (F.lane >> 3);
    u32x4 rk0[4], rk1[4]; f32x4 r0[4], r1[4]; f32x4 cs[4][4];
#pragma unroll
    for (int it = 0; it < 4; ++it) { const int t = tb + 8 * it; const bf16_t* ksrc = KV + (size_t)t * 2048 + g * 256;
        rk0[it] = *(const u32x4*)(ksrc + 8 * i); rk1[it] = *(const u32x4*)(ksrc + 64 + 8 * i);
        r0[it] = *(const f32x4*)(TAIL + (size_t)t * 80 + 8 * i); r1[it] = *(const f32x4*)(TAIL + (size_t)t * 80 + 8 * i + 4);
#pragma unroll
        for (int e2 = 0; e2 < 4; ++e2) cs[it][e2] = *(const f32x4*)(R32 + (size_t)t * 32 + 8 * (i & 3) + 2 * e2); }
#pragma unroll
    for (int it = 0; it < 4; ++it) { const int t = tb + 8 * it;
        float v0[8], v1[8], v2[8];
        unpack8(rk0[it], v0); unpack8(rk1[it], v1);
        v2[0] = r0[it].x; v2[1] = r0[it].y; v2[2] = r0[it].z; v2[3] = r0[it].w; v2[4] = r1[it].x; v2[5] = r1[it].y; v2[6] = r1[it].z; v2[7] = r1[it].w;
        float s = 0.f;
#pragma unroll
        for (int e = 0; e < 8; ++e) s += v0[e] * v0[e] + v1[e] * v1[e] + v2[e] * v2[e];
        s = row8_sum(s);
        const float rs = 1.0f / sqrtf(s * (1.f / 192.f) + EPS);
        float o2[8];
#pragma unroll
        for (int e = 0; e < 8; ++e) { v0[e] *= rs * kg[8 * i + e]; v1[e] *= rs * kg[64 + 8 * i + e]; v2[e] *= rs * kg[128 + 8 * i + e]; }
#pragma unroll
        for (int e = 0; e < 8; ++e) { const float pv = shx(v2[e], 4, F.lane); const float c = (e & 1) ? cs[it][e >> 1].z : cs[it][e >> 1].x, sn = (e & 1) ? cs[it][e >> 1].w : cs[it][e >> 1].y;
            o2[e] = (i < 4) ? v2[e] * c - pv * sn : v2[e] * c + pv * sn; }
        bf16_t* dst = KM + (size_t)t * 1536 + g * 192;
        u32x4 pk; pk.x = cvt_pk_bf16(v0[0], v0[1]); pk.y = cvt_pk_bf16(v0[2], v0[3]); pk.z = cvt_pk_bf16(v0[4], v0[5]); pk.w = cvt_pk_bf16(v0[6], v0[7]); *(u32x4*)(dst + 8 * i) = pk;
        pk.x = cvt_pk_bf16(v1[0], v1[1]); pk.y = cvt_pk_bf16(v1[2], v1[3]); pk.z = cvt_pk_bf16(v1[4], v1[5]); pk.w = cvt_pk_bf16(v1[6], v1[7]); *(u32x4*)(dst + 64 + 8 * i) = pk;
        pk.x = cvt_pk_bf16(o2[0], o2[1]); pk.y = cvt_pk_bf16(o2[2], o2[3]); pk.z = cvt_pk_bf16(o2[4], o2[5]); pk.w = cvt_pk_bf16(o2[6], o2[7]); *(u32x4*)(dst + 128 + 8 * i) = pk;
    }
}
__device__ __forceinline__ bf16x8 tr_frag(int a0, int a1) {
    s16x4 lo, hi2; asm volatile("ds_read_b64_tr_b16 %0, %2\n\tds_read_b64_tr_b16 %1, %3\n\ts_waitcnt lgkmcnt(0)" : "=&v"(lo), "=&v"(hi2) : "v"(a0), "v"(a1) : "memory");
    return (bf16x8){lo[0], lo[1], lo[2], lo[3], hi2[0], hi2[1], hi2[2], hi2[3]};
}
__device__ __forceinline__ void ssd_item(Frame& F, const Args& a, int it) {
    const bf16_t* XC = WSP(bf16_t, WS_XBCC); const float* DT = WSP(float, WS_DT); const bf16_t* Z = WSP(bf16_t, WS_Z); bf16_t* YG = WSP(bf16_t, WS_YG);
    constexpr int SBN = 272, SXD = 144;
    constexpr int O_BN = 0, O_CN = 17408, O_XD = 34816, O_HB = 44032, O_ACS = 61440, O_YO = 61952, O_XR = 78336, O_ZR = 78336 + 2 * 9216, NCH = SEQ / 64;
    int tid = F.tid; asm volatile("" : "+v"(tid));
    const int lane = tid & 63, wave = tid >> 6, r32 = lane & 31, hi = lane >> 5, gq = lane >> 4, li = lane & 15;
    const int h = it & 15, b = it >> 4, g = h >> 2;
    const float a_h = -expf(a.in[26][h]), dskip = a.in[27][h];
    LAS unsigned char* L = F.lds; const int Lb = (int)(uintptr_t)L;
    const int sl = tid >> 4, sc = tid & 15, xl = tid >> 3, xc = tid & 7;
    for (int i = tid; i < 64 * SBN / 4; i += NTHREADS) *(LAS unsigned*)(L + O_HB + i * 4) = 0u;
    f32x16 HT;
#pragma unroll
    for (int r = 0; r < 16; ++r) HT[r] = 0.f;
    u32x4 rb0, rb1, rc0, rc1, rx, rz; float rdt, rdtx;
#define SSD_LOAD(c) do { const size_t t0_ = (size_t)b * SEQ + (size_t)(c) * 64; \
        rb0 = *(const u32x4*)(XC + (t0_ + sl) * 2048 + 1024 + g * 128 + sc * 8); rb1 = *(const u32x4*)(XC + (t0_ + 32 + sl) * 2048 + 1024 + g * 128 + sc * 8); \
        rc0 = *(const u32x4*)(XC + (t0_ + sl) * 2048 + 1536 + g * 128 + sc * 8); rc1 = *(const u32x4*)(XC + (t0_ + 32 + sl) * 2048 + 1536 + g * 128 + sc * 8); \
        rx = *(const u32x4*)(XC + (t0_ + xl) * 2048 + h * 64 + xc * 8); rz = *(const u32x4*)(Z + (t0_ + xl) * 1024 + h * 64 + xc * 8); rdtx = DT[(t0_ + xl) * 16 + h]; rdt = DT[(t0_ + lane) * 16 + h]; } while (0)
    SSD_LOAD(0);
    f32x16 yd; float dAtot = 1.f; f32x16 ST;
#pragma unroll
    for (int r = 0; r < 16; ++r) { yd[r] = 0.f; ST[r] = 0.f; }
    const int trB = (li >> 2) * SBN + (16 * (gq & 1) + 4 * (li & 3)) * 2, trX = (li >> 2) * SXD + (16 * (gq & 1) + 4 * (li & 3)) * 2;
    for (int c = 0; c <= NCH; ++c) {
        if (c > 0) {
            if (wave < 4) { const int lb = wave & 1, pb = wave >> 1; const size_t t0_ = (size_t)b * SEQ + (size_t)(c - 1) * 64;
#pragma unroll
                for (int r = 0; r < 16; ++r) { const int l = 32 * lb + att::crow(r, hi), p = 32 * pb + r32; const size_t tr = t0_ + l;
                    const float yv = yd[r] + *(const LAS float*)(L + O_YO + (l * 64 + p) * 4);
                    const bf16_t xv = *(const LAS bf16_t*)(L + O_XR + ((c - 1) & 1) * 9216 + l * SXD + p * 2), zv = *(const LAS bf16_t*)(L + O_ZR + ((c - 1) & 1) * 9216 + l * SXD + p * 2);
                    YG[tr * 1024 + h * 64 + p] = f2bf((yv + dskip * bf2f(xv)) * silu_f(bf2f(zv))); } }
            const int nb = wave & 3, ph = wave >> 2;
#pragma unroll
            for (int r = 0; r < 16; ++r) HT[r] = HT[r] * dAtot + ST[r];
#pragma unroll
            for (int q = 0; q < 4; ++q) { u32x2 w; w.x = cvt_pk_bf16(HT[4 * q], HT[4 * q + 1]); w.y = cvt_pk_bf16(HT[4 * q + 2], HT[4 * q + 3]);
                *(LAS u32x2*)(L + O_HB + (32 * ph + r32) * SBN + (32 * nb + 8 * q + 4 * hi) * 2) = w; }
        }
        if (c == NCH) break;
        { *(LAS u32x4*)(L + O_BN + sl * SBN + sc * 16) = rb0; *(LAS u32x4*)(L + O_BN + (32 + sl) * SBN + sc * 16) = rb1;
          *(LAS u32x4*)(L + O_CN + sl * SBN + sc * 16) = rc0; *(LAS u32x4*)(L + O_CN + (32 + sl) * SBN + sc * 16) = rc1;
          float fx[8]; unpack8(rx, fx); u32x4 xw; xw.x = cvt_pk_bf16(fx[0] * rdtx, fx[1] * rdtx); xw.y = cvt_pk_bf16(fx[2] * rdtx, fx[3] * rdtx); xw.z = cvt_pk_bf16(fx[4] * rdtx, fx[5] * rdtx); xw.w = cvt_pk_bf16(fx[6] * rdtx, fx[7] * rdtx);
          *(LAS u32x4*)(L + O_XD + xl * SXD + xc * 16) = xw;
          *(LAS u32x4*)(L + O_XR + (c & 1) * 9216 + xl * SXD + xc * 16) = rx; *(LAS u32x4*)(L + O_ZR + (c & 1) * 9216 + xl * SXD + xc * 16) = rz;
          if (wave == 0) { float v = rdt * a_h;
              v += __int_as_float(__builtin_amdgcn_update_dpp(0, __float_as_int(v), 0x111, 0xf, 0xf, false)); v += __int_as_float(__builtin_amdgcn_update_dpp(0, __float_as_int(v), 0x112, 0xf, 0xf, false));
              v += __int_as_float(__builtin_amdgcn_update_dpp(0, __float_as_int(v), 0x114, 0xf, 0xf, false)); v += __int_as_float(__builtin_amdgcn_update_dpp(0, __float_as_int(v), 0x118, 0xf, 0xf, false));
              v += __int_as_float(__builtin_amdgcn_update_dpp(0, __float_as_int(v), 0x142, 0xa, 0xf, false)); v += __int_as_float(__builtin_amdgcn_update_dpp(0, __float_as_int(v), 0x143, 0xc, 0xf, false));
              *(LAS float*)(L + O_ACS + lane * 4) = v; } }
        __syncthreads();
        if (c + 1 < NCH) SSD_LOAD(c + 1);
        dAtot = fast_exp(*(const LAS float*)(L + O_ACS + 63 * 4));
        if (wave < 4) {
            const int lb = wave & 1, pb = wave >> 1;
#pragma unroll
            for (int r = 0; r < 16; ++r) yd[r] = 0.f;
            const float acl = *(const LAS float*)(L + O_ACS + (32 * lb + r32) * 4);
#pragma unroll
            for (int sb = 0; sb < 2; ++sb) { if (sb <= lb) {
                f32x16 X;
#pragma unroll
                for (int r = 0; r < 16; ++r) X[r] = 0.f;
#pragma unroll
                for (int ks = 0; ks < 8; ++ks) { const bf16x8 af = *(const LAS bf16x8*)(L + O_BN + (32 * sb + r32) * SBN + (16 * ks + 8 * hi) * 2), bfr = *(const LAS bf16x8*)(L + O_CN + (32 * lb + r32) * SBN + (16 * ks + 8 * hi) * 2);
                    X = __builtin_amdgcn_mfma_f32_32x32x16_bf16(af, bfr, X, 0, 0, 0); }
#pragma unroll
                for (int q = 0; q < 4; ++q) { const f32x4 as = *(const LAS f32x4*)(L + O_ACS + (32 * sb + 8 * q + 4 * hi) * 4);
#pragma unroll
                    for (int e = 0; e < 4; ++e) { const int r = 4 * q + e; float gv = X[r] * fast_exp(acl - as[e]); if (sb == lb && (8 * q + 4 * hi + e) > r32) gv = 0.f; X[r] = gv; } }
#pragma unroll
                for (int k2 = 0; k2 < 2; ++k2) { u32x4 aw; aw.x = cvt_pk_bf16(X[8 * k2], X[8 * k2 + 1]); aw.y = cvt_pk_bf16(X[8 * k2 + 2], X[8 * k2 + 3]); aw.z = cvt_pk_bf16(X[8 * k2 + 4], X[8 * k2 + 5]); aw.w = cvt_pk_bf16(X[8 * k2 + 6], X[8 * k2 + 7]);
                    const int xa = Lb + O_XD + (32 * sb + 16 * k2 + 4 * hi) * SXD + (32 * pb) * 2 + trX;
                    const bf16x8 bw = tr_frag(xa, xa + 8 * SXD);
                    yd = __builtin_amdgcn_mfma_f32_32x32x16_bf16(__builtin_bit_cast(bf16x8, aw), bw, yd, 0, 0, 0); } } }
        } else {
            const int lb = wave & 1, pb = (wave >> 1) & 1; f32x16 Y;
#pragma unroll
            for (int r = 0; r < 16; ++r) Y[r] = 0.f;
#pragma unroll
            for (int ks = 0; ks < 8; ++ks) { const bf16x8 af = *(const LAS bf16x8*)(L + O_CN + (32 * lb + r32) * SBN + (16 * ks + 8 * hi) * 2), bfr = *(const LAS bf16x8*)(L + O_HB + (32 * pb + r32) * SBN + (16 * ks + 8 * hi) * 2);
                Y = __builtin_amdgcn_mfma_f32_32x32x16_bf16(af, bfr, Y, 0, 0, 0); }
#pragma unroll
            for (int q = 0; q < 4; ++q) { const f32x4 al = *(const LAS f32x4*)(L + O_ACS + (32 * lb + 8 * q + 4 * hi) * 4);
#pragma unroll
                for (int e = 0; e < 4; ++e) *(LAS float*)(L + O_YO + ((32 * lb + 8 * q + 4 * hi + e) * 64 + 32 * pb + r32) * 4) = Y[4 * q + e] * fast_exp(al[e]); }
        }
        { const int nb = wave & 3, ph = wave >> 2; const float ac63 = *(const LAS float*)(L + O_ACS + 63 * 4);
#pragma unroll
          for (int r = 0; r < 16; ++r) ST[r] = 0.f;
#pragma unroll
          for (int ks = 0; ks < 4; ++ks) { const int l0 = 16 * ks + 8 * hi;
              const int ba = Lb + O_BN + l0 * SBN + (32 * nb) * 2 + trB; const bf16x8 af = tr_frag(ba, ba + 4 * SBN);
              const int xa = Lb + O_XD + l0 * SXD + (32 * ph) * 2 + trX; const bf16x8 xf = tr_frag(xa, xa + 4 * SXD);
              float fx[8]; unpack8(__builtin_bit_cast(u32x4, xf), fx);
              const f32x4 a0 = *(const LAS f32x4*)(L + O_ACS + l0 * 4), a1 = *(const LAS f32x4*)(L + O_ACS + (l0 + 4) * 4);
              u32x4 bw; bw.x = cvt_pk_bf16(fx[0] * fast_exp(ac63 - a0.x), fx[1] * fast_exp(ac63 - a0.y)); bw.y = cvt_pk_bf16(fx[2] * fast_exp(ac63 - a0.z), fx[3] * fast_exp(ac63 - a0.w));
              bw.z = cvt_pk_bf16(fx[4] * fast_exp(ac63 - a1.x), fx[5] * fast_exp(ac63 - a1.y)); bw.w = cvt_pk_bf16(fx[6] * fast_exp(ac63 - a1.z), fx[7] * fast_exp(ac63 - a1.w));
              ST = __builtin_amdgcn_mfma_f32_32x32x16_bf16(af, __builtin_bit_cast(bf16x8, bw), ST, 0, 0, 0); } }
        __syncthreads();
    }
    __syncthreads();
#undef SSD_LOAD
}
__device__ __forceinline__ void p_mla_ssd(Frame& F, const Args& a, unsigned* qctr, volatile LAS int* slot) {
    for (int it = F.bid; it < 64; it += F.G) ssd_item(F, a, it);
    if (F.G == TCONV_G && F.bid >= TCONV_FIRST && F.bid < TCONV_FIRST + TCONV_BLOCKS) { constexpr int RPB = (PEER_E + TCONV_BLOCKS - 1) / TCONV_BLOCKS; const int cb = F.bid - TCONV_FIRST;
        __syncthreads();
        p_layer0_late_weights(F, a, cb * 8 + F.wave, TCONV_BLOCKS * 8);
        p_layer1_weights(F, a, cb * 8 + F.wave, TCONV_BLOCKS * 8);
#pragma unroll 1
        for (int l = 0; l < 2; ++l) { const int rb = l * PEER_E + cb * RPB, re = rb + RPB < (l + 1) * PEER_E ? rb + RPB : (l + 1) * PEER_E; convert_table_rows(F, a, rb, re, F.wave, 8); }
        __syncthreads(); }
    const bf16_t* QM = WSP(bf16_t, WS_QM); const bf16_t* KM = WSP(bf16_t, WS_KM); const bf16_t* KV = WSP(bf16_t, WS_KV); bf16_t* MIX = WSP(bf16_t, WS_MIX);
    const float scale = 0.07216878364870322f;
#pragma unroll 1
    for (;;) {
        __syncthreads();
        if (F.tid == 0) *slot = (int)__hip_atomic_fetch_add(qctr, 1u, __ATOMIC_RELAXED, __HIP_MEMORY_SCOPE_AGENT);
        __syncthreads();
        const int idx = *slot;
        if (idx >= 512) break;
        const int qb = 15 - (idx >> 5), bh = idx & 31, b = bh >> 3, h = bh & 7, q0 = qb * 256; const size_t row0 = (size_t)b * SEQ + q0, kr0 = (size_t)b * SEQ;
        att::attn_unit<192, 128, true, false, 32>(F.lds, QM + row0 * 1536 + h * 192, 1536, KM + kr0 * 1536 + h * 192, 1536, KV + kr0 * 2048 + h * 256 + 128, 2048, MIX + row0 * 2048 + h * 128, 2048,
                                       4 * (qb + 1), q0, scale * 1.4426950408889634f, F.tid, a.in[21], WSP(f32x2, WS_ROPE32) + row0 * 32);
    }
}
__device__ __forceinline__ void p_ssd_norm(Frame& F, const Args& a) {
    const bf16_t* YG = WSP(bf16_t, WS_YG); bf16_t* MIX = WSP(bf16_t, WS_MIX); const float* gn = a.in[28] + F.lane * 8;
    for (int t = F.gw; t < TOK; t += F.NGW) { const bf16_t* p = YG + (size_t)t * 1024 + F.lane * 8;
        const u32x4 w0 = *(const u32x4*)p, w1 = *(const u32x4*)(p + 512); float f0[8], f1[8]; unpack8(w0, f0); unpack8(w1, f1); float s0 = 0.f, s1 = 0.f;
#pragma unroll
        for (int e = 0; e < 8; ++e) { s0 += f0[e] * f0[e]; s1 += f1[e] * f1[e]; }
        s0 = half_sum(s0); s1 = half_sum(s1);
        const float r0 = 1.0f / sqrtf(s0 * (1.f / 256.f) + EPS), r1 = 1.0f / sqrtf(s1 * (1.f / 256.f) + EPS);
        const f32x4 g00 = *(const f32x4*)gn, g01 = *(const f32x4*)(gn + 4), g10 = *(const f32x4*)(gn + 512), g11 = *(const f32x4*)(gn + 516);
        bf16_t* d = MIX + (size_t)t * 2048 + 1024 + F.lane * 8;
        *(u32x4*)d = pack8((f32x4){f0[0], f0[1], f0[2], f0[3]} * r0 * g00, (f32x4){f0[4], f0[5], f0[6], f0[7]} * r0 * g01);
        *(u32x4*)(d + 512) = pack8((f32x4){f1[0], f1[1], f1[2], f1[3]} * r1 * g10, (f32x4){f1[4], f1[5], f1[6], f1[7]} * r1 * g11); }
}
__device__ __forceinline__ void p_attn_mem(Frame& F, int layer, const pg8::StaticOrder& S) {
    const bf16_t* MQ = WSP(bf16_t, WS_MEMQ); const bf16_t* MKV = WSP(bf16_t, WS_MEMKV) + (size_t)layer * 1024 * 1024; bf16_t* MO = WSP(bf16_t, WS_MEMO);
    const float scale = 0.08838834764831845f;
    asm volatile("s_waitcnt vmcnt(0)" ::: "memory"); __builtin_amdgcn_fence(__ATOMIC_RELEASE, "workgroup"); __syncthreads(); __builtin_amdgcn_fence(__ATOMIC_ACQUIRE, "workgroup");
    pg8::Unit u;
#pragma unroll 1
    for (int i = 0; S.next(i, u); ++i) { const int h = u.pn, qb = u.pm & 15, b = u.pm >> 4; const size_t row0 = (size_t)b * SEQ + qb * 256;
        att::attn_unit<128, 128, false, true>(F.lds, MQ + row0 * 512 + h * 128, 512, MKV + (size_t)b * 256 * 1024 + h * 128, 1024, MKV + (size_t)b * 256 * 1024 + 512 + h * 128, 1024, MO + row0 * 512 + h * 128, 512,
                                              4, 0, scale * 1.4426950408889634f, (F.wave << 6) | lane_id()); }
}
__device__ __forceinline__ unsigned ordf(float x) { const unsigned u = __float_as_uint(x); return u ^ ((unsigned)((int)u >> 31) | 0x80000000u); }
__device__ __forceinline__ float unordf(unsigned k) { return __uint_as_float((k & 0x80000000u) ? (k ^ 0x80000000u) : ~k); }
#define TK_CS(a, b) do { const unsigned hi_ = (a) > (b) ? (a) : (b); const unsigned lo_ = (a) > (b) ? (b) : (a); (a) = hi_; (b) = lo_; } while (0)
__device__ __forceinline__ void tk_sort16(unsigned (&a)[16]) {
#pragma unroll
    for (int k = 2; k <= 16; k <<= 1)
#pragma unroll
        for (int j = k >> 1; j > 0; j >>= 1)
#pragma unroll
            for (int i = 0; i < 16; ++i) { const int l = i ^ j; if (l > i) { if ((i & k) == 0) TK_CS(a[i], a[l]); else TK_CS(a[l], a[i]); } }
}
__device__ __forceinline__ void tk_merge16(unsigned (&L)[16], const unsigned (&B)[16]) {
#pragma unroll
    for (int i = 0; i < 16; ++i) L[i] = L[i] > B[15 - i] ? L[i] : B[15 - i];
#pragma unroll
    for (int j = 8; j > 0; j >>= 1)
#pragma unroll
        for (int i = 0; i < 16; ++i) { const int l = i ^ j; if (l > i) TK_CS(L[i], L[l]); }
}
template <bool FUSED>
__device__ __forceinline__ void p_peer_topk(Frame& F, int layer, const pg8::StaticOrder& S, int part) {
    const bf16_t* PQ = WSP(bf16_t, WS_PQ); const bf16_t* KEYS = WSP(bf16_t, WS_KEYS) + (size_t)layer * 8 * 2 * 128 * 128; int* EXPo = WSP(int, WS_EXP); float* GATEo = WSP(float, WS_GATE);
    LAS float* sc = (LAS float*)(F.lds + F.wave * 16384);
    const bool u4 = (PEER_U4_MASK >> layer) & 1;
#pragma unroll 1
    for (int pass = 0; pass < (FUSED ? 1 : 2); ++pass) {
    if (FUSED ? (part == 0) : ((pass ^ (F.bid & 1)) == 0)) {
    u32x4 nx[4]; float nssq;
#define XQ_LOAD(tok) do { const bf16_t* xr_ = WSP(bf16_t, WS_XB) + (size_t)(tok) * 2048 + F.lane * 16; nx[0] = *(const u32x4*)xr_; nx[1] = *(const u32x4*)(xr_ + 8); nx[2] = *(const u32x4*)(xr_ + 1024); nx[3] = *(const u32x4*)(xr_ + 1032); \
        nssq = F.lane < 32 ? WSP(float, WS_SSQ2)[(size_t)(tok) * 32 + F.lane] : 0.f; } while (0)
    if (F.gw < TOK) XQ_LOAD(F.gw);
    for (int t = F.gw; t < TOK; t += F.NGW) { const int lane = F.lane; float f[32]; float mx = 0.f;
        const u32x4 cx0 = nx[0], cx1 = nx[1], cx2 = nx[2], cx3 = nx[3]; const float cssq = nssq;
        { const int tn = t + F.NGW < TOK ? t + F.NGW : t; XQ_LOAD(tn); }
        { float g8[8]; unpack8(cx0, g8);
#pragma unroll
            for (int j = 0; j < 8; ++j) f[j] = g8[j];
            unpack8(cx1, g8);
#pragma unroll
            for (int j = 0; j < 8; ++j) f[8 + j] = g8[j];
            unpack8(cx2, g8);
#pragma unroll
            for (int j = 0; j < 8; ++j) f[16 + j] = g8[j];
            unpack8(cx3, g8);
#pragma unroll
            for (int j = 0; j < 8; ++j) f[24 + j] = g8[j]; }
#pragma unroll
        for (int j = 0; j < 32; ++j) mx = fmaxf(mx, fabsf(f[j]));
        mx = wave_max(mx);
        const float qmax = u4 ? 119.f : 127.f;
        const float inv = mx > 0.f ? qmax / mx : 0.f;
#pragma unroll
        for (int c = 0; c < 2; ++c) { u32x4 w; unsigned* wp = (unsigned*)&w;
            if (!u4) {
#pragma unroll
                for (int q = 0; q < 4; ++q) { unsigned v = 0u;
#pragma unroll
                    for (int e = 0; e < 4; ++e) v |= (((unsigned)(int)__builtin_rintf(f[c * 16 + q * 4 + e] * inv)) & 0xffu) << (8 * e);
                    wp[q] = v; } }
            else {
#pragma unroll
                for (int j = 0; j < 2; ++j) { unsigned xh = 0u, xl = 0u;
#pragma unroll
                    for (int e = 0; e < 8; ++e) { const int qv = (int)__builtin_rintf(f[c * 16 + j * 8 + e] * inv); const int sh = 8 * (e & 3) + 4 * (e >> 2);
                        xl |= ((unsigned)qv & 15u) << sh; xh |= ((unsigned)((qv + 8) >> 4) & 15u) << sh; }
                    wp[2 * j] = xh; wp[2 * j + 1] = xl; } }
            if (!u4) *(u32x4*)(WSP(unsigned char, WS_XQ) + ((size_t)(c * 8 + (lane >> 3)) * TOK + t) * 128 + (lane & 7) * 16) = w;
            else *(u32x4*)(WSP(unsigned char, WS_XQ) + ((size_t)(c * 4 + (lane >> 4)) * TOK + t) * 256 + (lane & 15) * 16) = w;
        }
        const float ssq = wave_sum(cssq, lane);
        if (lane == 0) WSP(float, WS_XS)[t] = (mx / qmax) / sqrtf(ssq * (1.f / 2048.f) + EPS); }
#undef XQ_LOAD
    } else {
    pg8::Unit u;
    for (int idx = 0; ; ++idx) { int it;
        if (FUSED) { if (!S.next(idx, u)) break; it = (u.pm * 8 + F.wave) * 8 + u.pn; } else { it = F.gw + idx * F.NGW; if (it >= (TOK / 32) * 8) break; }
        int lane = lane_id(); asm volatile("" : "+v"(lane));
        const int r32 = lane & 31, hi = lane >> 5, h = it & 7, t0 = (it >> 3) * 32;
        unsigned KF[2][16];
#pragma unroll 1
        for (int p = 0; p < 2; ++p) {
            const bf16_t* qp = PQ + (size_t)(t0) * 2048 + h * 256 + p * 128; const int qo = r32 * 2048 + hi * 8; bf16x8 qf[8], af[8], an[8];
#pragma unroll
            for (int k = 0; k < 8; ++k) qf[k] = *(const bf16x8*)(qp + (qo + k * 16));
            const bf16_t* kp = KEYS + (size_t)(h * 2 + p) * 128 * 128; const int ko = r32 * 128 + hi * 8;
#pragma unroll
            for (int k = 0; k < 8; ++k) af[k] = *(const bf16x8*)(kp + (ko + k * 16));
            unsigned L[16];
#pragma unroll
            for (int i = 0; i < 16; ++i) L[i] = 0u;
#pragma unroll 1
            for (int nb = 0; nb < 4; ++nb) { f32x16 acc;
#pragma unroll
                for (int r = 0; r < 16; ++r) acc[r] = 0.f;
#pragma unroll
                for (int k = 0; k < 8; ++k) acc = __builtin_amdgcn_mfma_f32_32x32x16_bf16(af[k], qf[k], acc, 0, 0, 0);
                if (nb < 3) {
#pragma unroll
                    for (int k = 0; k < 8; ++k) an[k] = *(const bf16x8*)(kp + ((nb + 1) * 32 * 128 + ko + k * 16)); }
                const int nbase = 127 - (nb * 32 + 4 * hi); unsigned Bk[16];
#pragma unroll
                for (int r = 0; r < 16; ++r) Bk[r] = (ordf(acc[r]) & 0xFFFFFF80u) | (unsigned)(nbase - ((r & 3) + 8 * (r >> 2)));
                tk_sort16(Bk); tk_merge16(L, Bk);
#pragma unroll
                for (int k = 0; k < 8; ++k) af[k] = an[k];
            }
            unsigned P[16];
#pragma unroll
            for (int i = 0; i < 16; ++i) { auto sw_ = __builtin_amdgcn_permlane32_swap(L[i], L[i], false, false); P[i] = hi ? sw_[0] : sw_[1]; }
            tk_merge16(L, P);
            if (p == 0) {
#pragma unroll
                for (int i = 0; i < 16; ++i) KF[0][i] = L[i];
            } else {
#pragma unroll
                for (int i = 0; i < 16; ++i) KF[1][i] = L[i]; }
        }
        float s0[16], s1[16];
#pragma unroll
        for (int i = 0; i < 16; ++i) { s0[i] = unordf(KF[0][i] & 0xFFFFFF80u); s1[i] = unordf(KF[1][i] & 0xFFFFFF80u);
            sc[i * 64 + lane] = __int_as_float(127 - (int)(KF[0][i] & 127u)); sc[(16 + i) * 64 + lane] = __int_as_float(127 - (int)(KF[1][i] & 127u)); }
        unsigned Cn[16], Cb[16];
#define TK_CAND(i, j) ((ordf(s0[i] + s1[j]) & 0xFFFFFF00u) | (unsigned)(255 - ((i) * 16 + (j))))
        { int c = 0;
#pragma unroll
          for (int i = 0; i < 16; ++i)
#pragma unroll
              for (int j = 0; j < 16; ++j) if ((i + 1) * (j + 1) <= 16) { if (c < 16) Cn[c] = TK_CAND(i, j); ++c; } }
        tk_sort16(Cn);
#pragma unroll
        for (int grp = 1; grp < 4; ++grp) { int c = 0;
#pragma unroll
            for (int q = 0; q < 16; ++q) Cb[q] = 0u;
#pragma unroll
            for (int i = 0; i < 16; ++i)
#pragma unroll
                for (int j = 0; j < 16; ++j) if ((i + 1) * (j + 1) <= 16) { if (c >= grp * 16 && c < grp * 16 + 16) Cb[c - grp * 16] = TK_CAND(i, j); ++c; }
            tk_sort16(Cb); tk_merge16(Cn, Cb); }
#undef TK_CAND
        float bs[16]; int ex[16]; float mx = unordf(Cn[0] & 0xFFFFFF00u), sum = 0.f;
#pragma unroll
        for (int k = 0; k < 16; ++k) { const int c = 255 - (int)(Cn[k] & 255u); const int n0 = __float_as_int(sc[(c >> 4) * 64 + lane]), n1 = __float_as_int(sc[(16 + (c & 15)) * 64 + lane]);
            ex[k] = n0 * 128 + n1; bs[k] = fast_exp(unordf(Cn[k] & 0xFFFFFF00u) - mx); sum += bs[k]; }
        const float inv = 1.0f / sum;
        if (hi == 0) { int* ep = EXPo + (size_t)(t0 + r32) * 128 + h * 16; float* gp = GATEo + (size_t)(t0 + r32) * 128 + h * 16;
#pragma unroll
            for (int k = 0; k < 16; k += 4) { *(int4*)(ep + k) = make_int4(ex[k], ex[k + 1], ex[k + 2], ex[k + 3]); *(f32x4*)(gp + k) = (f32x4){bs[k] * inv, bs[k + 1] * inv, bs[k + 2] * inv, bs[k + 3] * inv}; } }
    }
    } }
}
#define UB0(x) ((float)((x) & 0xffu))
#define UB1(x) ((float)(((x) >> 8) & 0xffu))
#define UB2(x) ((float)(((x) >> 16) & 0xffu))
#define UB3(x) ((float)((x) >> 24))
template <bool U4> __device__ __forceinline__ void p_peer_u(Frame& F, int layer, unsigned* qbase) {
    const unsigned char* U8 = WSP(unsigned char, WS_U8) + (size_t)layer * PEER_E * 2048; const unsigned char* XQ = WSP(unsigned char, WS_XQ); const int* EXPi = WSP(int, WS_EXP); short* PD = WSP(short, WS_PD);
    const int xcc = (int)xb_xcc_id();
#pragma unroll 1
    for (int ri = 0; ri < (U4 ? 8 : 16); ++ri) {
        const int sl = U4 ? ((xcc + ri) & 7) : ((xcc + 8 * (ri & 1) + (ri >> 1)) & 15);
        const unsigned char* Us = U8 + (size_t)sl * PEER_E * 128; const unsigned char* Xs = XQ + (size_t)sl * TOK * (U4 ? 256 : 128); short* PDs = PD + (size_t)sl * TOK * 128;
#pragma unroll 1
        for (;;) {
            int lane = lane_id(); asm volatile("" : "+v"(lane));
            int chunk = 0; if (lane == 0) chunk = (int)__hip_atomic_fetch_add(qbase + sl * 64, 1u, __ATOMIC_RELAXED, __HIP_MEMORY_SCOPE_AGENT);
            chunk = __builtin_amdgcn_readfirstlane(chunk);
            if (chunk >= TOK / 32) break;
            const int r = lane >> 3, c = lane & 7; const bool c4 = c & 4, c2 = c & 2, c1 = c & 1;
            u32x4 R[2][16], E[2][4], X[2][2]; const size_t t0_ = (size_t)chunk * 32, tl_ = t0_ + 31;
#define U_EXP(dst, tok) do { const int* ep_ = EXPi + (tok) * 128 + 8 * r; dst[0] = *(const u32x4*)ep_; dst[1] = *(const u32x4*)(ep_ + 4); dst[2] = *(const u32x4*)(ep_ + 64); dst[3] = *(const u32x4*)(ep_ + 68); } while (0)
#define U_XLD(dst, tok) do { if constexpr (U4) { dst[0] = *(const u32x4*)(Xs + ((tok) * 256 + c * 32)); dst[1] = *(const u32x4*)(Xs + ((tok) * 256 + c * 32 + 16)); } else { dst[0] = *(const u32x4*)(Xs + ((tok) * 128 + c * 16)); dst[1] = dst[0]; } } while (0)
#define U_GATHER(Rd, Es) do { _Pragma("unroll") for (int g = 0; g < 16; ++g) { const unsigned ek = Es[g >> 2][g & 3]; Rd[g] = *(const u32x4*)(Us + (unsigned)(ek * 128u + (unsigned)(c * 16))); } } while (0)
#define U4_LO(w, xl) d = __builtin_amdgcn_sdot8((int)(w), (int)(xl), d, false)
#define U4_HI(w, xh) dh = __builtin_amdgcn_sdot8((int)(w), (int)(xh), dh, false)
#define U_TOKEN(P, TI) do { const size_t t = t0_ + (TI); const size_t t2 = t + 2 < tl_ ? t + 2 : tl_, t3 = t + 3 < tl_ ? t + 3 : tl_; \
                U_GATHER(R[(P) ^ 1], E[(P) ^ 1]); U_EXP(E[(P) ^ 1], t3); \
                int part[16]; \
                _Pragma("unroll") for (int g = 0; g < 16; ++g) { \
                    if constexpr (U4) { int dh = 0;        \
                        U4_HI(R[P][g].x, X[P][0].x); U4_HI(R[P][g].y, X[P][0].z); U4_HI(R[P][g].z, X[P][1].x); U4_HI(R[P][g].w, X[P][1].z); \
                        int d = dh << 4;        \
                        U4_LO(R[P][g].x, X[P][0].y); U4_LO(R[P][g].y, X[P][0].w); U4_LO(R[P][g].z, X[P][1].y); U4_LO(R[P][g].w, X[P][1].w); \
                        part[g] = d; } \
                    else { int d = __builtin_amdgcn_sdot4((int)R[P][g].x, (int)X[P][0].x, 0, false); d = __builtin_amdgcn_sdot4((int)R[P][g].y, (int)X[P][0].y, d, false); \
                        d = __builtin_amdgcn_sdot4((int)R[P][g].z, (int)X[P][0].z, d, false); part[g] = __builtin_amdgcn_sdot4((int)R[P][g].w, (int)X[P][0].w, d, false); } } \
                U_XLD(X[P], t2);        \
                  \
                _Pragma("unroll") for (int hh = 0; hh < 2; ++hh) { int q4[4], q2[2]; \
                    _Pragma("unroll") for (int i = 0; i < 4; ++i) q4[i] = (c4 ? part[8 * hh + 4 + i] : part[8 * hh + i]) + __builtin_amdgcn_update_dpp(0, c4 ? part[8 * hh + i] : part[8 * hh + 4 + i], 0x141, 0xf, 0xf, false);        \
                    _Pragma("unroll") for (int i = 0; i < 2; ++i) q2[i] = (c2 ? q4[2 + i] : q4[i]) + __builtin_amdgcn_update_dpp(0, c2 ? q4[i] : q4[2 + i], 0x4E, 0xf, 0xf, false);        \
                    const int q1 = (c1 ? q2[1] : q2[0]) + __builtin_amdgcn_update_dpp(0, c1 ? q2[0] : q2[1], 0xB1, 0xf, 0xf, false);        \
                    const int qs = (q1 + 2) >> 2; PDs[t * 128 + 64 * hh + lane] = (short)(qs > 32767 ? 32767 : (qs < -32767 ? -32767 : qs)); }        \
            } while (0)
            U_EXP(E[0], t0_); U_EXP(E[1], t0_ + 1); U_XLD(X[0], t0_); U_XLD(X[1], t0_ + 1);
            U_GATHER(R[0], E[0]); U_EXP(E[0], t0_ + 2);
#pragma unroll 1
            for (int ti = 0; ti < 32; ti += 2) { U_TOKEN(0, ti); U_TOKEN(1, ti + 1); }
#undef U_TOKEN
#undef U4_LO
#undef U4_HI
#undef U_GATHER
#undef U_XLD
        }
    }
}
#undef U_EXP
__device__ __forceinline__ void p_peer_fin(Frame& F, int layer) {
    const float* USC = WSP(float, WS_TSC) + (size_t)layer * PEER_E; const float* VSC = WSP(float, WS_TSC) + (size_t)(2 + layer) * PEER_E;
    const short* PD = WSP(short, WS_PD); const float* XS = WSP(float, WS_XS); const int* EXPi = WSP(int, WS_EXP); const float* GATEi = WSP(float, WS_GATE);
    const bool u4 = (PEER_U4_MASK >> layer) & 1;
    for (int tb = F.gw; tb < TOK; tb += 2 * F.NGW) { const int lane = F.lane; const bool two = tb + F.NGW < TOK; int tt[2] = {tb, two ? tb + F.NGW : tb};
        int s0[2] = {0, 0}, s1[2] = {0, 0}, e0[2], e1[2]; float g0[2], g1[2], xs[2];
#pragma unroll
        for (int u = 0; u < 2; ++u) { const int t = tt[u];
            if (!u4) {
#pragma unroll
                for (int s = 0; s < 16; ++s) { s0[u] += PD[((size_t)s * TOK + t) * 128 + lane]; s1[u] += PD[((size_t)s * TOK + t) * 128 + 64 + lane]; } }
            else {
#pragma unroll
                for (int s = 0; s < 8; ++s) { s0[u] += PD[((size_t)s * TOK + t) * 128 + lane]; s1[u] += PD[((size_t)s * TOK + t) * 128 + 64 + lane]; } }
            e0[u] = EXPi[(size_t)t * 128 + lane]; e1[u] = EXPi[(size_t)t * 128 + 64 + lane]; xs[u] = XS[t]; g0[u] = GATEi[(size_t)t * 128 + lane]; g1[u] = GATEi[(size_t)t * 128 + 64 + lane]; }
        float w0[2], w1[2];
#pragma unroll
        for (int u = 0; u < 2; ++u) { w0[u] = gelu_f((float)s0[u] * 4.f * USC[e0[u]] * xs[u]) * g0[u] * VSC[e0[u]]; w1[u] = gelu_f((float)s1[u] * 4.f * USC[e1[u]] * xs[u]) * g1[u] * VSC[e1[u]]; }
#pragma unroll
        for (int u = 0; u < 2; ++u) { if (u == 1 && !two) break; const int t = tt[u];
            float mx = fmaxf(fabsf(w0[u]), fabsf(w1[u]));
            mx = wave_max(mx);
            const float inv = mx > 0.f ? 127.f / mx : 0.f;
            const int q0 = (int)__builtin_rintf(w0[u] * inv), q1 = (int)__builtin_rintf(w1[u] * inv);
            if ((PEER_V4_MASK >> layer) & 1) { int sw = q0 + q1;
                sw = wave_sum_i(sw);
                if (lane == 0) WSP(int, WS_SW)[t] = sw; }
            int* pw = WSP(int, WS_PW) + (size_t)t * 128; pw[lane] = (e0[u] << 8) | (q0 & 0xff); pw[64 + lane] = (e1[u] << 8) | (q1 & 0xff);
            if (lane == 0) WSP(float, WS_PWS)[t] = mx * (1.f / 127.f); } }
}
#define V_PW(dst, tok) do { const int* pp_ = PWq + (tok) * 128 + 16 * r; dst[0] = *(const u32x4*)pp_; dst[1] = *(const u32x4*)(pp_ + 4); dst[2] = *(const u32x4*)(pp_ + 8); dst[3] = *(const u32x4*)(pp_ + 12); } while (0)
__device__ __forceinline__ void p_peer_v(Frame& F, const Args& a, int layer, bool next_stats, unsigned* qbase, float fac) {
    const unsigned char* V8 = WSP(unsigned char, WS_V8) + (size_t)layer * PEER_E * 2048; const int* PWq = WSP(int, WS_PW); const float* PWS = WSP(float, WS_PWS); float* out = a.out;
    const int xcc = (int)xb_xcc_id();
#pragma unroll 1
    for (int ri = 0; ri < 16; ++ri) {
        const int sl = (xcc + 8 * (ri & 1) + (ri >> 1)) & 15;
        const unsigned char* Vs = V8 + (size_t)sl * PEER_E * 128;
#pragma unroll 1
        for (;;) {
            int lane = lane_id(); asm volatile("" : "+v"(lane));
            int chunk = 0; if (lane == 0) chunk = (int)__hip_atomic_fetch_add(qbase + sl * 64, 1u, __ATOMIC_RELAXED, __HIP_MEMORY_SCOPE_AGENT);
            chunk = __builtin_amdgcn_readfirstlane(chunk);
            if (chunk >= TOK / 32) break;
            const int r = lane >> 3, c = lane & 7; const bool b5 = lane & 32, b4 = lane & 16, b3 = lane & 8;
            u32x4 wn[4]; float wsn;
            { const size_t t_ = (size_t)chunk * 32; V_PW(wn, t_); wsn = PWS[t_]; }
#pragma unroll 1
            for (int ti = 0; ti < 32; ++ti) {
                const size_t t = (size_t)chunk * 32 + ti; const u32x4 w0 = wn[0], w1 = wn[1], w2 = wn[2], w3 = wn[3]; const float ws = wsn;
                if (ti + 1 < 32) { V_PW(wn, t + 1); wsn = PWS[t + 1]; }
                unsigned* xp = (unsigned*)(WSP(bf16_t, WS_XB) + t * 2048 + (sl * 128 + c * 16 + r * 2)); const unsigned xw = *xp; const f32x2 o0 = {bf_lo(xw), bf_hi(xw)};
                u32x4 R[16]; int wk[16];
#pragma unroll
                for (int g = 0; g < 16; ++g) { const u32x4 wv = g < 4 ? w0 : (g < 8 ? w1 : (g < 12 ? w2 : w3)); wk[g] = (int)wv[g & 3];
                    R[g] = *(const u32x4*)(Vs + (unsigned)((((unsigned)wk[g] >> 8) * 128u) + (unsigned)(c * 16))); }
                int acc[16];
#pragma unroll
                for (int i = 0; i < 16; ++i) acc[i] = 0;
#pragma unroll
                for (int j = 0; j < 4; ++j) {
                    const unsigned W = ((unsigned)wk[4 * j] & 0xffu) | (((unsigned)wk[4 * j + 1] & 0xffu) << 8) | (((unsigned)wk[4 * j + 2] & 0xffu) << 16) | ((unsigned)wk[4 * j + 3] << 24);
#pragma unroll
                    for (int d = 0; d < 4; ++d) { const unsigned ra = ((const unsigned*)&R[4 * j])[d], rb = ((const unsigned*)&R[4 * j + 1])[d], rc = ((const unsigned*)&R[4 * j + 2])[d], rd = ((const unsigned*)&R[4 * j + 3])[d];
                        const unsigned ablo = __builtin_amdgcn_perm(rb, ra, 0x05010400u), abhi = __builtin_amdgcn_perm(rb, ra, 0x07030602u), cdlo = __builtin_amdgcn_perm(rd, rc, 0x05010400u), cdhi = __builtin_amdgcn_perm(rd, rc, 0x07030602u);
                        const unsigned t0 = __builtin_amdgcn_perm(cdlo, ablo, 0x05040100u), t1 = __builtin_amdgcn_perm(cdlo, ablo, 0x07060302u), t2 = __builtin_amdgcn_perm(cdhi, abhi, 0x05040100u), t3 = __builtin_amdgcn_perm(cdhi, abhi, 0x07060302u);
                        acc[4 * d] = __builtin_amdgcn_sdot4((int)t0, (int)W, acc[4 * d], false); acc[4 * d + 1] = __builtin_amdgcn_sdot4((int)t1, (int)W, acc[4 * d + 1], false);
                        acc[4 * d + 2] = __builtin_amdgcn_sdot4((int)t2, (int)W, acc[4 * d + 2], false); acc[4 * d + 3] = __builtin_amdgcn_sdot4((int)t3, (int)W, acc[4 * d + 3], false); }
                }
                int a8[8], a4[4], a2[2];
#pragma unroll
                for (int i = 0; i < 8; ++i) a8[i] = rs_bit5(acc[i], acc[8 + i]);
#pragma unroll
                for (int i = 0; i < 4; ++i) a4[i] = rs_bit4(a8[i], a8[4 + i]);
#pragma unroll
                for (int i = 0; i < 2; ++i) a2[i] = rs_bit3(a4[i], a4[2 + i], b3);
                const int s0 = a2[0], s1 = a2[1];
                const float sc = ws * fac; const f32x2 nv = {o0.x + (float)s0 * sc, o0.y + (float)s1 * sc};
                if (!next_stats) { if (fac != 0.f) *(f32x2*)(out + t * 2048 + (sl * 128 + c * 16 + r * 2)) = nv; }
                else { *xp = cvt_pk_bf16(nv.x, nv.y);
                    const float ssq = wave_sum(nv.x * nv.x + nv.y * nv.y, lane); if (lane < 2) WSP(float, WS_SSQ1)[t * 32 + 2 * sl + lane] = lane == 0 ? ssq : 0.f; }
            }
        }
    }
}
__device__ __forceinline__ void p_peer_v4(Frame& F, const Args& a, int layer, bool next_stats, unsigned* qbase, float fac) {
    const unsigned char* V8 = WSP(unsigned char, WS_V8) + (size_t)layer * PEER_E * 2048; const int* PWq = WSP(int, WS_PW); const float* PWS = WSP(float, WS_PWS); const int* SW = WSP(int, WS_SW); float* out = a.out;
    const int xcc = (int)xb_xcc_id();
#pragma unroll 1
    for (int ri = 0; ri < 8; ++ri) {
        const int sl = (xcc + ri) & 7;
        const unsigned char* Vs = V8 + (size_t)sl * PEER_E * 128;
#pragma unroll 1
        for (;;) {
            int lane = lane_id(); asm volatile("" : "+v"(lane));
            int chunk = 0; if (lane == 0) chunk = (int)__hip_atomic_fetch_add(qbase + sl * 64, 1u, __ATOMIC_RELAXED, __HIP_MEMORY_SCOPE_AGENT);
            chunk = __builtin_amdgcn_readfirstlane(chunk);
            if (chunk >= TOK / 32) break;
            const int r = lane >> 3, c = lane & 7; const bool b5 = lane & 32, b4 = lane & 16, b3 = lane & 8;
            u32x4 wn[4]; float wsn; int swn;
            { const size_t t_ = (size_t)chunk * 32; V_PW(wn, t_); wsn = PWS[t_]; swn = SW[t_]; }
#pragma unroll 1
            for (int ti = 0; ti < 32; ++ti) {
                const size_t t = (size_t)chunk * 32 + ti; const u32x4 w0 = wn[0], w1 = wn[1], w2 = wn[2], w3 = wn[3]; const float ws = wsn; const int sw8 = 8 * swn;
                if (ti + 1 < 32) { V_PW(wn, t + 1); wsn = PWS[t + 1]; swn = SW[t + 1]; }
                unsigned* xp = (unsigned*)(WSP(bf16_t, WS_XB) + t * 2048 + (sl * 256 + c * 32 + 8 * (r >> 1) + 2 * (r & 1))); u32x2 xw; xw.x = xp[0]; xw.y = xp[2];
                u32x4 R[16]; int wk[16];
#pragma unroll
                for (int g = 0; g < 16; ++g) { const u32x4 wv = g < 4 ? w0 : (g < 8 ? w1 : (g < 12 ? w2 : w3)); wk[g] = (int)wv[g & 3];
                    R[g] = *(const u32x4*)(Vs + (unsigned)((((unsigned)wk[g] >> 8) * 128u) + (unsigned)(c * 16))); }
                int acc[32];
#pragma unroll
                for (int i = 0; i < 32; ++i) acc[i] = 0;
#pragma unroll
                for (int j = 0; j < 4; ++j) {
                    const unsigned W = ((unsigned)wk[4 * j] & 0xffu) | (((unsigned)wk[4 * j + 1] & 0xffu) << 8) | (((unsigned)wk[4 * j + 2] & 0xffu) << 16) | ((unsigned)wk[4 * j + 3] << 24);
#pragma unroll
                    for (int d = 0; d < 4; ++d) { const unsigned ra = ((const unsigned*)&R[4 * j])[d], rb = ((const unsigned*)&R[4 * j + 1])[d], rc = ((const unsigned*)&R[4 * j + 2])[d], rd = ((const unsigned*)&R[4 * j + 3])[d];
                        const unsigned ablo = __builtin_amdgcn_perm(rb, ra, 0x05010400u), abhi = __builtin_amdgcn_perm(rb, ra, 0x07030602u), cdlo = __builtin_amdgcn_perm(rd, rc, 0x05010400u), cdhi = __builtin_amdgcn_perm(rd, rc, 0x07030602u);
                        const unsigned t0 = __builtin_amdgcn_perm(cdlo, ablo, 0x05040100u), t1 = __builtin_amdgcn_perm(cdlo, ablo, 0x07060302u), t2 = __builtin_amdgcn_perm(cdhi, abhi, 0x05040100u), t3 = __builtin_amdgcn_perm(cdhi, abhi, 0x07060302u);
                        const int b = 8 * d;
#define V4_COL(tt, i) acc[b + 2 * (i)] = __builtin_amdgcn_sdot4((int)(tt), (int)W, acc[b + 2 * (i)], false); acc[b + 2 * (i) + 1] = __builtin_amdgcn_sdot4((int)((tt) & 0xF0F0F0F0u), (int)W, acc[b + 2 * (i) + 1], false)
                        V4_COL(t0, 0); V4_COL(t1, 1); V4_COL(t2, 2); V4_COL(t3, 3);
#undef V4_COL
                    }
                }
                int a16[16], a8[8], a4[4];
#pragma unroll
                for (int i = 0; i < 16; ++i) a16[i] = rs_bit5(acc[i], acc[16 + i]);
#pragma unroll
                for (int i = 0; i < 8; ++i) a8[i] = rs_bit4(a16[i], a16[8 + i]);
#pragma unroll
                for (int i = 0; i < 4; ++i) a4[i] = rs_bit3(a8[i], a8[4 + i], b3);

                const float sc = ws * fac; f32x4 nv;
                const int lo0 = a4[0] - a4[1] - sw8, hi0 = a4[1] >> 4, lo1 = a4[2] - a4[3] - sw8, hi1 = a4[3] >> 4;
                nv.x = bf_lo(xw.x) + (float)lo0 * sc; nv.y = bf_hi(xw.x) + (float)lo1 * sc; nv.z = bf_lo(xw.y) + (float)hi0 * sc; nv.w = bf_hi(xw.y) + (float)hi1 * sc;
                if (!next_stats) { if (fac != 0.f) { float* op = out + t * 2048 + (sl * 256 + c * 32 + 8 * (r >> 1) + 2 * (r & 1)); *(f32x2*)op = (f32x2){nv.x, nv.y}; *(f32x2*)(op + 4) = (f32x2){nv.z, nv.w}; } }
                else { xp[0] = cvt_pk_bf16(nv.x, nv.y); xp[2] = cvt_pk_bf16(nv.z, nv.w);
                    const float ssq = wave_sum((nv.x * nv.x + nv.y * nv.y) + (nv.z * nv.z + nv.w * nv.w), lane); if (lane < 4) WSP(float, WS_SSQ1)[t * 32 + 4 * sl + lane] = lane == 0 ? ssq : 0.f; }
            }
        }
    }
}
__device__ __forceinline__ void p_diff_prep(Frame& F, const Args& a) {
    const f32x2* R64 = WSP(f32x2, WS_ROPE64); const int lane = F.lane, d0 = (lane & 15) * 8; const float* gn = a.in[32] + d0;
    for (int t = F.gw; t < TOK; t += F.NGW) {
        u32x4 raw[4]; f32x2 cs[8]; bf16_t* base = WSP(bf16_t, WS_KD) + (size_t)t * 2048;
#pragma unroll
        for (int i = 0; i < 4; ++i) raw[i] = *(const u32x4*)(base + (lane + 64 * i) * 8);
#pragma unroll
        for (int e = 0; e < 8; ++e) cs[e] = R64[(size_t)t * 64 + (lane & 7) * 8 + e];
#pragma unroll
        for (int i = 0; i < 4; ++i) { bf16_t* p = base + (lane + 64 * i) * 8; float f[8]; unpack8(raw[i], f); float s = 0.f;
#pragma unroll
            for (int e = 0; e < 8; ++e) s += f[e] * f[e];
            s = row16_sum(s);
            const float rs = 1.0f / sqrtf(s * (1.f / 128.f) + EPS); float o[8];
#pragma unroll
            for (int e = 0; e < 8; ++e) f[e] *= rs * gn[e];
#pragma unroll
            for (int e = 0; e < 8; ++e) { const float pv = dppf<0x128>(f[e]); o[e] = (lane & 8) ? f[e] * cs[e].x + pv * cs[e].y : f[e] * cs[e].x - pv * cs[e].y; }
            u32x4 pk; pk.x = cvt_pk_bf16(o[0], o[1]); pk.y = cvt_pk_bf16(o[2], o[3]); pk.z = cvt_pk_bf16(o[4], o[5]); pk.w = cvt_pk_bf16(o[6], o[7]); *(u32x4*)p = pk; }
    }
}
__device__ __forceinline__ void p_attn_diff(Frame& F, const Args& a) {
    const bf16_t* QD = WSP(bf16_t, WS_QD); const bf16_t* KD = WSP(bf16_t, WS_KD); const bf16_t* VD = WSP(bf16_t, WS_VD); bf16_t* OD = WSP(bf16_t, WS_OD); bf16_t* MIX = WSP(bf16_t, WS_MIX);
    const float scale = 0.08838834764831845f;
    const float lam_init = 0.8f - 0.6f * 0.7408182206817179f;
    for (int it = F.bid; it < 256; it += F.G) {
        const int x = it & 7, y = it >> 3, pairidx = y & 7, bh = x * 4 + (y >> 3), h = bh & 7, b = bh >> 3;
#pragma unroll 1
        for (int s = 0; s < 4; ++s) { const int qb = (s >> 1) ? pairidx : 15 - pairidx, m = s & 1, q0 = qb * 256; const size_t row0 = (size_t)b * SEQ + q0, kr0 = (size_t)b * SEQ;
            float lam = 0.f;
            if (m) { const int ln = lane_id(); const float d1 = wave_sum(a.in[33][ln] * a.in[34][ln] + a.in[33][64 + ln] * a.in[34][64 + ln], ln), d2 = wave_sum(a.in[35][ln] * a.in[36][ln] + a.in[35][64 + ln] * a.in[36][64 + ln], ln);
                     lam = expf(d1) - expf(d2) + lam_init; }
            att::attn_unit<128, 256, true, false, 64, true>(F.lds, QD + row0 * 2048 + h * 256 + m * 128, 2048, KD + kr0 * 2048 + h * 256 + m * 128, 2048, VD + kr0 * 2048 + h * 256, 2048,
                                           OD + row0 * 4096 + h * 512 + m * 256, 4096, 4 * (qb + 1), q0, scale * 1.4426950408889634f, (F.wave << 6) | lane_id(), a.in[31], WSP(f32x2, WS_ROPE64) + row0 * 64,
                                           OD + row0 * 4096 + h * 512, MIX + row0 * 2048 + h * 256, 2048, lam, a.in[37], 1.0f - lam_init); }
    }
}

constexpr int PH_LAST = 35;
__global__ void __launch_bounds__(NTHREADS, 2) mega_fwd(Args args) {
    extern __shared__ __attribute__((aligned(16))) unsigned char lds_raw[];
    Frame F;
    F.lds = (LAS unsigned char*)lds_raw; F.tid = threadIdx.x; F.lane = F.tid & 63; F.wave = __builtin_amdgcn_readfirstlane(F.tid >> 6);
    F.G = gridDim.x; F.bid = blockIdx.x; F.gw = F.bid * NWAVES + F.wave; F.NGW = F.G * NWAVES; F.ws = (GAS unsigned char*)args.ws;
    volatile LAS unsigned* MISC = (volatile LAS unsigned*)(F.lds + MISC_OFF);
    if (F.tid < 64) MISC[F.tid] = 0u;
    __syncthreads();
    const int lo = args.ph_lo, hi = args.ph_hi;
    XcdBarrier bar; bar.bar = (unsigned*)(F.ws + WS_CTL) + CW_BAR; bar.x = 0; bar.st = nullptr;
    if (hi - lo > 1) bar = xcd_barrier_post((unsigned*)(F.ws + WS_CTL) + CW_BAR, MISC + 8);
#ifdef ONLY
#define IN(k) ((k) == ONLY && lo <= (k) && (k) < hi)
#else
#define IN(k) (lo <= (k) && (k) < hi)
#endif
#define SEAM(k) do { if (IN((k) + 1)) { XcdBarrier bb_ = bar; unsigned* b_ = bar.bar; asm volatile("" : "+s"(b_)); bb_.bar = (unsigned*)(GAS unsigned*)b_; xcd_barrier(bb_, ((F.wave << 6) | lane_id()) == 0); } } while (0)
#define REFRESH() do { int t_ = (F.wave << 6) | lane_id(); asm volatile("" : "+v"(t_)); F.tid = t_; F.lane = t_ & 63; unsigned char* w_ = args.ws; asm volatile("" : "+s"(w_)); F.ws = (GAS unsigned char*)w_; } while (0)
#define GEMM_STORE(Ap, Bp, Mv, Nv, Kv, Op, ldcv, rs, scv, ssv, invn, slotsv) do { pg8::Gemm g_{Ap, Bp, Mv, Nv, Kv}; pg8::StaticOrder S_; S_.init(Mv, Nv, F.G, F.bid); pg8::EpiStore E_{Op, ldcv, rs, scv, ssv, invn, slotsv}; \
        pg8::gemm_phase<pg8::EpiStore, pg8::StaticOrder, true, true>(F.lds, g_, S_, E_, F.tid); } while (0)
#define GEMM_RESID(Ap, Bp, Kv, ssqp) do { pg8::Gemm g_{Ap, Bp, TOK, DM, Kv}; pg8::StaticOrder S_; S_.init(TOK, DM, F.G, F.bid); pg8::EpiResid E_{WSP(bf16_t, WS_XB), dry ? nullptr : (ssqp), fac}; \
        pg8::gemm_phase<pg8::EpiResid, pg8::StaticOrder, true, true>(F.lds, g_, S_, E_, F.tid); } while (0)
#ifndef REPEAT_MASK
#define REPEAT_MASK 0ull
#endif
#define PHASE(k, ...) if (IN(k)) { REFRESH(); { const float fac = 1.f; const bool dry = false; (void)fac; (void)dry; __VA_ARGS__ } \
        if ((REPEAT_MASK >> ((k) > 24 ? (k) - 16 : (k))) & 1ull) { const float fac = 0.f; const bool dry = true; (void)fac; (void)dry; __VA_ARGS__ } SEAM(k); }
    PHASE(0, p_prologue(F, args);)
    PHASE(1,
        { pg8::Gemm g{WSP(bf16_t, WS_XB), WSP(bf16_t, WS_WIN), TOK, 4096, 2048}; pg8::StaticOrder S; S.init(TOK, 4096, F.G, F.bid);
          pg8::EpiWin E{WSP(bf16_t, WS_CQ), WSP(bf16_t, WS_CKV), WSP(bf16_t, WS_Z), WSP(bf16_t, WS_XBC), WSP(float, WS_TAIL), WSP(float, WS_RSTD)};
          pg8::gemm_phase<pg8::EpiWin, pg8::StaticOrder, true, true>(F.lds, g, S, E, F.tid); })
    PHASE(2,
        { pg8::Gemm g{WSP(bf16_t, WS_XB), WSP(bf16_t, WS_WIN) + (size_t)4096 * 2048, TOK, 256, 2048}; pg8::StaticOrder S; S.init(TOK, 256, F.G, F.bid);
          pg8::EpiTail E{{WSP(bf16_t, WS_CQ), WSP(bf16_t, WS_CKV), WSP(bf16_t, WS_Z), WSP(bf16_t, WS_XBC), WSP(float, WS_TAIL), WSP(float, WS_RSTD)}};
          pg8::gemm_phase<pg8::EpiTail, pg8::StaticOrder, true, true>(F.lds, g, S, E, F.tid); }
        _Pragma("unroll 1")
        for (int l = 0; l < 2; ++l) { pg8::Gemm g{WSP(bf16_t, WS_MEMB), WSP(bf16_t, WS_WMEMKV) + (size_t)l * 1024 * 2048, 1024, 1024, 2048}; pg8::StaticOrder S; S.init(1024, 1024, F.G, (F.bid + 2 * F.G - 64 - 16 * l) % F.G);
          pg8::EpiStore E{WSP(bf16_t, WS_MEMKV) + (size_t)l * 1024 * 1024, 1024, WSP(float, WS_RSTD_MEM), 0, 0, 1.f / 2048.f, false};
          pg8::gemm_phase<pg8::EpiStore, pg8::StaticOrder, true, true>(F.lds, g, S, E, F.tid); }
        if (!dry) { const int first = F.G > 96 ? 96 : 0; if (F.bid >= first) p_prepA(F, args, F.bid - first, F.G - first); })
    PHASE(3,
        GEMM_STORE(WSP(bf16_t, WS_CQ), WSP(bf16_t, WS_WUQ), TOK, 1536, 512, WSP(bf16_t, WS_QM), 1536, WSP(float, WS_RSTD_CQ), 0, 0, 0.f, false);
        { pg8::Gemm g_{WSP(bf16_t, WS_CKV), WSP(bf16_t, WS_WUKV), TOK, 2048, 512}; pg8::StaticOrder S_; S_.init(TOK, 2048, F.G, F.bid); pg8::EpiStore E_{WSP(bf16_t, WS_KV), 2048, WSP(float, WS_RSTD_CKV), 0, 0, 0.f, false};
          pg8::gemm_phase<pg8::EpiStore, pg8::StaticOrder, true, true>(F.lds, g_, S_, E_, F.tid);
          if (!dry) {
              asm volatile("s_waitcnt vmcnt(0)" ::: "memory"); __builtin_amdgcn_fence(__ATOMIC_RELEASE, "workgroup"); __syncthreads(); __builtin_amdgcn_fence(__ATOMIC_ACQUIRE, "workgroup");
              pg8::Unit u_;
              _Pragma("unroll 1") for (int i_ = 0; S_.next(i_, u_); ++i_) p_prepB_tile(F, args, u_.pm, u_.pn);
              p_prep_late(F, args); } })
    PHASE(5, if (!dry) p_mla_ssd(F, args, (unsigned*)(F.ws + WS_CTL) + 64, (volatile LAS int*)(F.lds + MISC_OFF + 128));)
    PHASE(7, p_ssd_norm(F, args);)
    PHASE(8, GEMM_RESID(WSP(bf16_t, WS_MIX), WSP(bf16_t, WS_WOUT), 2048, WSP(float, WS_SSQ1));)
#pragma unroll 1
    for (int layer = 0; layer < 2; ++layer) {
        const int pb = layer ? 25 : 9;
        if (layer == 1) {
            PHASE(20, GEMM_STORE(WSP(bf16_t, WS_XB), WSP(bf16_t, WS_WQKV), TOK, 6144, 2048, WSP(bf16_t, WS_QD), 2048, WSP(float, WS_SSQ1), 2048, (size_t)TOK * 2048, 1.f / 2048.f, true);)
            PHASE(21, if (!dry) p_diff_prep(F, args);)
            PHASE(22, p_attn_diff(F, args);)
            PHASE(24, GEMM_RESID(WSP(bf16_t, WS_MIX), WSP(bf16_t, WS_WO), 2048, WSP(float, WS_SSQ1));)
        }
        PHASE(pb + 1,
                      { pg8::Gemm g_{WSP(bf16_t, WS_XB), WSP(bf16_t, WS_WMEMQ) + (size_t)layer * 512 * 2048, TOK, 512, 2048}; pg8::StaticOrder S_; S_.init(TOK, 2 * 512, F.G, F.bid);
                        pg8::EpiStore E_{WSP(bf16_t, WS_MEMQ), 512, WSP(float, WS_SSQ1), 0, 0, 1.f / 2048.f, true, true};
                        pg8::gemm_phase<pg8::EpiStore, pg8::StaticOrder, true, true, true>(F.lds, g_, S_, E_, F.tid);
                        p_attn_mem(F, layer, S_); })
        PHASE(pb + 4, GEMM_RESID(WSP(bf16_t, WS_MEMO), WSP(bf16_t, WS_WMEMO) + (size_t)layer * 2048 * 512, 512, WSP(float, WS_SSQ2));)
        PHASE(pb + 6,
                      { pg8::Gemm g_{WSP(bf16_t, WS_XB), WSP(bf16_t, WS_WPEERQ) + (size_t)layer * 2048 * 2048, TOK, 2048, 2048}; pg8::StaticOrder S_; S_.init(TOK, 2048, F.G, F.bid);
                        pg8::EpiStore E_{WSP(bf16_t, WS_PQ), 2048, WSP(float, WS_SSQ2), 0, 0, 1.f / 2048.f, true};
                        pg8::gemm_phase<pg8::EpiStore, pg8::StaticOrder, true, true>(F.lds, g_, S_, E_, F.tid);
                        asm volatile("s_waitcnt vmcnt(0)" ::: "memory"); __builtin_amdgcn_fence(__ATOMIC_RELEASE, "workgroup"); __syncthreads(); __builtin_amdgcn_fence(__ATOMIC_ACQUIRE, "workgroup");
                        _Pragma("unroll 1") for (int part = 0; part < 2; ++part) p_peer_topk<true>(F, layer, S_, part ^ (F.bid & 1)); })
        PHASE(pb + 8, if ((PEER_U4_MASK >> layer) & 1) p_peer_u<true>(F, layer, (unsigned*)(F.ws + WS_CTL) + 8192 + layer * 2048 + (dry ? 8192 : 0));
                      else p_peer_u<false>(F, layer, (unsigned*)(F.ws + WS_CTL) + 8192 + layer * 2048 + (dry ? 8192 : 0));)
        PHASE(pb + 9, p_peer_fin(F, layer);)
        PHASE(pb + 10, if ((PEER_V4_MASK >> layer) & 1) p_peer_v4(F, args, layer, layer == 0, (unsigned*)(F.ws + WS_CTL) + 8192 + layer * 2048 + 1024 + (dry ? 8192 : 0), fac);
                       else p_peer_v(F, args, layer, layer == 0, (unsigned*)(F.ws + WS_CTL) + 8192 + layer * 2048 + 1024 + (dry ? 8192 : 0), fac);)
    }
}

extern "C" void kernel_launch(void* const* d_in, const int* in_sizes, int n_in, void* d_out, int out_size, void* d_ws, size_t ws_size, hipStream_t stream) {
    static int grid = 0;
    if (grid == 0) {
        if (n_in != 39 || out_size != TOK * DM || ws_size < WS_END) { fprintf(stderr, "kernel_launch: unexpected shapes (n_in %d out %d ws %zu need %zu)\n", n_in, out_size, ws_size, (size_t)WS_END); grid = -1; return; }
        int dev = 0, cus = 0, per_cu = 0;
        if (hipGetDevice(&dev) != hipSuccess || hipDeviceGetAttribute(&cus, hipDeviceAttributeMultiprocessorCount, dev) != hipSuccess) { grid = -1; return; }
        if (hipFuncSetAttribute((const void*)mega_fwd, hipFuncAttributeMaxDynamicSharedMemorySize, LDS_BYTES) != hipSuccess) { fprintf(stderr, "kernel_launch: hipFuncSetAttribute failed\n"); grid = -1; return; }
        if (hipOccupancyMaxActiveBlocksPerMultiprocessor(&per_cu, (const void*)mega_fwd, NTHREADS, LDS_BYTES) != hipSuccess || per_cu < 1) { fprintf(stderr, "kernel_launch: occupancy query says %d\n", per_cu); grid = -1; return; }
        (void)hipGetLastError();
        grid = cus;
    }
    if (grid < 0) return;
    (void)hipMemsetAsync((char*)d_ws + WS_CTL, 0, CTL_ZERO_BYTES, stream);
    Args a{};
    for (int i = 0; i < 39; ++i) a.in[i] = (const float*)d_in[i];
    a.pos = (const int*)d_in[2]; a.out = (float*)d_out; a.ws = (unsigned char*)d_ws;
#if MK_ONE_LAUNCH
    a.ph_lo = 0; a.ph_hi = PH_LAST + 1;
    hipLaunchKernelGGL(mega_fwd, dim3(grid), dim3(NTHREADS), LDS_BYTES, stream, a);
#else
    for (int ph = 0; ph <= PH_LAST; ++ph) { a.ph_lo = ph; a.ph_hi = ph + 1; hipLaunchKernelGGL(mega_fwd, dim3(grid), dim3(NTHREADS), LDS_BYTES, stream, a); }
#endif
}
```
